# Optimizing an MI355X kernel written in HIP

```python
import jax, jax.numpy as jnp
from jax import lax
import numpy as np

D_MODEL = 2048
BATCH = 4
SEQ = 4096
DEPTH = 2

N_MIXERS = 2
N_POOL_LAYERS = (DEPTH + 1) // 2
N_RWKV_LAYERS = DEPTH // 2
D_FF = 5632
POOL_WINDOWS = (2, 4, 8, 16)
N_POOL_GROUPS = len(POOL_WINDOWS)
POOL_GROUP = D_MODEL // N_POOL_GROUPS
HEAD_SIZE = 64
N_HEADS = D_MODEL // HEAD_SIZE
D_DECAY_LORA = 96
D_AAA_LORA = 96
D_GATE_LORA = 256
N_DIRS = 2
RMS_EPS = 1e-6
GN_EPS = 64e-5

kernel_name = 'hybrid_pool_rwkv7_macaron_encoder'


def rms_norm(x, g):
    xf = x.astype(jnp.float32)
    y = xf * lax.rsqrt(jnp.mean(xf * xf, axis=-1, keepdims=True) + RMS_EPS)
    return (y * g.astype(jnp.float32)).astype(x.dtype)


def swiglu(x, w_gate, w_up, w_down):
    return (jax.nn.silu(x @ w_gate) * (x @ w_up)) @ w_down


def pool_mixer(x, w_grp, scale):
    B, S, D = x.shape
    xf = x.astype(jnp.float32).reshape(B, S, N_POOL_GROUPS, POOL_GROUP)
    cs = jnp.concatenate([jnp.zeros_like(xf[:, :1]), jnp.cumsum(xf, axis=1)], axis=1)
    t = jnp.arange(S)
    outs = []
    for g, w in enumerate(POOL_WINDOWS):
        lo = jnp.clip(t - w // 2, 0, S)
        hi = jnp.clip(t - w // 2 + w, 0, S)
        csg = cs[:, :, g]
        win_sum = csg[:, hi] - csg[:, lo]
        cnt = (hi - lo).astype(jnp.float32)[None, :, None]
        outs.append(win_sum / cnt - xf[:, :, g])
    pooled = jnp.stack(outs, axis=2).astype(x.dtype)
    y = jnp.einsum('bsgc,gcd->bsgd', pooled, w_grp).reshape(B, S, D)
    return y * scale


def centred_shift_delta(x):
    zero = jnp.zeros_like(x[:, :1])
    prev = jnp.concatenate([zero, x[:, :-1]], axis=1)
    nxt = jnp.concatenate([x[:, 1:], zero], axis=1)
    return 0.5 * (prev + nxt) - x


def wkv7_scan(r, decay, k, v, a_vec, b, reverse):
    B, S, H, N = r.shape

    def step(state, inp):
        r_t, w_t, k_t, v_t, a_t, b_t = inp
        sa = jnp.einsum('bhij,bhj->bhi', state, a_t)
        state = (state * w_t[:, :, None, :] + sa[..., None] * b_t[:, :, None, :]
                 + v_t[..., None] * k_t[:, :, None, :])
        y = jnp.einsum('bhij,bhj->bhi', state, r_t)
        return state, y

    s0 = jnp.zeros((B, H, N, N), jnp.float32)
    xs = tuple(jnp.moveaxis(z, 1, 0) for z in (r, decay, k, v, a_vec, b))
    _, ys = lax.scan(step, s0, xs, reverse=reverse)
    return jnp.moveaxis(ys, 0, 1)


def rwkv7_bidir_mixer(x, mu, w_r, w_k, w_v, w_o, w0, w1, w2, a0, a1, a2, g1, g2,
                      k_k, k_a, r_k, ln_w, ln_b):
    B, S, D = x.shape
    f32 = jnp.float32
    heads = lambda z: z.astype(f32).reshape(B, S, N_HEADS, HEAD_SIZE)
    xx = centred_shift_delta(x)
    xr, xw, xk, xv, xa, xg = [x + xx * mu[i] for i in range(6)]
    r = xr @ w_r
    k = xk @ w_k
    v = xv @ w_v
    g = jax.nn.sigmoid(xg @ g1) @ g2
    kk = heads(k * k_k)
    kk = kk / jnp.maximum(jnp.sqrt(jnp.sum(kk * kk, axis=-1, keepdims=True)), 1e-12)
    rh, vh = heads(r), heads(v)
    y_sum = jnp.zeros((B, S, N_HEADS, HEAD_SIZE), f32)
    bonus = jnp.zeros((B, S, N_HEADS, HEAD_SIZE), f32)
    for d, rev in enumerate((False, True)):
        w_log = -jax.nn.softplus(-(w0[d] + jnp.tanh(xw @ w1[d]) @ w2[d]).astype(f32)) - 0.5
        decay = jnp.exp(-jnp.exp(w_log))
        a = jax.nn.sigmoid((a0[d] + (xa @ a1[d]) @ a2[d]).astype(f32))
        kd = heads(k.astype(f32) * (1.0 + (a - 1.0) * k_a.astype(f32)))
        ah = heads(a)
        y_sum = y_sum + wkv7_scan(rh, heads(decay), kd, vh, -kk, kk * ah, rev)
        bonus = bonus + jnp.sum(rh * kd * r_k.astype(f32), axis=-1, keepdims=True) * vh
    mean = jnp.mean(y_sum, axis=-1, keepdims=True)
    var = jnp.mean(jnp.square(y_sum - mean), axis=-1, keepdims=True)
    gn = ((y_sum - mean) * lax.rsqrt(var + GN_EPS)).reshape(B, S, D)
    gn = gn * ln_w.astype(f32) + ln_b.astype(f32)
    out = (gn + bonus.reshape(B, S, D)).astype(x.dtype) * g
    return out @ w_o


def setup_inputs(seed: int = 0) -> dict:
    key = jax.random.key(seed)
    ks = iter(jax.random.split(key, 48))
    nrm = lambda shape, s: jax.random.normal(next(ks), shape, jnp.float32) * s
    D, F, L, NP, NR = D_MODEL, D_FF, DEPTH, N_POOL_LAYERS, N_RWKV_LAYERS
    base_w0 = -6.5 + 5.0 * jnp.linspace(0.0, 1.0, D) ** 0.85
    return {
        'x': nrm((BATCH, SEQ, D), 1.0),
        'ffn1_norm': 1.0 + nrm((L, D), 0.05),
        'ffn1_gate': nrm((L, D, F), D ** -0.5),
        'ffn1_up': nrm((L, D, F), D ** -0.5),
        'ffn1_down': nrm((L, F, D), F ** -0.5),
        'mix_norm': 1.0 + nrm((L, D), 0.05),
        'ffn2_norm': 1.0 + nrm((L, D), 0.05),
        'ffn2_gate': nrm((L, D, F), D ** -0.5),
        'ffn2_up': nrm((L, D, F), D ** -0.5),
        'ffn2_down': nrm((L, F, D), F ** -0.5),
        'pool_w': nrm((NP, N_POOL_GROUPS, POOL_GROUP, POOL_GROUP), POOL_GROUP ** -0.5),
        'pool_scale': 1.0 + nrm((NP, D), 0.1),
        'rwkv_mu': jax.random.uniform(next(ks), (NR, 6, D), jnp.float32),
        'rwkv_wr': nrm((NR, D, D), D ** -0.5),
        'rwkv_wk': nrm((NR, D, D), D ** -0.5),
        'rwkv_wv': nrm((NR, D, D), D ** -0.5),
        'rwkv_wo': nrm((NR, D, D), D ** -0.5),
        'rwkv_w0': base_w0 + nrm((NR, N_DIRS, D), 0.1),
        'rwkv_w1': nrm((NR, N_DIRS, D, D_DECAY_LORA), 0.3 * D ** -0.5),
        'rwkv_w2': nrm((NR, N_DIRS, D_DECAY_LORA, D), 0.3 * D_DECAY_LORA ** -0.5),
        'rwkv_a0': nrm((NR, N_DIRS, D), 0.1),
        'rwkv_a1': nrm((NR, N_DIRS, D, D_AAA_LORA), D ** -0.5),
        'rwkv_a2': nrm((NR, N_DIRS, D_AAA_LORA, D), 0.3 * D_AAA_LORA ** -0.5),
        'rwkv_g1': nrm((NR, D, D_GATE_LORA), D ** -0.5),
        'rwkv_g2': nrm((NR, D_GATE_LORA, D), D_GATE_LORA ** -0.5),
        'rwkv_kk': 0.85 + nrm((NR, D), 0.05),
        'rwkv_ka': 1.0 + nrm((NR, D), 0.05),
        'rwkv_rk': nrm((NR, N_HEADS, HEAD_SIZE), 0.1),
        'rwkv_lnw': 1.0 + nrm((NR, D), 0.05),
        'rwkv_lnb': nrm((NR, D), 0.02),
        'final_norm': 1.0 + nrm((D,), 0.05),
    }


def reference(x, ffn1_norm, ffn1_gate, ffn1_up, ffn1_down, mix_norm,
              ffn2_norm, ffn2_gate, ffn2_up, ffn2_down, pool_w, pool_scale,
              rwkv_mu, rwkv_wr, rwkv_wk, rwkv_wv, rwkv_wo, rwkv_w0, rwkv_w1, rwkv_w2,
              rwkv_a0, rwkv_a1, rwkv_a2, rwkv_g1, rwkv_g2, rwkv_kk, rwkv_ka, rwkv_rk,
              rwkv_lnw, rwkv_lnb, final_norm):
    h = x
    for i in range(DEPTH):
        h = h + 0.5 * swiglu(rms_norm(h, ffn1_norm[i]), ffn1_gate[i], ffn1_up[i], ffn1_down[i])
        hn = rms_norm(h, mix_norm[i])
        j = i // N_MIXERS
        if i % N_MIXERS == 0:
            m = pool_mixer(hn, pool_w[j], pool_scale[j])
        else:
            m = rwkv7_bidir_mixer(hn, rwkv_mu[j], rwkv_wr[j], rwkv_wk[j], rwkv_wv[j], rwkv_wo[j],
                                  rwkv_w0[j], rwkv_w1[j], rwkv_w2[j], rwkv_a0[j], rwkv_a1[j],
                                  rwkv_a2[j], rwkv_g1[j], rwkv_g2[j], rwkv_kk[j], rwkv_ka[j],
                                  rwkv_rk[j], rwkv_lnw[j], rwkv_lnb[j])
        h = h + m
        h = h + 0.5 * swiglu(rms_norm(h, ffn2_norm[i]), ffn2_gate[i], ffn2_up[i], ffn2_down[i])
    return rms_norm(h, final_norm)
```

```cpp
#include <hip/hip_runtime.h>
#include <hip/hip_cooperative_groups.h>
#include <cstdio>
namespace cg = cooperative_groups;

#ifndef REP_MASK
#define REP_MASK 0
#endif
#ifndef MK_SINGLE
#define MK_SINGLE 1
#endif

#define LAS __attribute__((address_space(3)))
typedef unsigned short bf16_t;
typedef short bf16x8 __attribute__((ext_vector_type(8)));
typedef float f32x4 __attribute__((ext_vector_type(4)));
typedef float f32x2 __attribute__((ext_vector_type(2)));
typedef unsigned u32x4 __attribute__((ext_vector_type(4)));
typedef unsigned u32x2 __attribute__((ext_vector_type(2)));
typedef _Float16 h8 __attribute__((ext_vector_type(8)));

constexpr int M_ = 16384, D_ = 2048, F_ = 5632, S_ = 4096, NH_ = 32;
constexpr int NPHASE = 21;
constexpr int LDS_BYTES = 131072 + 16;
constexpr size_t MiB = 1ull << 20;
constexpr size_t O_WRT = 0 * MiB, O_WKT = 8 * MiB, O_WVT = 16 * MiB, O_WOT = 24 * MiB, O_W1C = 32 * MiB, O_A1C = 33 * MiB, O_G1C = 34 * MiB;
constexpr size_t O_W2T0 = 35 * MiB, O_W2T1 = 36 * MiB, O_A2T0 = 37 * MiB, O_A2T1 = 38 * MiB, O_G2T = 39 * MiB, O_POOLT = 40 * MiB;
constexpr size_t O_BAR = 42 * MiB;
constexpr size_t O_XN = 70 * MiB;
constexpr size_t O_AGU = 134 * MiB, O_AD = 178 * MiB, O_BGU = 200 * MiB, O_BD = 244 * MiB;
constexpr size_t O_U = 266 * MiB;
constexpr size_t O_X6 = 70 * MiB;
constexpr size_t O_R = 454 * MiB, O_K = 518 * MiB, O_V = 582 * MiB, O_LW = 646 * MiB, O_LA = 654 * MiB, O_LG = 662 * MiB, O_BS = 670 * MiB;
constexpr size_t O_E0 = 70 * MiB, O_E1 = 134 * MiB, O_A0 = 198 * MiB, O_A1 = 262 * MiB, O_G = 326 * MiB, O_POST = 390 * MiB;
constexpr size_t WS_NEED = 674 * MiB;

struct Params {
    const float* in[31];
    float* out;
    unsigned char* ws;
    int ph_lo, ph_hi;
};

#define GAS __attribute__((address_space(1)))
__device__ __forceinline__ const float* pin(const Params& p, int i) { asm volatile("" : "+s"(i)); return p.in[i]; }
__device__ __forceinline__ unsigned cvt_pk_bf16(float lo, float hi) { unsigned r; asm volatile("v_cvt_pk_bf16_f32 %0, %1, %2" : "=v"(r) : "v"(lo), "v"(hi)); return r; }
__device__ __forceinline__ unsigned pk_h2(float a, float b) { auto h = __builtin_amdgcn_cvt_pkrtz(a, b); return __builtin_bit_cast(unsigned, h); }
__device__ __forceinline__ float bf_lo(unsigned w) { return __builtin_bit_cast(float, w << 16); }
__device__ __forceinline__ float bf_hi(unsigned w) { return __builtin_bit_cast(float, w & 0xffff0000u); }
template <int CTRL> __device__ __forceinline__ float dpp_f(float v) {
    return __builtin_bit_cast(float, __builtin_amdgcn_update_dpp(0, __builtin_bit_cast(int, v), CTRL, 0xF, 0xF, true));
}
__device__ __forceinline__ float red8(float v) { v += dpp_f<0xB1>(v); v += dpp_f<0x4E>(v); v += dpp_f<0x141>(v); return v; }
__device__ __forceinline__ float wave_sum(float v) {
    v += dpp_f<0xB1>(v); v += dpp_f<0x4E>(v); v += dpp_f<0x141>(v); v += dpp_f<0x140>(v);
    const int iv = __builtin_bit_cast(int, v);
    const float r0 = __builtin_bit_cast(float, __builtin_amdgcn_readlane(iv, 0)), r1 = __builtin_bit_cast(float, __builtin_amdgcn_readlane(iv, 16));
    const float r2 = __builtin_bit_cast(float, __builtin_amdgcn_readlane(iv, 32)), r3 = __builtin_bit_cast(float, __builtin_amdgcn_readlane(iv, 48));
    return (r0 + r1) + (r2 + r3);
}
__device__ __forceinline__ float sigmoidf_(float x) { return __builtin_amdgcn_rcpf(1.f + __expf(-x)); }
#define LDS_WAIT() asm volatile("s_waitcnt lgkmcnt(0)" ::: "memory")


#define XB_TMO      128
#define XB_XCNT(j)  (256  + 64 * (j))
#define XB_XSUB(j)  (1280 + 64 * (j))
#define XB_XGEN(j)  (2304 + 64 * (j))
#define XB_TOP      3328
#define XB_TOPGEN   3392
#define XCD_BAR_WORDS 3456
#define XB_SPIN_CAP (1u << 18)
__device__ __forceinline__ unsigned xb_ld(unsigned* p)              { return __hip_atomic_load(p, __ATOMIC_RELAXED, __HIP_MEMORY_SCOPE_AGENT); }
__device__ __forceinline__ unsigned xb_add(unsigned* p, unsigned v) { return __hip_atomic_fetch_add(p, v, __ATOMIC_RELAXED, __HIP_MEMORY_SCOPE_AGENT); }
__device__ __forceinline__ unsigned xb_xcc_id() { return (unsigned)__builtin_amdgcn_s_getreg((3 << 11) | 20) & 0xFu; }
#define XB_SPIN(cond, bar) do { unsigned _sp = 0; while (cond) { __builtin_amdgcn_s_sleep(1); \
    if ((++_sp & 255u) == 0u) { if (xb_ld(&(bar)[XB_TMO])) break; if (_sp > XB_SPIN_CAP) { atomicAdd(&(bar)[XB_TMO], 1u); break; } } } } while (0)
struct XcdBarrier { unsigned* bar; unsigned x; volatile LAS unsigned* st; };
__device__ __forceinline__ void xcd_barrier_complete(unsigned* bar, unsigned x, unsigned& nloc, unsigned& nx) {
    const unsigned G = gridDim.x;
    unsigned sum, cnt, mine, sp = 0u;
    for (;;) {
        sum = 0u; cnt = 0u; mine = 0u;
#pragma unroll
        for (unsigned j = 0; j < 16; ++j) { const unsigned c = xb_ld(&bar[XB_XCNT(j)]); sum += c; cnt += (c > 0u) ? 1u : 0u; mine = (j == x) ? c : mine; }
        if (sum == G) break;
        __builtin_amdgcn_s_sleep(1);
        if ((++sp & 255u) == 0u) { if (xb_ld(&bar[XB_TMO])) break; if (sp > XB_SPIN_CAP) { atomicAdd(&bar[XB_TMO], 1u); break; } }
    }
    nloc = mine > 0u ? mine : 1u; nx = cnt > 0u ? cnt : 1u;
}
__device__ __forceinline__ void xcd_barrier(const XcdBarrier& b, bool leader_thread) {
    asm volatile("s_waitcnt vmcnt(0)" ::: "memory");
    __syncthreads();
    if (leader_thread) {
        unsigned* bar = b.bar;
        __builtin_amdgcn_s_waitcnt(0);
        unsigned nloc = b.st[0], nx = b.st[1];
        if (nloc == 0u) { xcd_barrier_complete(bar, b.x, nloc, nx); b.st[0] = nloc; b.st[1] = nx; }
        const unsigned old = xb_add(&bar[XB_XSUB(b.x)], 1u);
        const unsigned gen = old / nloc;
        if (old + 1u == (gen + 1u) * nloc) {
            __builtin_amdgcn_fence(__ATOMIC_RELEASE, "agent");
            asm volatile("s_waitcnt vmcnt(0)" ::: "memory");
            const unsigned og = xb_add(&bar[XB_TOP], 1u);
            const unsigned tg = og / nx;
            if (og + 1u == (tg + 1u) * nx) xb_add(&bar[XB_TOPGEN], 1u);
            else XB_SPIN(xb_ld(&bar[XB_TOPGEN]) == tg, bar);
            __builtin_amdgcn_fence(__ATOMIC_ACQUIRE, "agent");
            xb_add(&bar[XB_XGEN(b.x)], 1u);
            asm volatile("s_waitcnt vmcnt(0)" ::: "memory");
        } else {
            XB_SPIN(xb_ld(&bar[XB_XGEN(b.x)]) == gen, bar);
            __builtin_amdgcn_fence(__ATOMIC_ACQUIRE, "agent");
            asm volatile("s_waitcnt vmcnt(0)" ::: "memory");
        }
    }
    __syncthreads();
}

__device__ __forceinline__ void tr_load(const float* src, int N, int k0, int n0, float (&v)[32], int lane) {
#pragma unroll
    for (int i = 0; i < 32; ++i) v[i] = src[(size_t)(k0 + 2 * i + (lane >> 5)) * N + n0 + (lane & 31)];
}
__device__ __forceinline__ void tr_store(const float (&v)[32], int k0, int n0, bf16_t* dst, int ldd, int mode, int row0, int col0, const float* scale, LAS float* scr, int lane) {
#pragma unroll
    for (int i = 0; i < 32; ++i) {
        const int kk = 2 * i + (lane >> 5);
        float x = v[i];
        if (scale) x *= scale[k0 + kk];
        scr[kk * 33 + (lane & 31)] = x;
    }
    LDS_WAIT();
    const int c = lane & 7;
#pragma unroll
    for (int j = 0; j < 4; ++j) {
        const int n = (lane >> 3) + 8 * j; const LAS float* s = scr + (8 * c) * 33 + n;
        u32x4 o; o.x = cvt_pk_bf16(s[0 * 33], s[1 * 33]); o.y = cvt_pk_bf16(s[2 * 33], s[3 * 33]); o.z = cvt_pk_bf16(s[4 * 33], s[5 * 33]); o.w = cvt_pk_bf16(s[6 * 33], s[7 * 33]);
        const int ng = n0 + n;
        const int row = mode ? (256 * (ng >> 7) + row0 + (ng & 127)) : (row0 + ng);
        *(u32x4*)(dst + (size_t)row * ldd + col0 + k0 + 8 * c) = o;
    }
    LDS_WAIT();
}
__device__ __forceinline__ void tr_mat(const float* src, int K, int N, bf16_t* dst, int ldd, int mode, int row0, int col0, const float* scale, LAS float* scr, int lane, int gw, int NGW, int rot) {
    const int nblk = N / 32, items = (K / 64) * nblk;
    int it = gw - rot; while (it < 0) it += NGW;
    float va[32], vb[32];
    if (it < items) tr_load(src, N, 64 * (it / nblk), 32 * (it % nblk), va, lane);
    while (it < items) {
        const int nx = it + NGW;
        if (nx < items) tr_load(src, N, 64 * (nx / nblk), 32 * (nx % nblk), vb, lane);
        tr_store(va, 64 * (it / nblk), 32 * (it % nblk), dst, ldd, mode, row0, col0, scale, scr, lane);
#pragma unroll
        for (int i = 0; i < 32; ++i) va[i] = vb[i];
        it = nx;
    }
}
__device__ __forceinline__ void conv_ffn(const float* gate, const float* up, const float* down, bf16_t* gu, bf16_t* dn, LAS float* scr, int lane, int gw, int NGW) {
    tr_mat(gate, D_, F_, gu, D_, 1, 0, 0, nullptr, scr, lane, gw, NGW, 0);
    tr_mat(up, D_, F_, gu, D_, 1, 128, 0, nullptr, scr, lane, gw, NGW, 5632);
    tr_mat(down, F_, D_, dn, F_, 0, 0, 0, nullptr, scr, lane, gw, NGW, 11264);
}
__device__ __forceinline__ void conv_rwkv(const Params& p, unsigned char* ws, LAS float* scr, int lane, int gw, int NGW) {
    tr_mat(pin(p, 13), D_, D_, (bf16_t*)(ws + O_WRT), D_, 0, 0, 0, nullptr, scr, lane, gw, NGW, 0);
    tr_mat(pin(p, 14), D_, D_, (bf16_t*)(ws + O_WKT), D_, 0, 0, 0, nullptr, scr, lane, gw, NGW, 0);
    tr_mat(pin(p, 15), D_, D_, (bf16_t*)(ws + O_WVT), D_, 0, 0, 0, nullptr, scr, lane, gw, NGW, 0);
    tr_mat(pin(p, 16), D_, D_, (bf16_t*)(ws + O_WOT), D_, 0, 0, 0, nullptr, scr, lane, gw, NGW, 0);
    for (int d = 0; d < 2; ++d) {
        tr_mat(pin(p, 18) + (size_t)d * D_ * 96, D_, 96, (bf16_t*)(ws + O_W1C), D_, 0, d * 96, 0, nullptr, scr, lane, gw, NGW, d * 96);
        tr_mat(pin(p, 21) + (size_t)d * D_ * 96, D_, 96, (bf16_t*)(ws + O_A1C), D_, 0, d * 96, 0, nullptr, scr, lane, gw, NGW, 192 + d * 96);
    }
    tr_mat(pin(p, 23), D_, 256, (bf16_t*)(ws + O_G1C), D_, 0, 0, 0, nullptr, scr, lane, gw, NGW, 384);
    tr_mat(pin(p, 24), 256, D_, (bf16_t*)(ws + O_G2T), 256, 0, 0, 0, nullptr, scr, lane, gw, NGW, 1280);
    for (int g = 0; g < 4; ++g)
        tr_mat(pin(p, 10) + (size_t)g * 512 * 512, 512, 512, (bf16_t*)(ws + O_POOLT) + (size_t)g * 512 * 512, 512, 0, 0, 0, nullptr, scr, lane, gw, NGW, 1536 + g * 128);
    const int gt = gw * 64 + lane, NT = NGW * 64;
    for (int idx = gt; idx < 2 * 64 * 2048; idx += NT) {
        const int which = idx / (64 * 2048), r = idx % (64 * 2048);
        bf16_t* dst = (bf16_t*)(ws + (which ? O_A1C : O_W1C)) + (size_t)192 * 2048;
        dst[r] = 0;
    }
    for (int idx = gt; idx < 4 * 256 * 2048; idx += NT) {
        const int mat = idx / (256 * 2048), r = idx % (256 * 2048), kk = r / 2048, n = r % 2048;
        const int d = mat & 1; const bool isa = mat >= 2;
        const float* src = (isa ? pin(p, 22) : pin(p, 19)) + (size_t)d * 96 * D_;
        bf16_t* dst = (bf16_t*)(ws + (isa ? (d ? O_A2T1 : O_A2T0) : (d ? O_W2T1 : O_W2T0)));
        const int j = kk - d * 96;
        const float v = (j >= 0 && j < 96) ? src[(size_t)j * D_ + n] : 0.f;
        dst[(size_t)n * 256 + kk] = (bf16_t)(cvt_pk_bf16(v, 0.f) & 0xffffu);
    }
}

template <bool FINAL>
__device__ __forceinline__ void norm_phase(const float* src, const float* gain, bf16_t* dst, float* fdst, int lane, int gw, int NGW) {
    f32x4 gv[8];
#pragma unroll
    for (int j = 0; j < 8; ++j) gv[j] = ((const f32x4*)gain)[lane + 64 * j];
    for (int row = gw; row < M_; row += NGW) {
        const f32x4* xr = (const f32x4*)(src + (size_t)row * D_) + lane;
        f32x4 v[8]; float s = 0.f;
#pragma unroll
        for (int j = 0; j < 8; ++j) { v[j] = xr[64 * j]; s += (v[j].x * v[j].x + v[j].y * v[j].y) + (v[j].z * v[j].z + v[j].w * v[j].w); }
        const float rstd = rsqrtf(wave_sum(s) * (1.f / D_) + 1e-6f);
        if (FINAL) {
            f32x4* o = (f32x4*)(fdst + (size_t)row * D_) + lane;
#pragma unroll
            for (int j = 0; j < 8; ++j) o[64 * j] = v[j] * rstd * gv[j];
        } else {
            u32x2* o = (u32x2*)(dst + (size_t)row * D_) + lane;
#pragma unroll
            for (int j = 0; j < 8; ++j) { f32x4 t = v[j] * rstd * gv[j]; u32x2 w; w.x = cvt_pk_bf16(t.x, t.y); w.y = cvt_pk_bf16(t.z, t.w); o[64 * j] = w; }
        }
    }
}

__device__ __forceinline__ void load_norm_row(const float* src, int row, const f32x4 (&gv)[8], f32x4 (&o)[8], int lane) {
    const f32x4* xr = (const f32x4*)(src + (size_t)row * D_) + lane;
    float s = 0.f;
#pragma unroll
    for (int j = 0; j < 8; ++j) { o[j] = xr[64 * j]; s += (o[j].x * o[j].x + o[j].y * o[j].y) + (o[j].z * o[j].z + o[j].w * o[j].w); }
    const float rstd = rsqrtf(wave_sum(s) * (1.f / D_) + 1e-6f);
#pragma unroll
    for (int j = 0; j < 8; ++j) o[j] = o[j] * rstd * gv[j];
}
__device__ __forceinline__ void rwkv_prep_phase(const float* h, const float* gain, const float* mu, bf16_t* x6, int lane, int gw, int NGW) {
    f32x4 gv[8];
#pragma unroll
    for (int j = 0; j < 8; ++j) gv[j] = ((const f32x4*)gain)[lane + 64 * j];
    for (int run = gw; run < M_ / 8; run += NGW) {
        const int row0 = run * 8, t0 = row0 & (S_ - 1);
        f32x4 prev[8], cur[8], nxt[8];
        if (t0 > 0) load_norm_row(h, row0 - 1, gv, prev, lane);
        else {
#pragma unroll
            for (int j = 0; j < 8; ++j) prev[j] = (f32x4){0.f, 0.f, 0.f, 0.f};
        }
        load_norm_row(h, row0, gv, cur, lane);
        for (int i = 0; i < 8; ++i) {
            const int row = row0 + i, t = t0 + i;
            if (t + 1 < S_) load_norm_row(h, row + 1, gv, nxt, lane);
            else {
#pragma unroll
                for (int j = 0; j < 8; ++j) nxt[j] = (f32x4){0.f, 0.f, 0.f, 0.f};
            }
#pragma unroll
            for (int j = 0; j < 8; ++j) {
                const f32x4 xx = (prev[j] + nxt[j]) * 0.5f - cur[j];
#pragma unroll
                for (int q = 0; q < 6; ++q) {
                    const f32x4 m4 = ((const f32x4*)(mu + (size_t)q * D_))[lane + 64 * j];
                    const f32x4 xm = cur[j] + xx * m4;
                    u32x2 w; w.x = cvt_pk_bf16(xm.x, xm.y); w.y = cvt_pk_bf16(xm.z, xm.w);
                    ((u32x2*)(x6 + (size_t)q * M_ * D_ + (size_t)row * D_))[lane + 64 * j] = w;
                }
                prev[j] = cur[j]; cur[j] = nxt[j];
            }
        }
    }
}

__device__ __forceinline__ void pool_prep_phase(const float* h, const float* gain, bf16_t* outp, LAS unsigned char* lds, int tid, int lane, int wave, int bid, int nb) {
    LAS float* rs = (LAS float*)lds;
    for (int chunk = bid; chunk < M_ / 64; chunk += nb) {
        const int m0 = chunk * 64, b = m0 / S_, t0 = m0 % S_;
        __syncthreads();
        for (int rr = wave; rr < 80; rr += 8) {
            const int t = t0 - 8 + rr;
            if (t >= 0 && t < S_) {
                const f32x4* xr = (const f32x4*)(h + ((size_t)b * S_ + t) * D_) + lane;
                float s = 0.f;
#pragma unroll
                for (int j = 0; j < 8; ++j) { const f32x4 v = xr[64 * j]; s += (v.x * v.x + v.y * v.y) + (v.z * v.z + v.w * v.w); }
                s = wave_sum(s);
                if (lane == 0) rs[rr] = rsqrtf(s * (1.f / D_) + 1e-6f);
            }
        }
        __syncthreads();
        const int c = 4 * tid, g = tid >> 7, w = 2 << g, half = w >> 1;
        const f32x4 gn = *(const f32x4*)(gain + c);
        const float* hb = h + (size_t)b * S_ * D_ + c;
#define HN(t) ((*(const f32x4*)(hb + (size_t)(t) * D_)) * rs[(t) - t0 + 8] * gn)
        int lo = t0 - half; if (lo < 0) lo = 0;
        int hi = t0 + half; if (hi > S_) hi = S_;
        f32x4 sum = (f32x4){0.f, 0.f, 0.f, 0.f};
        for (int u = lo; u < hi; ++u) sum += HN(u);
#pragma unroll 8
        for (int i = 0; i < 64; ++i) {
            const int t = t0 + i;
            const f32x4 x = HN(t);
            const float inv = 1.f / (float)(hi - lo);
            const f32x4 o = sum * inv - x;
            u32x2 wv; wv.x = cvt_pk_bf16(o.x, o.y); wv.y = cvt_pk_bf16(o.z, o.w);
            *(u32x2*)(outp + ((size_t)b * S_ + t) * D_ + c) = wv;
            if (i < 63) {
                if (t + 1 - half > 0) { sum -= HN(lo); ++lo; }
                if (t + half < S_) { sum += HN(t + half); ++hi; }
            }
        }
#undef HN
    }
}

constexpr int BM = 256, BK = 64, HALF = 128, HTB = HALF * BK * 2;
__device__ __forceinline__ int lds_byte(int r, int c) { const int st = (r >> 4) * 2 + (c >> 5), rr = r & 15, cc = c & 31, ob = rr * 64 + cc * 2; return st * 1024 + (ob ^ (((ob >> 9) & 1) << 5)); }
__device__ __forceinline__ void stage_rc(int b, int& R, int& C) { const int st = b / 1024, sb = b % 1024, swz = sb ^ (((sb >> 9) & 1) << 5); R = (st >> 1) * 16 + swz / 64; C = (st & 1) * 32 + (swz % 64) / 2; }
__device__ __forceinline__ int perm32(int rho) { const int n = rho >> 4, i = rho & 15; return 8 * (i >> 2) + 4 * n + (i & 3); }

struct Unit { const char* a; const char* b; int pm, pn, job; };

__device__ __forceinline__ void remap_tile(int l, int nM, int nN, int& pm, int& pn, int wgm = 8) {
    const int nwg = nM * nN; int wgid = l;
    { const int q = nwg / 8, r = nwg % 8, xcd = wgid % 8, off = wgid / 8; wgid = (xcd < r ? xcd * (q + 1) : r * (q + 1) + (xcd - r) * q) + off; }
    const int nig = wgm * nN, gid = wgid / nig, fm = gid * wgm, gsz = (nM - fm) < wgm ? (nM - fm) : wgm;
    pm = fm + ((wgid % nig) % gsz); pn = (wgid % nig) / gsz;
}

template <class Epi, class Sched>
__device__ __forceinline__ void gemm_phase(LAS unsigned char* lds, const int tid, const int K, const int lda, const int ldb, const Sched& S, const Epi& E) {
    const int wid = __builtin_amdgcn_readfirstlane(tid >> 6), lane = tid & 63, wr = wid >> 2, wc = wid & 3, fr = lane & 15, fq = lane >> 4;
    const int nt = K / BK;
    unsigned voffA, voffB;
    { int R, C; stage_rc(tid * 16, R, C); const int Rb = Epi::PERM ? ((R & ~31) + perm32(R & 31)) : R;
        voffA = (unsigned)(R * lda + C) * 2u; voffB = (unsigned)(Rb * ldb + C) * 2u; }
    const size_t q64A = (size_t)64 * lda * 2, q64B = (size_t)64 * ldb * 2;
    const size_t kstep = (size_t)(BK * 2);
    const size_t hstepA = (size_t)HALF * lda * 2, hstepB = (size_t)HALF * ldb * 2;
    const unsigned ldsw = (unsigned)wid * 1024u;
    const int aoff = lds_byte(wr * 64 + fr, fq * 8), boff = lds_byte(wc * 32 + fr, fq * 8);
#define PG8_SA(b, h) (((b) * 2 + (h)) * HTB)
#define PG8_SB(b, h) ((4 + (b) * 2 + (h)) * HTB)
#define PG8_STAGE(bufoff, gbase, voff) do { \
        __builtin_amdgcn_global_load_lds((const unsigned*)((const char*)(gbase) + (voff)), (LAS unsigned*)(lds + (bufoff) + ldsw), 16, 0, 0); \
        __builtin_amdgcn_global_load_lds((const unsigned*)((const char*)(gbase) + q64_##voff + (voff)), (LAS unsigned*)(lds + (bufoff) + ldsw + 8192), 16, 0, 0); } while (0)
#define q64_voffA q64A
#define q64_voffB q64B
#define PG8_LDA(dst, b, h) do { _Pragma("unroll") for (int m = 0; m < 4; ++m) _Pragma("unroll") for (int k = 0; k < 2; ++k) dst[m][k] = *(const LAS bf16x8*)(lds + PG8_SA(b, h) + aoff + m * 2048 + k * 1024); } while (0)
#define PG8_LDB(dst, b, h) do { _Pragma("unroll") for (int n = 0; n < 2; ++n) _Pragma("unroll") for (int k = 0; k < 2; ++k) dst[n][k] = *(const LAS bf16x8*)(lds + PG8_SB(b, h) + boff + n * 2048 + k * 1024); } while (0)
#define PG8_MMA(ai, bj, At, Bt) do { __builtin_amdgcn_s_setprio(1); _Pragma("unroll") for (int m = 0; m < 4; ++m) _Pragma("unroll") for (int n = 0; n < 2; ++n) _Pragma("unroll") for (int k = 0; k < 2; ++k) \
        acc[ai][bj][m][n] = __builtin_amdgcn_mfma_f32_16x16x32_bf16(Bt[n][k], At[m][k], acc[ai][bj][m][n], 0, 0, 0); __builtin_amdgcn_s_setprio(0); } while (0)
#define PG8_WAIT_V(n) asm volatile("s_waitcnt vmcnt(" #n ")" ::: "memory")
#define PG8_WAIT_L(n) asm volatile("s_waitcnt lgkmcnt(" #n ")" ::: "memory")
#define PG8_BAR __builtin_amdgcn_s_barrier()
#define PG8_SCHED __builtin_amdgcn_sched_barrier(0)
    Unit cur, nxt; int ui = 0;
    if (!S.next(0, cur)) return;
    f32x4 acc[2][2][4][2];
#pragma unroll
    for (int a = 0; a < 2; ++a)
#pragma unroll
        for (int b = 0; b < 2; ++b)
#pragma unroll
            for (int m = 0; m < 4; ++m)
#pragma unroll
                for (int n = 0; n < 2; ++n) acc[a][b][m][n] = (f32x4){0.f, 0.f, 0.f, 0.f};
    bf16x8 At[4][2], B0[2][2], B1[2][2];
    const char* cA = cur.a; const char* cB = cur.b;
    PG8_STAGE(PG8_SB(0, 0), cB, voffB); PG8_STAGE(PG8_SA(0, 0), cA, voffA); PG8_STAGE(PG8_SB(0, 1), cB + hstepB, voffB); PG8_STAGE(PG8_SA(0, 1), cA + hstepA, voffA);
    if (wr == 1) PG8_BAR;
    PG8_WAIT_V(4); PG8_BAR;
    PG8_STAGE(PG8_SB(1, 0), cB + kstep, voffB); PG8_STAGE(PG8_SA(1, 0), cA + kstep, voffA); PG8_STAGE(PG8_SB(1, 1), cB + hstepB + kstep, voffB);
    PG8_WAIT_V(6); PG8_BAR;
    for (;;) {
        const bool has_next = S.next(ui + 1, nxt);
        const char* nA = has_next ? nxt.a : cA; const char* nB = has_next ? nxt.b : cB;
        for (int t = 0; t < nt; t += 2) {
            const bool last = (t == nt - 2);
            const char* a1 = cA + (size_t)(t + 1) * kstep;
            const char* a2 = last ? nA : cA + (size_t)(t + 2) * kstep; const char* b2 = last ? nB : cB + (size_t)(t + 2) * kstep;
            const char* a3 = a2 + kstep; const char* b3 = b2 + kstep;
            PG8_LDB(B0, 0, 0); PG8_SCHED; PG8_LDA(At, 0, 0); PG8_STAGE(PG8_SA(1, 1), a1 + hstepA, voffA);
            PG8_WAIT_L(8); PG8_BAR; PG8_WAIT_L(0); PG8_MMA(0, 0, At, B0); PG8_BAR; PG8_SCHED;
            PG8_LDB(B1, 0, 1); PG8_STAGE(PG8_SB(0, 0), b2, voffB);
            PG8_BAR; PG8_WAIT_L(0); PG8_MMA(0, 1, At, B1); PG8_BAR;
            PG8_LDA(At, 0, 1); PG8_STAGE(PG8_SA(0, 0), a2, voffA);
            PG8_BAR; PG8_WAIT_L(0); PG8_MMA(1, 0, At, B0); PG8_BAR; PG8_SCHED;
            PG8_STAGE(PG8_SB(0, 1), b2 + hstepB, voffB);
            PG8_WAIT_V(6); PG8_BAR; PG8_MMA(1, 1, At, B1); PG8_BAR;
            PG8_LDB(B0, 1, 0); PG8_SCHED; PG8_LDA(At, 1, 0); PG8_STAGE(PG8_SA(0, 1), a2 + hstepA, voffA);
            PG8_WAIT_L(8); PG8_BAR; PG8_WAIT_L(0); PG8_MMA(0, 0, At, B0); PG8_BAR; PG8_SCHED;
            PG8_LDB(B1, 1, 1); PG8_STAGE(PG8_SB(1, 0), b3, voffB);
            PG8_BAR; PG8_WAIT_L(0); PG8_MMA(0, 1, At, B1); PG8_BAR;
            PG8_LDA(At, 1, 1); PG8_STAGE(PG8_SA(1, 0), a3, voffA);
            PG8_BAR; PG8_WAIT_L(0); PG8_MMA(1, 0, At, B0); PG8_BAR; PG8_SCHED;
            PG8_STAGE(PG8_SB(1, 1), b3 + hstepB, voffB);
            PG8_WAIT_V(6); PG8_BAR; PG8_MMA(1, 1, At, B1); PG8_BAR;
        }
        { int ln = lane; asm volatile("" : "+v"(ln)); E(acc, cur, wr, wc, ln & 15, ln >> 4); }
        if (!has_next) break;
#pragma unroll
        for (int a = 0; a < 2; ++a)
#pragma unroll
            for (int b = 0; b < 2; ++b)
#pragma unroll
                for (int m = 0; m < 4; ++m)
#pragma unroll
                    for (int n = 0; n < 2; ++n) acc[a][b][m][n] = (f32x4){0.f, 0.f, 0.f, 0.f};
        cur = nxt; cA = nA; cB = nB; ++ui;
    }
    PG8_WAIT_V(0);
    if (wr == 0) PG8_BAR;
    PG8_BAR;
#undef PG8_SA
#undef PG8_SB
#undef PG8_STAGE
#undef q64_voffA
#undef q64_voffB
#undef PG8_LDA
#undef PG8_LDB
#undef PG8_MMA
#undef PG8_WAIT_V
#undef PG8_WAIT_L
#undef PG8_BAR
#undef PG8_SCHED
}

struct SchedSimple {
    const char* A; const char* Bt; int nM, nN, G, c, poolmode, wgm; size_t tstepA, tstepB;
    __device__ __forceinline__ bool next(int i, Unit& u) const {
        const int L = i * G + c; if (L >= nM * nN) return false;
        int pm, pn; remap_tile(L, nM, nN, pm, pn, wgm);
        u.a = A + (size_t)pm * tstepA + (poolmode ? (size_t)(pn >> 1) * 1024 : 0); u.b = Bt + (size_t)pn * tstepB; u.pm = pm; u.pn = pn; u.job = 0; return true;
    }
};
struct SchedProj {
    const char* ws; int G, c;
    __device__ __forceinline__ bool next(int i, Unit& u) const {
        const int L = i * G + c; if (L >= 1728) return false;
        int job, l, nN; size_t bo, ao;
        if (L < 1536) { job = L >> 9; l = L & 511; nN = 8; bo = job == 0 ? O_WRT : (job == 1 ? O_WKT : O_WVT); ao = job == 0 ? 0 : (job == 1 ? 2 : 3); }
        else { const int q = L - 1536; job = 3 + (q >> 6); l = q & 63; nN = 1; bo = job == 3 ? O_W1C : (job == 4 ? O_A1C : O_G1C); ao = job == 3 ? 1 : (job == 4 ? 4 : 5); }
        int pm, pn; remap_tile(l, 64, nN, pm, pn, nN == 8 ? 4 : 8);
        u.a = ws + O_X6 + ao * (64 * MiB) + (size_t)pm * (256 * 2048 * 2); u.b = ws + bo + (size_t)pn * (256 * 2048 * 2); u.pm = pm; u.pn = pn; u.job = job; return true;
    }
};
struct SchedLora2 {
    const char* ws; int G, c;
    __device__ __forceinline__ bool next(int i, Unit& u) const {
        const int L = i * G + c; if (L >= 2560) return false;
        const int job = L >> 9, l = L & 511;
        const size_t ao = job < 2 ? O_LW : (job < 4 ? O_LA : O_LG);
        const size_t bo = job == 0 ? O_W2T0 : (job == 1 ? O_W2T1 : (job == 2 ? O_A2T0 : (job == 3 ? O_A2T1 : O_G2T)));
        int pm, pn; remap_tile(l, 64, 8, pm, pn, 4);
        u.a = ws + ao + (size_t)pm * (256 * 256 * 2); u.b = ws + bo + (size_t)pn * (256 * 256 * 2); u.pm = pm; u.pn = pn; u.job = job; return true;
    }
};

struct EpiSwiGLU {
    static constexpr bool PERM = true;
    bf16_t* U;
    __device__ __forceinline__ void operator()(const f32x4 (&acc)[2][2][4][2], const Unit& u, int wr, int wc, int fr, int fq) const {
        const int row0 = u.pm * BM + wr * 64 + fr, col0 = u.pn * 128 + wc * 32 + 8 * fq;
#pragma unroll
        for (int ai = 0; ai < 2; ++ai)
#pragma unroll
            for (int m = 0; m < 4; ++m) {
                bf16_t* rowp = U + (size_t)(row0 + ai * HALF + m * 16) * F_ + col0;
                float o[8];
#pragma unroll
                for (int n = 0; n < 2; ++n)
#pragma unroll
                    for (int j = 0; j < 4; ++j) { const float g = acc[ai][0][m][n][j], up = acc[ai][1][m][n][j]; o[4 * n + j] = g * sigmoidf_(g) * up; }
                u32x4 w; w.x = cvt_pk_bf16(o[0], o[1]); w.y = cvt_pk_bf16(o[2], o[3]); w.z = cvt_pk_bf16(o[4], o[5]); w.w = cvt_pk_bf16(o[6], o[7]);
                *(u32x4*)rowp = w;
            }
    }
};
struct EpiResid {
    static constexpr bool PERM = false;
    const float* src; float* dst; const float* colscale; float scale;
    __device__ __forceinline__ void operator()(const f32x4 (&acc)[2][2][4][2], const Unit& u, int wr, int wc, int fr, int fq) const {
        const int row0 = u.pm * BM + wr * 64 + fr, col0 = u.pn * BM + wc * 32 + 4 * fq;
        f32x4 sv[2][2];
#pragma unroll
        for (int bj = 0; bj < 2; ++bj)
#pragma unroll
            for (int n = 0; n < 2; ++n) sv[bj][n] = colscale ? *(const f32x4*)(colscale + col0 + bj * HALF + n * 16) * scale : (f32x4){scale, scale, scale, scale};
#pragma unroll
        for (int ai = 0; ai < 2; ++ai) {
            f32x4 base[4][2][2];
#pragma unroll
            for (int m = 0; m < 4; ++m)
#pragma unroll
                for (int bj = 0; bj < 2; ++bj)
#pragma unroll
                    for (int n = 0; n < 2; ++n) base[m][bj][n] = *(const f32x4*)(src + (size_t)(row0 + ai * HALF + m * 16) * D_ + col0 + bj * HALF + n * 16);
            __builtin_amdgcn_sched_barrier(0);
#pragma unroll
            for (int m = 0; m < 4; ++m)
#pragma unroll
                for (int bj = 0; bj < 2; ++bj)
#pragma unroll
                    for (int n = 0; n < 2; ++n) *(f32x4*)(dst + (size_t)(row0 + ai * HALF + m * 16) * D_ + col0 + bj * HALF + n * 16) = base[m][bj][n] + acc[ai][bj][m][n] * sv[bj][n];
            __builtin_amdgcn_sched_barrier(0);
        }
    }
};
struct EpiProj {
    static constexpr bool PERM = true;
    unsigned char* ws;
    __device__ __forceinline__ void operator()(const f32x4 (&acc)[2][2][4][2], const Unit& u, int wr, int wc, int fr, int fq) const {
        const int job = u.job;
        const int row0 = u.pm * BM + wr * 64 + fr, col0 = u.pn * BM + wc * 32 + 8 * fq;
        const size_t obase = job == 0 ? O_R : (job == 1 ? O_K : (job == 2 ? O_V : (job == 3 ? O_LW : (job == 4 ? O_LA : O_LG))));
        const int ldc = job < 3 ? D_ : 256;
        unsigned short* outp = (unsigned short*)(ws + obase) + (size_t)row0 * ldc + col0;
        const float c0 = job == 3 ? 1.f : 0.f, c1 = job == 3 ? -2.f : 1.f, c2 = job == 3 ? 2.f : -1.f;
        const bool act = (job == 3) || (job == 5), f16 = job < 3;
#pragma unroll
        for (int ai = 0; ai < 2; ++ai)
#pragma unroll
            for (int m = 0; m < 4; ++m) {
                unsigned short* rowp = outp + (size_t)(ai * HALF + m * 16) * ldc;
#pragma unroll
                for (int bj = 0; bj < 2; ++bj) {
                    f32x4 v0 = acc[ai][bj][m][0], v1 = acc[ai][bj][m][1];
                    if (act) {
#pragma unroll
                        for (int j = 0; j < 4; ++j) { v0[j] = c0 + c1 * __builtin_amdgcn_rcpf(1.f + __expf(c2 * v0[j])); v1[j] = c0 + c1 * __builtin_amdgcn_rcpf(1.f + __expf(c2 * v1[j])); }
                    }
                    u32x4 w;
                    if (f16) { w.x = pk_h2(v0[0], v0[1]); w.y = pk_h2(v0[2], v0[3]); w.z = pk_h2(v1[0], v1[1]); w.w = pk_h2(v1[2], v1[3]); }
                    else { w.x = cvt_pk_bf16(v0[0], v0[1]); w.y = cvt_pk_bf16(v0[2], v0[3]); w.z = cvt_pk_bf16(v1[0], v1[1]); w.w = cvt_pk_bf16(v1[2], v1[3]); }
                    *(u32x4*)(rowp + bj * HALF) = w;
                }
            }
    }
};
struct EpiLora2 {
    static constexpr bool PERM = true;
    unsigned char* ws; const float* w0; const float* a0;
    __device__ __forceinline__ void operator()(const f32x4 (&acc)[2][2][4][2], const Unit& u, int wr, int wc, int fr, int fq) const {
        const int job = u.job;
        const int row0 = u.pm * BM + wr * 64 + fr, col0 = u.pn * BM + wc * 32 + 8 * fq;
        const size_t obase = job == 0 ? O_E0 : (job == 1 ? O_E1 : (job == 2 ? O_A0 : (job == 3 ? O_A1 : O_G)));
        unsigned short* outp = (unsigned short*)(ws + obase) + (size_t)row0 * D_ + col0;
        const float* bias = (job < 2 ? (w0 + (size_t)job * D_) : (a0 + (size_t)(job & 1) * D_)) + col0;
        const float osc = job < 2 ? 0.60653065971f : 1.f;
        const bool act = job < 4;
#pragma unroll
        for (int bj = 0; bj < 2; ++bj) {
            f32x4 b0 = (f32x4){0.f, 0.f, 0.f, 0.f}, b1 = b0;
            if (act) { b0 = *(const f32x4*)(bias + bj * HALF); b1 = *(const f32x4*)(bias + bj * HALF + 4); }
#pragma unroll
            for (int ai = 0; ai < 2; ++ai)
#pragma unroll
                for (int m = 0; m < 4; ++m) {
                    unsigned short* rowp = outp + (size_t)(ai * HALF + m * 16) * D_;
                    f32x4 v0 = acc[ai][bj][m][0] + b0, v1 = acc[ai][bj][m][1] + b1;
                    if (act) {
#pragma unroll
                        for (int j = 0; j < 4; ++j) { v0[j] = osc * sigmoidf_(v0[j]); v1[j] = osc * sigmoidf_(v1[j]); }
                    }
                    u32x4 w; w.x = pk_h2(v0[0], v0[1]); w.y = pk_h2(v0[2], v0[3]); w.z = pk_h2(v1[0], v1[1]); w.w = pk_h2(v1[2], v1[3]);
                    *(u32x4*)(rowp + bj * HALF) = w;
                    __builtin_amdgcn_sched_barrier(0);
                }
        }
    }
};

constexpr int SC_T = 32;
constexpr int SC_AV = 0, SC_WR = SC_T * 32 * 4, SC_W = 2 * SC_T * 32 * 4, SC_BK = SC_W + SC_T * 64 * 4, SC_V = SC_BK + SC_T * 64 * 4, SC_SC = SC_V + SC_T * 64 * 4, SC_Y = SC_SC + SC_T * 2 * 4, SC_A = SC_Y + SC_T * 64 * 4, SC_BUF = SC_A + SC_T * 64 * 4;
constexpr int SC_ZERO = 2 * SC_BUF;
typedef _Float16 half2_t __attribute__((ext_vector_type(2)));
__device__ __forceinline__ float dot2h(unsigned a, unsigned b, float c) { return __builtin_amdgcn_fdot2(__builtin_bit_cast(half2_t, a), __builtin_bit_cast(half2_t, b), c, false); }
__device__ __forceinline__ void red8x4(float& a, float& b, float& c, float& d) {
    asm volatile("s_nop 1\n\t"
                 "v_add_f32_dpp %0, %0, %0 quad_perm:[1,0,3,2] row_mask:0xf bank_mask:0xf\n\t"
                 "v_add_f32_dpp %1, %1, %1 quad_perm:[1,0,3,2] row_mask:0xf bank_mask:0xf\n\t"
                 "v_add_f32_dpp %2, %2, %2 quad_perm:[1,0,3,2] row_mask:0xf bank_mask:0xf\n\t"
                 "v_add_f32_dpp %3, %3, %3 quad_perm:[1,0,3,2] row_mask:0xf bank_mask:0xf\n\t"
                 "v_add_f32_dpp %0, %0, %0 quad_perm:[2,3,0,1] row_mask:0xf bank_mask:0xf\n\t"
                 "v_add_f32_dpp %1, %1, %1 quad_perm:[2,3,0,1] row_mask:0xf bank_mask:0xf\n\t"
                 "v_add_f32_dpp %2, %2, %2 quad_perm:[2,3,0,1] row_mask:0xf bank_mask:0xf\n\t"
                 "v_add_f32_dpp %3, %3, %3 quad_perm:[2,3,0,1] row_mask:0xf bank_mask:0xf\n\t"
                 "v_add_f32_dpp %0, %0, %0 row_half_mirror row_mask:0xf bank_mask:0xf\n\t"
                 "v_add_f32_dpp %1, %1, %1 row_half_mirror row_mask:0xf bank_mask:0xf\n\t"
                 "v_add_f32_dpp %2, %2, %2 row_half_mirror row_mask:0xf bank_mask:0xf\n\t"
                 "v_add_f32_dpp %3, %3, %3 row_half_mirror row_mask:0xf bank_mask:0xf"
                 : "+v"(a), "+v"(b), "+v"(c), "+v"(d));
}
#define SC_BARRIER() do { asm volatile("s_waitcnt lgkmcnt(0)" ::: "memory"); __builtin_amdgcn_s_barrier(); asm volatile("" ::: "memory"); } while (0)
__device__ __forceinline__ void scan_phase(const Params& p, unsigned char* ws, LAS unsigned char* lds, int tid, int lane, int wave, int bid, int nb) {
    const float* k_k = pin(p, 25); const float* k_a = pin(p, 26); const float* r_k = pin(p, 27);
    for (int chain = bid; chain < 256; chain += nb) {
        const int d = chain & 1, hh = (chain >> 1) & 31, b = chain >> 6;
        const unsigned short* Rg = (const unsigned short*)(ws + O_R);
        const unsigned short* Kg = (const unsigned short*)(ws + O_K);
        const unsigned short* Vg = (const unsigned short*)(ws + O_V);
        unsigned short* Eg = (unsigned short*)(ws + (d ? O_E1 : O_E0));
        const unsigned short* Ag = (const unsigned short*)(ws + (d ? O_A1 : O_A0));
        float* BSg = (float*)(ws + O_BS) + (size_t)d * M_ * NH_;
        __syncthreads();
        if (wave >= 4) {
            const int lid = tid - 256, s = lid >> 3, j0 = 8 * (lid & 7), ch = hh * 64 + j0;
            float kkc[8], kac[8], rkc[8];
#pragma unroll
            for (int i = 0; i < 8; ++i) { kkc[i] = k_k[ch + i]; kac[i] = k_a[ch + i]; rkc[i] = r_k[ch + i]; }
            if (lid < 32) ((LAS unsigned*)(lds + SC_ZERO))[lid] = 0u;
            h8 r8, k8, v8, e8, a8;
            { const int t = d ? (S_ - 1 - s) : s; const size_t off = ((size_t)b * S_ + t) * D_ + ch;
              r8 = *(const GAS h8*)(Rg + off); k8 = *(const GAS h8*)(Kg + off); v8 = *(const GAS h8*)(Vg + off); e8 = *(const GAS h8*)(Eg + off); a8 = *(const GAS h8*)(Ag + off); }
            for (int ci = -1; ci < S_ / SC_T; ++ci) {
                if (ci >= 1) {
                    const int cj = ci - 1; const int st = cj * SC_T + s; const int t = d ? (S_ - 1 - st) : st;
                    const LAS unsigned char* fb = lds + (cj & 1) * SC_BUF;
                    const LAS float* yb = (const LAS float*)(fb + SC_Y) + s * 64 + j0; const LAS float* ab = (const LAS float*)(fb + SC_A) + s * 64 + j0; const LAS float* vv = (const LAS float*)(fb + SC_V) + s * 64 + j0;
                    const f32x2 bk2 = *(const LAS f32x2*)((const LAS float*)(fb + SC_SC) + s * 2);
                    const f32x4 y0 = *(const LAS f32x4*)yb + *(const LAS f32x4*)ab * bk2.x + *(const LAS f32x4*)vv * bk2.y, y1 = *(const LAS f32x4*)(yb + 4) + *(const LAS f32x4*)(ab + 4) * bk2.x + *(const LAS f32x4*)(vv + 4) * bk2.y;
                    u32x4 w; w.x = cvt_pk_bf16(y0.x, y0.y); w.y = cvt_pk_bf16(y0.z, y0.w); w.z = cvt_pk_bf16(y1.x, y1.y); w.w = cvt_pk_bf16(y1.z, y1.w);
                    *(GAS u32x4*)(Eg + ((size_t)b * S_ + t) * D_ + ch) = w;
                }
                if (ci + 1 < S_ / SC_T) {
                    const int cj = ci + 1; const int st = cj * SC_T + s; const int t = d ? (S_ - 1 - st) : st;
                    const size_t m = (size_t)b * S_ + t;
                    h8 r8n = r8, k8n = k8, v8n = v8, e8n = e8, a8n = a8;
                    if (cj + 1 < S_ / SC_T) {
                        const int st2 = (cj + 1) * SC_T + s; const int t2 = d ? (S_ - 1 - st2) : st2; const size_t off2 = ((size_t)b * S_ + t2) * D_ + ch;
                        r8n = *(const GAS h8*)(Rg + off2); k8n = *(const GAS h8*)(Kg + off2); v8n = *(const GAS h8*)(Vg + off2); e8n = *(const GAS h8*)(Eg + off2); a8n = *(const GAS h8*)(Ag + off2);
                    }
                    float kk[8], ss = 0.f;
#pragma unroll
                    for (int i = 0; i < 8; ++i) { kk[i] = (float)k8[i] * kkc[i]; ss += kk[i] * kk[i]; }
                    ss = red8(ss);
                    const float inv = fminf(__builtin_amdgcn_rsqf(ss), 1e12f);
                    float av[8], wv[8], bb[8], kd[8], wrr[8], br = 0.f, kr = 0.f, bsum = 0.f;
#pragma unroll
                    for (int i = 0; i < 8; ++i) {
                        const float rr = (float)r8[i], kf = (float)k8[i], af = (float)a8[i];
                        kk[i] *= inv; av[i] = -kk[i]; wv[i] = __expf(-(float)e8[i]); bb[i] = kk[i] * af; kd[i] = kf * (1.f + (af - 1.f) * kac[i]); wrr[i] = wv[i] * rr;
                        br += bb[i] * rr; kr += kd[i] * rr; bsum += rr * kd[i] * rkc[i];
                    }
                    br = red8(br); kr = red8(kr); bsum = red8(bsum);
                    LAS unsigned char* buf = lds + (cj & 1) * SC_BUF;
                    *(LAS u32x4*)((LAS unsigned*)(buf + SC_AV) + s * 32 + (j0 >> 1)) = (u32x4){pk_h2(av[0], av[1]), pk_h2(av[2], av[3]), pk_h2(av[4], av[5]), pk_h2(av[6], av[7])};
                    *(LAS u32x4*)((LAS unsigned*)(buf + SC_WR) + s * 32 + (j0 >> 1)) = (u32x4){pk_h2(wrr[0], wrr[1]), pk_h2(wrr[2], wrr[3]), pk_h2(wrr[4], wrr[5]), pk_h2(wrr[6], wrr[7])};
                    { LAS float* wp = (LAS float*)(buf + SC_W) + s * 64 + j0;
                      *(LAS f32x4*)wp = (f32x4){wv[0], wv[1], wv[2], wv[3]}; *(LAS f32x4*)(wp + 4) = (f32x4){wv[4], wv[5], wv[6], wv[7]}; }
                    LAS unsigned* bkp = (LAS unsigned*)(buf + SC_BK) + s * 64 + j0;
                    *(LAS u32x4*)bkp = (u32x4){pk_h2(bb[0], kd[0]), pk_h2(bb[1], kd[1]), pk_h2(bb[2], kd[2]), pk_h2(bb[3], kd[3])};
                    *(LAS u32x4*)(bkp + 4) = (u32x4){pk_h2(bb[4], kd[4]), pk_h2(bb[5], kd[5]), pk_h2(bb[6], kd[6]), pk_h2(bb[7], kd[7])};
                    LAS float* vb = (LAS float*)(buf + SC_V) + s * 64 + j0;
                    *(LAS f32x4*)vb = (f32x4){(float)v8[0], (float)v8[1], (float)v8[2], (float)v8[3]}; *(LAS f32x4*)(vb + 4) = (f32x4){(float)v8[4], (float)v8[5], (float)v8[6], (float)v8[7]};
                    if ((lid & 7) == 0) { *(LAS f32x2*)((LAS float*)(buf + SC_SC) + s * 2) = (f32x2){br, kr}; *(GAS float*)(BSg + m * NH_ + hh) = bsum; }
                    r8 = r8n; k8 = k8n; v8 = v8n; e8 = e8n; a8 = a8n;
                }
                SC_BARRIER();
            }
            {
                const int cj = S_ / SC_T - 1; const int st = cj * SC_T + s; const int t = d ? (S_ - 1 - st) : st;
                const LAS unsigned char* fb = lds + (cj & 1) * SC_BUF;
                const LAS float* yb = (const LAS float*)(fb + SC_Y) + s * 64 + j0; const LAS float* ab = (const LAS float*)(fb + SC_A) + s * 64 + j0; const LAS float* vv = (const LAS float*)(fb + SC_V) + s * 64 + j0;
                const f32x2 bk2 = *(const LAS f32x2*)((const LAS float*)(fb + SC_SC) + s * 2);
                const f32x4 y0 = *(const LAS f32x4*)yb + *(const LAS f32x4*)ab * bk2.x + *(const LAS f32x4*)vv * bk2.y, y1 = *(const LAS f32x4*)(yb + 4) + *(const LAS f32x4*)(ab + 4) * bk2.x + *(const LAS f32x4*)(vv + 4) * bk2.y;
                u32x4 w; w.x = cvt_pk_bf16(y0.x, y0.y); w.y = cvt_pk_bf16(y0.z, y0.w); w.z = cvt_pk_bf16(y1.x, y1.y); w.w = cvt_pk_bf16(y1.z, y1.w);
                *(GAS u32x4*)(Eg + ((size_t)b * S_ + t) * D_ + ch) = w;
            }
        } else {
            const int rl = lane & 15, g = lane >> 4, row = 16 * wave + rl, m4 = rl & 3;
            f32x2 S[8];
#pragma unroll
            for (int q = 0; q < 8; ++q) S[q] = (f32x2){0.f, 0.f};
            SC_BARRIER();
            for (int ci = 0; ci < S_ / SC_T; ++ci) {
                const LAS unsigned char* buf = lds + (ci & 1) * SC_BUF;
                const LAS unsigned char* xb = (m4 == 0 ? buf + SC_AV : (m4 == 1 ? buf + SC_WR : lds + SC_ZERO)) + 16 * g;
                const int xs = m4 < 2 ? 128 : 0;
                const LAS float* wb = (const LAS float*)(buf + SC_W) + 8 * g;
                const LAS unsigned* bkb = (const LAS unsigned*)(buf + SC_BK) + 8 * g;
                const LAS float* vb = (const LAS float*)(buf + SC_V) + row;
                LAS float* yb = (LAS float*)(lds + (ci & 1) * SC_BUF + SC_Y) + row;
#define SC_LOAD(P, s) do { \
                    P##x1 = *(const LAS h8*)(xb + (s) * xs); P##x2 = *(const LAS h8*)(xb + (s) * xs + 64); \
                    P##w0 = *(const LAS f32x4*)(wb + (s) * 64); P##w1 = *(const LAS f32x4*)(wb + (s) * 64 + 4); P##w2 = *(const LAS f32x4*)(wb + (s) * 64 + 32); P##w3 = *(const LAS f32x4*)(wb + (s) * 64 + 36); \
                    P##k0 = *(const LAS u32x4*)(bkb + (s) * 64); P##k1 = *(const LAS u32x4*)(bkb + (s) * 64 + 4); P##k2 = *(const LAS u32x4*)(bkb + (s) * 64 + 32); P##k3 = *(const LAS u32x4*)(bkb + (s) * 64 + 36); \
                    P##v = *(vb + (s) * 64); } while (0)
#define SC_STEP(P, s) do { \
                    const u32x4 b1u = (u32x4){pk_h2(S[0].x, S[0].y), pk_h2(S[1].x, S[1].y), pk_h2(S[2].x, S[2].y), pk_h2(S[3].x, S[3].y)}; \
                    const u32x4 b2u = (u32x4){pk_h2(S[4].x, S[4].y), pk_h2(S[5].x, S[5].y), pk_h2(S[6].x, S[6].y), pk_h2(S[7].x, S[7].y)}; \
                    f32x4 acc = __builtin_amdgcn_mfma_f32_16x16x32_f16(P##x1, __builtin_bit_cast(h8, b1u), (f32x4){0.f, 0.f, 0.f, 0.f}, 0, 0, 0); \
                    acc = __builtin_amdgcn_mfma_f32_16x16x32_f16(P##x2, __builtin_bit_cast(h8, b2u), acc, 0, 0, 0); \
                    f32x2 t; \
                    const f32x2 t0 = S[0] * P##w0.xy, t1 = S[1] * P##w0.zw, t2 = S[2] * P##w1.xy, t3 = S[3] * P##w1.zw, t4 = S[4] * P##w2.xy, t5 = S[5] * P##w2.zw, t6 = S[6] * P##w3.xy, t7 = S[7] * P##w3.zw; \
                    const unsigned hh0 = pk_h2(acc[0], P##v); \
                    S[0].x = dot2h(hh0, P##k0.x, t0.x); S[0].y = dot2h(hh0, P##k0.y, t0.y); S[1].x = dot2h(hh0, P##k0.z, t1.x); S[1].y = dot2h(hh0, P##k0.w, t1.y); \
                    S[2].x = dot2h(hh0, P##k1.x, t2.x); S[2].y = dot2h(hh0, P##k1.y, t2.y); S[3].x = dot2h(hh0, P##k1.z, t3.x); S[3].y = dot2h(hh0, P##k1.w, t3.y); \
                    S[4].x = dot2h(hh0, P##k2.x, t4.x); S[4].y = dot2h(hh0, P##k2.y, t4.y); S[5].x = dot2h(hh0, P##k2.z, t5.x); S[5].y = dot2h(hh0, P##k2.w, t5.y); \
                    S[6].x = dot2h(hh0, P##k3.x, t6.x); S[6].y = dot2h(hh0, P##k3.y, t6.y); S[7].x = dot2h(hh0, P##k3.z, t7.x); S[7].y = dot2h(hh0, P##k3.w, t7.y); \
                    (void)t; if (g == 0) { *(yb + (s) * 64) = acc[1]; *(yb + (s) * 64 + SC_T * 64) = acc[0]; } } while (0)
                h8 Ax1, Ax2, Bx1, Bx2; f32x4 Aw0, Aw1, Aw2, Aw3, Bw0, Bw1, Bw2, Bw3; u32x4 Ak0, Ak1, Ak2, Ak3, Bk0, Bk1, Bk2, Bk3; float Av, Bv;
                SC_LOAD(A, 0);
                for (int s = 0; s < SC_T; s += 2) {
                    SC_LOAD(B, s + 1);
                    __builtin_amdgcn_sched_barrier(0);
                    SC_STEP(A, s);
                    __builtin_amdgcn_sched_barrier(0);
                    SC_LOAD(A, s + 2);
                    __builtin_amdgcn_sched_barrier(0);
                    SC_STEP(B, s + 1);
                    __builtin_amdgcn_sched_barrier(0);
                }
#undef SC_LOAD
#undef SC_STEP
                SC_BARRIER();
            }
        }
    }
}

__device__ __forceinline__ void post_phase(const Params& p, unsigned char* ws, int lane, int gw, int NGW) {
    const float* lnw = pin(p, 28); const float* lnb = pin(p, 29);
    const unsigned short* Y0 = (const unsigned short*)(ws + O_E0); const unsigned short* Y1 = (const unsigned short*)(ws + O_E1);
    const unsigned short* Vg = (const unsigned short*)(ws + O_V); const unsigned short* Gg = (const unsigned short*)(ws + O_G);
    const float* BS = (const float*)(ws + O_BS);
    unsigned short* P = (unsigned short*)(ws + O_POST);
    for (int m = gw; m < M_; m += NGW) {
#pragma unroll
        for (int j = 0; j < 4; ++j) {
            const int ch0 = 8 * (lane + 64 * j), head = ch0 >> 6;
            const size_t off = (size_t)m * D_ + ch0;
            const u32x4 a = *(const u32x4*)(Y0 + off), bq = *(const u32x4*)(Y1 + off);
            float ys[8];
            ys[0] = bf_lo(a.x) + bf_lo(bq.x); ys[1] = bf_hi(a.x) + bf_hi(bq.x); ys[2] = bf_lo(a.y) + bf_lo(bq.y); ys[3] = bf_hi(a.y) + bf_hi(bq.y);
            ys[4] = bf_lo(a.z) + bf_lo(bq.z); ys[5] = bf_hi(a.z) + bf_hi(bq.z); ys[6] = bf_lo(a.w) + bf_lo(bq.w); ys[7] = bf_hi(a.w) + bf_hi(bq.w);
            float s = 0.f;
#pragma unroll
            for (int i = 0; i < 8; ++i) s += ys[i];
            const float mean = red8(s) * (1.f / 64.f);
            float s2 = 0.f;
#pragma unroll
            for (int i = 0; i < 8; ++i) { ys[i] -= mean; s2 += ys[i] * ys[i]; }
            const float rs = rsqrtf(red8(s2) * (1.f / 64.f) + 64e-5f);
            const h8 v8 = *(const GAS h8*)(Vg + off), g8 = *(const h8*)(Gg + off);
            const f32x4 w0 = *(const f32x4*)(lnw + ch0), w1 = *(const f32x4*)(lnw + ch0 + 4), b0 = *(const f32x4*)(lnb + ch0), b1 = *(const f32x4*)(lnb + ch0 + 4);
            const float bsum = BS[(size_t)m * NH_ + head] + BS[(size_t)M_ * NH_ + (size_t)m * NH_ + head];
            float o[8];
#pragma unroll
            for (int i = 0; i < 8; ++i) {
                const float lw = i < 4 ? w0[i] : w1[i - 4], lb = i < 4 ? b0[i] : b1[i - 4];
                o[i] = (ys[i] * rs * lw + lb + bsum * (float)v8[i]) * (float)g8[i];
            }
            u32x4 w; w.x = cvt_pk_bf16(o[0], o[1]); w.y = cvt_pk_bf16(o[2], o[3]); w.z = cvt_pk_bf16(o[4], o[5]); w.w = cvt_pk_bf16(o[6], o[7]);
            *(u32x4*)(P + off) = w;
        }
    }
}

__device__ __forceinline__ void ffn_g1(unsigned char* ws, LAS unsigned char* lds, int tid, int bid, int nb, size_t o_gu) {
    SchedSimple S; S.A = (const char*)(ws + O_XN); S.Bt = (const char*)(ws + o_gu); S.nM = 64; S.nN = 44; S.G = nb; S.c = bid; S.poolmode = 0; S.wgm = 8;
    S.tstepA = (size_t)256 * D_ * 2; S.tstepB = (size_t)256 * D_ * 2;
    EpiSwiGLU E; E.U = (bf16_t*)(ws + O_U);
    gemm_phase(lds, tid, D_, D_, D_, S, E);
}
__device__ __forceinline__ void gemm_resid(unsigned char* ws, float* hout, LAS unsigned char* lds, int tid, int bid, int nb, size_t o_a, int lda, size_t o_bt, int K, int poolmode, const float* src, const float* colscale, float scale) {
    SchedSimple S; S.A = (const char*)(ws + o_a); S.Bt = (const char*)(ws + o_bt); S.nM = 64; S.nN = 8; S.G = nb; S.c = bid; S.poolmode = poolmode; S.wgm = 4;
    S.tstepA = (size_t)256 * lda * 2; S.tstepB = (size_t)256 * K * 2;
    EpiResid E; E.src = src; E.dst = hout; E.colscale = colscale; E.scale = scale;
    gemm_phase(lds, tid, K, lda, K, S, E);
}

__global__ void __launch_bounds__(512) mega(Params p) {
    extern __shared__ __attribute__((aligned(16))) unsigned char smem[];
    LAS unsigned char* lds = (LAS unsigned char*)smem;
    cg::grid_group grid = cg::this_grid();
    XcdBarrier xb;
    {
        volatile LAS unsigned* st = (volatile LAS unsigned*)(lds + 131072);
        if (threadIdx.x == 0) { st[0] = 0u; st[1] = 0u; }
        __syncthreads();
        xb.bar = (unsigned*)(p.ws + O_BAR); xb.x = xb_xcc_id(); xb.st = st;
        if (threadIdx.x == 0) (void)xb_add(&xb.bar[XB_XCNT(xb.x)], 1u);
    }
    constexpr int nb = 256;
    const int wid_s = __builtin_amdgcn_readfirstlane((int)(threadIdx.x >> 6));
#define PROLOG int m1_ = -1; asm volatile("" : "+s"(m1_)); int tid = wid_s * 64 + (int)__builtin_amdgcn_mbcnt_hi(m1_, __builtin_amdgcn_mbcnt_lo(m1_, 0)); int bid = blockIdx.x; asm volatile("" : "+s"(bid)); \
        const int lane = tid & 63, wave = tid >> 6; const int gw = bid * 8 + wave, NGW = nb * 8; LAS float* scr = (LAS float*)(lds + wave * 8704); \
        unsigned char* ws = p.ws; asm volatile("" : "+s"(ws)); float* h = p.out; asm volatile("" : "+s"(h)); (void)lane; (void)gw; (void)NGW; (void)scr; (void)h; (void)ws;
    for (int ph = p.ph_lo; ph < p.ph_hi; ++ph) {
#if REP_MASK
      const int nrep = ((REP_MASK >> ph) & 1) + 1;
      for (int rep = 0; rep < nrep; ++rep) {
        const float rsc = (rep == nrep - 1) ? 1.f : 0.f;
        if (rep) grid.sync();
#else
      { constexpr float rsc = 1.f;
#endif
        switch (ph) {
        case 0: { PROLOG
            norm_phase<false>(pin(p, 0), pin(p, 1), (bf16_t*)(ws + O_XN), nullptr, lane, gw, NGW);
            conv_ffn(pin(p, 2), pin(p, 3), pin(p, 4), (bf16_t*)(ws + O_AGU), (bf16_t*)(ws + O_AD), scr, lane, gw, NGW);
            conv_ffn(pin(p, 7), pin(p, 8), pin(p, 9), (bf16_t*)(ws + O_BGU), (bf16_t*)(ws + O_BD), scr, lane, gw, NGW);
            conv_rwkv(p, ws, scr, lane, gw, NGW);
        } break;
        case 1: { PROLOG
            ffn_g1(ws, lds, tid, bid, nb, O_AGU);
        } break;
        case 2: { PROLOG
            gemm_resid(ws, h, lds, tid, bid, nb, O_U, F_, O_AD, F_, 0, pin(p, 0), nullptr, 0.5f * rsc);
        } break;
        case 3: { PROLOG
            pool_prep_phase(h, pin(p, 5), (bf16_t*)(ws + O_XN), lds, tid, lane, wave, bid, nb);
            __syncthreads();
            conv_ffn(pin(p, 2) + (size_t)D_ * F_, pin(p, 3) + (size_t)D_ * F_, pin(p, 4) + (size_t)D_ * F_, (bf16_t*)(ws + O_AGU), (bf16_t*)(ws + O_AD), scr, lane, gw, NGW);
        } break;
        case 4: { PROLOG
            gemm_resid(ws, h, lds, tid, bid, nb, O_XN, D_, O_POOLT, 512, 1, h, pin(p, 11), 1.f * rsc);
        } break;
        case 5: { PROLOG
            norm_phase<false>(h, pin(p, 6), (bf16_t*)(ws + O_XN), nullptr, lane, gw, NGW);
        } break;
        case 6: { PROLOG
            ffn_g1(ws, lds, tid, bid, nb, O_BGU);
        } break;
        case 7: { PROLOG
            gemm_resid(ws, h, lds, tid, bid, nb, O_U, F_, O_BD, F_, 0, h, nullptr, 0.5f * rsc);
        } break;
        case 8: { PROLOG
            norm_phase<false>(h, pin(p, 1) + D_, (bf16_t*)(ws + O_XN), nullptr, lane, gw, NGW);
        } break;
        case 9: { PROLOG
            ffn_g1(ws, lds, tid, bid, nb, O_AGU);
        } break;
        case 10: { PROLOG
            gemm_resid(ws, h, lds, tid, bid, nb, O_U, F_, O_AD, F_, 0, h, nullptr, 0.5f * rsc);
        } break;
        case 11: { PROLOG
            rwkv_prep_phase(h, pin(p, 5) + D_, pin(p, 12), (bf16_t*)(ws + O_X6), lane, gw, NGW);
        } break;
        case 12: { PROLOG
            {
            SchedProj S; S.ws = (const char*)ws; S.G = nb; S.c = bid;
            EpiProj E; E.ws = ws;
            gemm_phase(lds, tid, D_, D_, D_, S, E);
        }
        } break;
        case 13: { PROLOG
            {
            SchedLora2 S; S.ws = (const char*)ws; S.G = nb; S.c = bid;
            EpiLora2 E; E.ws = ws; E.w0 = pin(p, 17); E.a0 = pin(p, 20);
            gemm_phase(lds, tid, 256, 256, 256, S, E);
        }
        } break;
        case 14: { PROLOG
            scan_phase(p, ws, lds, tid, lane, wave, bid, nb);
        } break;
        case 15: { PROLOG
            post_phase(p, ws, lane, gw, NGW);
        } break;
        case 16: { PROLOG
            gemm_resid(ws, h, lds, tid, bid, nb, O_POST, D_, O_WOT, D_, 0, h, nullptr, 1.f * rsc);
        } break;
        case 17: { PROLOG
            norm_phase<false>(h, pin(p, 6) + D_, (bf16_t*)(ws + O_XN), nullptr, lane, gw, NGW);
            conv_ffn(pin(p, 7) + (size_t)D_ * F_, pin(p, 8) + (size_t)D_ * F_, pin(p, 9) + (size_t)D_ * F_, (bf16_t*)(ws + O_BGU), (bf16_t*)(ws + O_BD), scr, lane, gw, NGW);
        } break;
        case 18: { PROLOG
            ffn_g1(ws, lds, tid, bid, nb, O_BGU);
        } break;
        case 19: { PROLOG
            gemm_resid(ws, h, lds, tid, bid, nb, O_U, F_, O_BD, F_, 0, h, nullptr, 0.5f * rsc);
        } break;
        case 20: { PROLOG
            norm_phase<true>(h, pin(p, 30), nullptr, h, lane, gw, NGW);
        } break;
        default: break;
        }
      }
        if (ph + 1 < p.ph_hi) {
            if (p.ph_lo < 0) grid.sync();
            xcd_barrier(xb, threadIdx.x == 0);
        }
    }
}

extern "C" void kernel_launch(void* const* d_in, const int* in_sizes, int n_in, void* d_out, int out_size, void* d_ws, size_t ws_size, hipStream_t stream) {
    static int grid_blocks = 0;
    if (grid_blocks == 0) {
        if (n_in != 31 || out_size != M_ * D_ || ws_size < WS_NEED) { fprintf(stderr, "kernel_launch: unexpected shapes (n_in %d out %d ws %zu)\n", n_in, out_size, ws_size); grid_blocks = -1; return; }
        int dev = 0, cus = 0, per_cu = 0;
        hipGetDevice(&dev);
        hipDeviceGetAttribute(&cus, hipDeviceAttributeMultiprocessorCount, dev);
        if (hipFuncSetAttribute((const void*)mega, hipFuncAttributeMaxDynamicSharedMemorySize, LDS_BYTES) != hipSuccess) { fprintf(stderr, "kernel_launch: hipFuncSetAttribute failed\n"); grid_blocks = -1; return; }
        hipOccupancyMaxActiveBlocksPerMultiprocessor(&per_cu, (const void*)mega, 512, LDS_BYTES);
        if (per_cu < 1) per_cu = 1;
        if (cus * per_cu < 256) { fprintf(stderr, "kernel_launch: device holds only %d co-resident workgroups, 256 needed\n", cus * per_cu); grid_blocks = -1; (void)hipGetLastError(); return; }
        grid_blocks = 256;
        (void)hipGetLastError();
    }
    if (grid_blocks < 0) return;
    Params p{};
    for (int i = 0; i < 31; ++i) p.in[i] = (const float*)d_in[i];
    p.out = (float*)d_out; p.ws = (unsigned char*)d_ws;
#if MK_SINGLE
    (void)hipMemsetAsync((unsigned char*)d_ws + O_BAR, 0, XCD_BAR_WORDS * 4, stream);
    p.ph_lo = 0; p.ph_hi = NPHASE;
    void* args[] = {&p};
    hipError_t e = hipLaunchCooperativeKernel((const void*)mega, dim3(grid_blocks), dim3(512), args, LDS_BYTES, stream);
    if (e != hipSuccess) fprintf(stderr, "cooperative launch failed: %s (grid %d)\n", hipGetErrorString(e), grid_blocks);
#else
    for (int ph = 0; ph < NPHASE; ++ph) {
        p.ph_lo = ph; p.ph_hi = ph + 1;
        hipLaunchKernelGGL(mega, dim3(grid_blocks), dim3(512), LDS_BYTES, stream, p);
    }
#endif
}
```

```cpp
#include <hip/hip_runtime.h>
#include <hip/hip_cooperative_groups.h>
#include <cstdio>
namespace cg = cooperative_groups;

#ifndef REP_MASK
#define REP_MASK 0
#endif
#ifndef MK_SINGLE
#define MK_SINGLE 1
#endif

#define LAS __attribute__((address_space(3)))
typedef unsigned short bf16_t;
typedef short bf16x8 __attribute__((ext_vector_type(8)));
typedef float f32x4 __attribute__((ext_vector_type(4)));
typedef float f32x2 __attribute__((ext_vector_type(2)));
typedef unsigned u32x4 __attribute__((ext_vector_type(4)));
typedef unsigned u32x2 __attribute__((ext_vector_type(2)));
typedef _Float16 h8 __attribute__((ext_vector_type(8)));

constexpr int M_ = 16384, D_ = 2048, F_ = 5632, S_ = 4096, NH_ = 32;
constexpr int NPHASE = 21;
constexpr int LDS_BYTES = 131072 + 16;
constexpr size_t MiB = 1ull << 20;
constexpr size_t O_WRT = 0 * MiB, O_WKT = 8 * MiB, O_WVT = 16 * MiB, O_WOT = 24 * MiB, O_W1C = 32 * MiB, O_A1C = 33 * MiB, O_G1C = 34 * MiB;
constexpr size_t O_W2T0 = 35 * MiB, O_W2T1 = 36 * MiB, O_A2T0 = 37 * MiB, O_A2T1 = 38 * MiB, O_G2T = 39 * MiB, O_POOLT = 40 * MiB;
constexpr size_t O_BAR = 42 * MiB;
constexpr size_t O_XN = 70 * MiB;
constexpr size_t O_AGU = 134 * MiB, O_AD = 178 * MiB, O_BGU = 200 * MiB, O_BD = 244 * MiB;
constexpr size_t O_U = 266 * MiB;
constexpr size_t O_X6 = 70 * MiB;
constexpr size_t O_R = 454 * MiB, O_K = 518 * MiB, O_V = 582 * MiB, O_LW = 646 * MiB, O_LA = 654 * MiB, O_LG = 662 * MiB, O_BS = 670 * MiB;
constexpr size_t O_E0 = 70 * MiB, O_E1 = 134 * MiB, O_A0 = 198 * MiB, O_A1 = 262 * MiB, O_G = 326 * MiB, O_POST = 390 * MiB;
constexpr size_t WS_NEED = 674 * MiB;

struct Params {
    const float* in[31];
    float* out;
    unsigned char* ws;
    int ph_lo, ph_hi;
};

__device__ __forceinline__ const float* pin(const Params& p, int i) { asm volatile("" : "+s"(i)); return p.in[i]; }
__device__ __forceinline__ unsigned cvt_pk_bf16(float lo, float hi) { unsigned r; asm volatile("v_cvt_pk_bf16_f32 %0, %1, %2" : "=v"(r) : "v"(lo), "v"(hi)); return r; }
__device__ __forceinline__ unsigned pk_h2(float a, float b) { auto h = __builtin_amdgcn_cvt_pkrtz(a, b); return __builtin_bit_cast(unsigned, h); }
__device__ __forceinline__ float bf_lo(unsigned w) { return __builtin_bit_cast(float, w << 16); }
__device__ __forceinline__ float bf_hi(unsigned w) { return __builtin_bit_cast(float, w & 0xffff0000u); }
template <int CTRL> __device__ __forceinline__ float dpp_f(float v) {
    return __builtin_bit_cast(float, __builtin_amdgcn_update_dpp(0, __builtin_bit_cast(int, v), CTRL, 0xF, 0xF, true));
}
__device__ __forceinline__ float red8(float v) { v += dpp_f<0xB1>(v); v += dpp_f<0x4E>(v); v += dpp_f<0x141>(v); return v; }
__device__ __forceinline__ float wave_sum(float v) {
    v += dpp_f<0xB1>(v); v += dpp_f<0x4E>(v); v += dpp_f<0x141>(v); v += dpp_f<0x140>(v);
    const int iv = __builtin_bit_cast(int, v);
    const float r0 = __builtin_bit_cast(float, __builtin_amdgcn_readlane(iv, 0)), r1 = __builtin_bit_cast(float, __builtin_amdgcn_readlane(iv, 16));
    const float r2 = __builtin_bit_cast(float, __builtin_amdgcn_readlane(iv, 32)), r3 = __builtin_bit_cast(float, __builtin_amdgcn_readlane(iv, 48));
    return (r0 + r1) + (r2 + r3);
}
__device__ __forceinline__ float sigmoidf_(float x) { return __builtin_amdgcn_rcpf(1.f + __expf(-x)); }
#define LDS_WAIT() asm volatile("s_waitcnt lgkmcnt(0)" ::: "memory")


#define XB_TMO      128
#define XB_XCNT(j)  (256  + 64 * (j))
#define XB_XSUB(j)  (1280 + 64 * (j))
#define XB_XGEN(j)  (2304 + 64 * (j))
#define XB_TOP      3328
#define XB_TOPGEN   3392
#define XCD_BAR_WORDS 3456
#define XB_SPIN_CAP (1u << 18)
__device__ __forceinline__ unsigned xb_ld(unsigned* p)              { return __hip_atomic_load(p, __ATOMIC_RELAXED, __HIP_MEMORY_SCOPE_AGENT); }
__device__ __forceinline__ unsigned xb_add(unsigned* p, unsigned v) { return __hip_atomic_fetch_add(p, v, __ATOMIC_RELAXED, __HIP_MEMORY_SCOPE_AGENT); }
__device__ __forceinline__ unsigned xb_xcc_id() { return (unsigned)__builtin_amdgcn_s_getreg((3 << 11) | 20) & 0xFu; }
#define XB_SPIN(cond, bar) do { unsigned _sp = 0; while (cond) { __builtin_amdgcn_s_sleep(1); \
    if ((++_sp & 255u) == 0u) { if (xb_ld(&(bar)[XB_TMO])) break; if (_sp > XB_SPIN_CAP) { atomicAdd(&(bar)[XB_TMO], 1u); break; } } } } while (0)
struct XcdBarrier { unsigned* bar; unsigned x; volatile LAS unsigned* st; };
__device__ __forceinline__ void xcd_barrier_complete(unsigned* bar, unsigned x, unsigned& nloc, unsigned& nx) {
    const unsigned G = gridDim.x;
    unsigned sum, cnt, mine, sp = 0u;
    for (;;) {
        sum = 0u; cnt = 0u; mine = 0u;
#pragma unroll
        for (unsigned j = 0; j < 16; ++j) { const unsigned c = xb_ld(&bar[XB_XCNT(j)]); sum += c; cnt += (c > 0u) ? 1u : 0u; mine = (j == x) ? c : mine; }
        if (sum == G) break;
        __builtin_amdgcn_s_sleep(1);
        if ((++sp & 255u) == 0u) { if (xb_ld(&bar[XB_TMO])) break; if (sp > XB_SPIN_CAP) { atomicAdd(&bar[XB_TMO], 1u); break; } }
    }
    nloc = mine > 0u ? mine : 1u; nx = cnt > 0u ? cnt : 1u;
}
__device__ __forceinline__ void xcd_barrier(const XcdBarrier& b, bool leader_thread) {
    asm volatile("s_waitcnt vmcnt(0)" ::: "memory");
    __syncthreads();
    if (leader_thread) {
        unsigned* bar = b.bar;
        __builtin_amdgcn_s_waitcnt(0);
        unsigned nloc = b.st[0], nx = b.st[1];
        if (nloc == 0u) { xcd_barrier_complete(bar, b.x, nloc, nx); b.st[0] = nloc; b.st[1] = nx; }
        const unsigned old = xb_add(&bar[XB_XSUB(b.x)], 1u);
        const unsigned gen = old / nloc;
        if (old + 1u == (gen + 1u) * nloc) {
            __builtin_amdgcn_fence(__ATOMIC_RELEASE, "agent");
            asm volatile("s_waitcnt vmcnt(0)" ::: "memory");
            const unsigned og = xb_add(&bar[XB_TOP], 1u);
            const unsigned tg = og / nx;
            if (og + 1u == (tg + 1u) * nx) xb_add(&bar[XB_TOPGEN], 1u);
            else XB_SPIN(xb_ld(&bar[XB_TOPGEN]) == tg, bar);
            __builtin_amdgcn_fence(__ATOMIC_ACQUIRE, "agent");
            xb_add(&bar[XB_XGEN(b.x)], 1u);
            asm volatile("s_waitcnt vmcnt(0)" ::: "memory");
        } else {
            XB_SPIN(xb_ld(&bar[XB_XGEN(b.x)]) == gen, bar);
            __builtin_amdgcn_fence(__ATOMIC_ACQUIRE, "agent");
            asm volatile("s_waitcnt vmcnt(0)" ::: "memory");
        }
    }
    __syncthreads();
}

__device__ __forceinline__ void tr_load(const float* src, int N, int k0, int n0, float (&v)[32], int lane) {
#pragma unroll
    for (int i = 0; i < 32; ++i) v[i] = src[(size_t)(k0 + 2 * i + (lane >> 5)) * N + n0 + (lane & 31)];
}
__device__ __forceinline__ void tr_store(const float (&v)[32], int k0, int n0, bf16_t* dst, int ldd, int mode, int row0, int col0, const float* scale, LAS float* scr, int lane) {
#pragma unroll
    for (int i = 0; i < 32; ++i) {
        const int kk = 2 * i + (lane >> 5);
        float x = v[i];
        if (scale) x *= scale[k0 + kk];
        scr[kk * 33 + (lane & 31)] = x;
    }
    LDS_WAIT();
    const int c = lane & 7;
#pragma unroll
    for (int j = 0; j < 4; ++j) {
        const int n = (lane >> 3) + 8 * j; const LAS float* s = scr + (8 * c) * 33 + n;
        u32x4 o; o.x = cvt_pk_bf16(s[0 * 33], s[1 * 33]); o.y = cvt_pk_bf16(s[2 * 33], s[3 * 33]); o.z = cvt_pk_bf16(s[4 * 33], s[5 * 33]); o.w = cvt_pk_bf16(s[6 * 33], s[7 * 33]);
        const int ng = n0 + n;
        const int row = mode ? (256 * (ng >> 7) + row0 + (ng & 127)) : (row0 + ng);
        *(u32x4*)(dst + (size_t)row * ldd + col0 + k0 + 8 * c) = o;
    }
    LDS_WAIT();
}
__device__ __forceinline__ void tr_mat(const float* src, int K, int N, bf16_t* dst, int ldd, int mode, int row0, int col0, const float* scale, LAS float* scr, int lane, int gw, int NGW, int rot) {
    const int nblk = N / 32, items = (K / 64) * nblk;
    int it = gw - rot; while (it < 0) it += NGW;
    float va[32], vb[32];
    if (it < items) tr_load(src, N, 64 * (it / nblk), 32 * (it % nblk), va, lane);
    while (it < items) {
        const int nx = it + NGW;
        if (nx < items) tr_load(src, N, 64 * (nx / nblk), 32 * (nx % nblk), vb, lane);
        tr_store(va, 64 * (it / nblk), 32 * (it % nblk), dst, ldd, mode, row0, col0, scale, scr, lane);
#pragma unroll
        for (int i = 0; i < 32; ++i) va[i] = vb[i];
        it = nx;
    }
}
__device__ __forceinline__ void conv_ffn(const float* gate, const float* up, const float* down, bf16_t* gu, bf16_t* dn, LAS float* scr, int lane, int gw, int NGW) {
    tr_mat(gate, D_, F_, gu, D_, 1, 0, 0, nullptr, scr, lane, gw, NGW, 0);
    tr_mat(up, D_, F_, gu, D_, 1, 128, 0, nullptr, scr, lane, gw, NGW, 5632);
    tr_mat(down, F_, D_, dn, F_, 0, 0, 0, nullptr, scr, lane, gw, NGW, 11264);
}
__device__ __forceinline__ void conv_rwkv(const Params& p, unsigned char* ws, LAS float* scr, int lane, int gw, int NGW) {
    tr_mat(pin(p, 13), D_, D_, (bf16_t*)(ws + O_WRT), D_, 0, 0, 0, nullptr, scr, lane, gw, NGW, 0);
    tr_mat(pin(p, 14), D_, D_, (bf16_t*)(ws + O_WKT), D_, 0, 0, 0, nullptr, scr, lane, gw, NGW, 0);
    tr_mat(pin(p, 15), D_, D_, (bf16_t*)(ws + O_WVT), D_, 0, 0, 0, nullptr, scr, lane, gw, NGW, 0);
    tr_mat(pin(p, 16), D_, D_, (bf16_t*)(ws + O_WOT), D_, 0, 0, 0, nullptr, scr, lane, gw, NGW, 0);
    for (int d = 0; d < 2; ++d) {
        tr_mat(pin(p, 18) + (size_t)d * D_ * 96, D_, 96, (bf16_t*)(ws + O_W1C), D_, 0, d * 96, 0, nullptr, scr, lane, gw, NGW, d * 96);
        tr_mat(pin(p, 21) + (size_t)d * D_ * 96, D_, 96, (bf16_t*)(ws + O_A1C), D_, 0, d * 96, 0, nullptr, scr, lane, gw, NGW, 192 + d * 96);
    }
    tr_mat(pin(p, 23), D_, 256, (bf16_t*)(ws + O_G1C), D_, 0, 0, 0, nullptr, scr, lane, gw, NGW, 384);
    tr_mat(pin(p, 24), 256, D_, (bf16_t*)(ws + O_G2T), 256, 0, 0, 0, nullptr, scr, lane, gw, NGW, 1280);
    for (int g = 0; g < 4; ++g)
        tr_mat(pin(p, 10) + (size_t)g * 512 * 512, 512, 512, (bf16_t*)(ws + O_POOLT) + (size_t)g * 512 * 512, 512, 0, 0, 0, nullptr, scr, lane, gw, NGW, 1536 + g * 128);
    const int gt = gw * 64 + lane, NT = NGW * 64;
    for (int idx = gt; idx < 2 * 64 * 2048; idx += NT) {
        const int which = idx / (64 * 2048), r = idx % (64 * 2048);
        bf16_t* dst = (bf16_t*)(ws + (which ? O_A1C : O_W1C)) + (size_t)192 * 2048;
        dst[r] = 0;
    }
    for (int idx = gt; idx < 4 * 256 * 2048; idx += NT) {
        const int mat = idx / (256 * 2048), r = idx % (256 * 2048), kk = r / 2048, n = r % 2048;
        const int d = mat & 1; const bool isa = mat >= 2;
        const float* src = (isa ? pin(p, 22) : pin(p, 19)) + (size_t)d * 96 * D_;
        bf16_t* dst = (bf16_t*)(ws + (isa ? (d ? O_A2T1 : O_A2T0) : (d ? O_W2T1 : O_W2T0)));
        const int j = kk - d * 96;
        const float v = (j >= 0 && j < 96) ? src[(size_t)j * D_ + n] : 0.f;
        dst[(size_t)n * 256 + kk] = (bf16_t)(cvt_pk_bf16(v, 0.f) & 0xffffu);
    }
}

template <bool FINAL>
__device__ __forceinline__ void norm_phase(const float* src, const float* gain, bf16_t* dst, float* fdst, int lane, int gw, int NGW) {
    f32x4 gv[8];
#pragma unroll
    for (int j = 0; j < 8; ++j) gv[j] = ((const f32x4*)gain)[lane + 64 * j];
    for (int row = gw; row < M_; row += NGW) {
        const f32x4* xr = (const f32x4*)(src + (size_t)row * D_) + lane;
        f32x4 v[8]; float s = 0.f;
#pragma unroll
        for (int j = 0; j < 8; ++j) { v[j] = xr[64 * j]; s += (v[j].x * v[j].x + v[j].y * v[j].y) + (v[j].z * v[j].z + v[j].w * v[j].w); }
        const float rstd = rsqrtf(wave_sum(s) * (1.f / D_) + 1e-6f);
        if (FINAL) {
            f32x4* o = (f32x4*)(fdst + (size_t)row * D_) + lane;
#pragma unroll
            for (int j = 0; j < 8; ++j) o[64 * j] = v[j] * rstd * gv[j];
        } else {
            u32x2* o = (u32x2*)(dst + (size_t)row * D_) + lane;
#pragma unroll
            for (int j = 0; j < 8; ++j) { f32x4 t = v[j] * rstd * gv[j]; u32x2 w; w.x = cvt_pk_bf16(t.x, t.y); w.y = cvt_pk_bf16(t.z, t.w); o[64 * j] = w; }
        }
    }
}

__device__ __forceinline__ void load_norm_row(const float* src, int row, const f32x4 (&gv)[8], f32x4 (&o)[8], int lane) {
    const f32x4* xr = (const f32x4*)(src + (size_t)row * D_) + lane;
    float s = 0.f;
#pragma unroll
    for (int j = 0; j < 8; ++j) { o[j] = xr[64 * j]; s += (o[j].x * o[j].x + o[j].y * o[j].y) + (o[j].z * o[j].z + o[j].w * o[j].w); }
    const float rstd = rsqrtf(wave_sum(s) * (1.f / D_) + 1e-6f);
#pragma unroll
    for (int j = 0; j < 8; ++j) o[j] = o[j] * rstd * gv[j];
}
__device__ __forceinline__ void rwkv_prep_phase(const float* h, const float* gain, const float* mu, bf16_t* x6, int lane, int gw, int NGW) {
    f32x4 gv[8];
#pragma unroll
    for (int j = 0; j < 8; ++j) gv[j] = ((const f32x4*)gain)[lane + 64 * j];
    for (int run = gw; run < M_ / 8; run += NGW) {
        const int row0 = run * 8, t0 = row0 & (S_ - 1);
        f32x4 prev[8], cur[8], nxt[8];
        if (t0 > 0) load_norm_row(h, row0 - 1, gv, prev, lane);
        else {
#pragma unroll
            for (int j = 0; j < 8; ++j) prev[j] = (f32x4){0.f, 0.f, 0.f, 0.f};
        }
        load_norm_row(h, row0, gv, cur, lane);
        for (int i = 0; i < 8; ++i) {
            const int row = row0 + i, t = t0 + i;
            if (t + 1 < S_) load_norm_row(h, row + 1, gv, nxt, lane);
            else {
#pragma unroll
                for (int j = 0; j < 8; ++j) nxt[j] = (f32x4){0.f, 0.f, 0.f, 0.f};
            }
#pragma unroll
            for (int j = 0; j < 8; ++j) {
                const f32x4 xx = (prev[j] + nxt[j]) * 0.5f - cur[j];
#pragma unroll
                for (int q = 0; q < 6; ++q) {
                    const f32x4 m4 = ((const f32x4*)(mu + (size_t)q * D_))[lane + 64 * j];
                    const f32x4 xm = cur[j] + xx * m4;
                    u32x2 w; w.x = cvt_pk_bf16(xm.x, xm.y); w.y = cvt_pk_bf16(xm.z, xm.w);
                    ((u32x2*)(x6 + (size_t)q * M_ * D_ + (size_t)row * D_))[lane + 64 * j] = w;
                }
                prev[j] = cur[j]; cur[j] = nxt[j];
            }
        }
    }
}

__device__ __forceinline__ void pool_prep_phase(const float* h, const float* gain, bf16_t* outp, LAS unsigned char* lds, int tid, int lane, int wave, int bid, int nb) {
    LAS float* rs = (LAS float*)lds;
    for (int chunk = bid; chunk < M_ / 64; chunk += nb) {
        const int m0 = chunk * 64, b = m0 / S_, t0 = m0 % S_;
        __syncthreads();
        for (int rr = wave; rr < 80; rr += 8) {
            const int t = t0 - 8 + rr;
            if (t >= 0 && t < S_) {
                const f32x4* xr = (const f32x4*)(h + ((size_t)b * S_ + t) * D_) + lane;
                float s = 0.f;
#pragma unroll
                for (int j = 0; j < 8; ++j) { const f32x4 v = xr[64 * j]; s += (v.x * v.x + v.y * v.y) + (v.z * v.z + v.w * v.w); }
                s = wave_sum(s);
                if (lane == 0) rs[rr] = rsqrtf(s * (1.f / D_) + 1e-6f);
            }
        }
        __syncthreads();
        const int c = 4 * tid, g = tid >> 7, w = 2 << g, half = w >> 1;
        const f32x4 gn = *(const f32x4*)(gain + c);
        const float* hb = h + (size_t)b * S_ * D_ + c;
#define HN(t) ((*(const f32x4*)(hb + (size_t)(t) * D_)) * rs[(t) - t0 + 8] * gn)
        int lo = t0 - half; if (lo < 0) lo = 0;
        int hi = t0 + half; if (hi > S_) hi = S_;
        f32x4 sum = (f32x4){0.f, 0.f, 0.f, 0.f};
        for (int u = lo; u < hi; ++u) sum += HN(u);
#pragma unroll 8
        for (int i = 0; i < 64; ++i) {
            const int t = t0 + i;
            const f32x4 x = HN(t);
            const float inv = 1.f / (float)(hi - lo);
            const f32x4 o = sum * inv - x;
            u32x2 wv; wv.x = cvt_pk_bf16(o.x, o.y); wv.y = cvt_pk_bf16(o.z, o.w);
            *(u32x2*)(outp + ((size_t)b * S_ + t) * D_ + c) = wv;
            if (i < 63) {
                if (t + 1 - half > 0) { sum -= HN(lo); ++lo; }
                if (t + half < S_) { sum += HN(t + half); ++hi; }
            }
        }
#undef HN
    }
}

constexpr int BM = 256, BK = 64, HALF = 128, HTB = HALF * BK * 2;
__device__ __forceinline__ int lds_byte(int r, int c) { const int st = (r >> 4) * 2 + (c >> 5), rr = r & 15, cc = c & 31, ob = rr * 64 + cc * 2; return st * 1024 + (ob ^ (((ob >> 9) & 1) << 5)); }
__device__ __forceinline__ void stage_rc(int b, int& R, int& C) { const int st = b / 1024, sb = b % 1024, swz = sb ^ (((sb >> 9) & 1) << 5); R = (st >> 1) * 16 + swz / 64; C = (st & 1) * 32 + (swz % 64) / 2; }
__device__ __forceinline__ int perm32(int rho) { const int n = rho >> 4, i = rho & 15; return 8 * (i >> 2) + 4 * n + (i & 3); }

struct Unit { const char* a; const char* b; int pm, pn, job; };

__device__ __forceinline__ void remap_tile(int l, int nM, int nN, int& pm, int& pn, int wgm = 8) {
    const int nwg = nM * nN; int wgid = l;
    { const int q = nwg / 8, r = nwg % 8, xcd = wgid % 8, off = wgid / 8; wgid = (xcd < r ? xcd * (q + 1) : r * (q + 1) + (xcd - r) * q) + off; }
    const int nig = wgm * nN, gid = wgid / nig, fm = gid * wgm, gsz = (nM - fm) < wgm ? (nM - fm) : wgm;
    pm = fm + ((wgid % nig) % gsz); pn = (wgid % nig) / gsz;
}

template <class Epi, class Sched>
__device__ __forceinline__ void gemm_phase(LAS unsigned char* lds, const int tid, const int K, const int lda, const int ldb, const Sched& S, const Epi& E) {
    const int wid = __builtin_amdgcn_readfirstlane(tid >> 6), lane = tid & 63, wr = wid >> 2, wc = wid & 3, fr = lane & 15, fq = lane >> 4;
    const int nt = K / BK;
    unsigned voffA, voffB;
    { int R, C; stage_rc(tid * 16, R, C); const int Rb = Epi::PERM ? ((R & ~31) + perm32(R & 31)) : R;
        voffA = (unsigned)(R * lda + C) * 2u; voffB = (unsigned)(Rb * ldb + C) * 2u; }
    const size_t q64A = (size_t)64 * lda * 2, q64B = (size_t)64 * ldb * 2;
    const size_t kstep = (size_t)(BK * 2);
    const size_t hstepA = (size_t)HALF * lda * 2, hstepB = (size_t)HALF * ldb * 2;
    const unsigned ldsw = (unsigned)wid * 1024u;
    const int aoff = lds_byte(wr * 64 + fr, fq * 8), boff = lds_byte(wc * 32 + fr, fq * 8);
#define PG8_SA(b, h) (((b) * 2 + (h)) * HTB)
#define PG8_SB(b, h) ((4 + (b) * 2 + (h)) * HTB)
#define PG8_STAGE(bufoff, gbase, voff) do { \
        __builtin_amdgcn_global_load_lds((const unsigned*)((const char*)(gbase) + (voff)), (LAS unsigned*)(lds + (bufoff) + ldsw), 16, 0, 0); \
        __builtin_amdgcn_global_load_lds((const unsigned*)((const char*)(gbase) + q64_##voff + (voff)), (LAS unsigned*)(lds + (bufoff) + ldsw + 8192), 16, 0, 0); } while (0)
#define q64_voffA q64A
#define q64_voffB q64B
#define PG8_LDA(dst, b, h) do { _Pragma("unroll") for (int m = 0; m < 4; ++m) _Pragma("unroll") for (int k = 0; k < 2; ++k) dst[m][k] = *(const LAS bf16x8*)(lds + PG8_SA(b, h) + aoff + m * 2048 + k * 1024); } while (0)
#define PG8_LDB(dst, b, h) do { _Pragma("unroll") for (int n = 0; n < 2; ++n) _Pragma("unroll") for (int k = 0; k < 2; ++k) dst[n][k] = *(const LAS bf16x8*)(lds + PG8_SB(b, h) + boff + n * 2048 + k * 1024); } while (0)
#define PG8_MMA(ai, bj, At, Bt) do { __builtin_amdgcn_s_setprio(1); _Pragma("unroll") for (int m = 0; m < 4; ++m) _Pragma("unroll") for (int n = 0; n < 2; ++n) _Pragma("unroll") for (int k = 0; k < 2; ++k) \
        acc[ai][bj][m][n] = __builtin_amdgcn_mfma_f32_16x16x32_bf16(Bt[n][k], At[m][k], acc[ai][bj][m][n], 0, 0, 0); __builtin_amdgcn_s_setprio(0); } while (0)
#define PG8_WAIT_V(n) asm volatile("s_waitcnt vmcnt(" #n ")" ::: "memory")
#define PG8_WAIT_L(n) asm volatile("s_waitcnt lgkmcnt(" #n ")" ::: "memory")
#define PG8_BAR __builtin_amdgcn_s_barrier()
#define PG8_SCHED __builtin_amdgcn_sched_barrier(0)
    Unit cur, nxt; int ui = 0;
    if (!S.next(0, cur)) return;
    f32x4 acc[2][2][4][2];
#pragma unroll
    for (int a = 0; a < 2; ++a)
#pragma unroll
        for (int b = 0; b < 2; ++b)
#pragma unroll
            for (int m = 0; m < 4; ++m)
#pragma unroll
                for (int n = 0; n < 2; ++n) acc[a][b][m][n] = (f32x4){0.f, 0.f, 0.f, 0.f};
    bf16x8 At[4][2], B0[2][2], B1[2][2];
    const char* cA = cur.a; const char* cB = cur.b;
    PG8_STAGE(PG8_SB(0, 0), cB, voffB); PG8_STAGE(PG8_SA(0, 0), cA, voffA); PG8_STAGE(PG8_SB(0, 1), cB + hstepB, voffB); PG8_STAGE(PG8_SA(0, 1), cA + hstepA, voffA);
    if (wr == 1) PG8_BAR;
    PG8_WAIT_V(4); PG8_BAR;
    PG8_STAGE(PG8_SB(1, 0), cB + kstep, voffB); PG8_STAGE(PG8_SA(1, 0), cA + kstep, voffA); PG8_STAGE(PG8_SB(1, 1), cB + hstepB + kstep, voffB);
    PG8_WAIT_V(6); PG8_BAR;
    for (;;) {
        const bool has_next = S.next(ui + 1, nxt);
        const char* nA = has_next ? nxt.a : cA; const char* nB = has_next ? nxt.b : cB;
        for (int t = 0; t < nt; t += 2) {
            const bool last = (t == nt - 2);
            const char* a1 = cA + (size_t)(t + 1) * kstep;
            const char* a2 = last ? nA : cA + (size_t)(t + 2) * kstep; const char* b2 = last ? nB : cB + (size_t)(t + 2) * kstep;
            const char* a3 = a2 + kstep; const char* b3 = b2 + kstep;
            PG8_LDB(B0, 0, 0); PG8_SCHED; PG8_LDA(At, 0, 0); PG8_STAGE(PG8_SA(1, 1), a1 + hstepA, voffA);
            PG8_WAIT_L(8); PG8_BAR; PG8_WAIT_L(0); PG8_MMA(0, 0, At, B0); PG8_BAR; PG8_SCHED;
            PG8_LDB(B1, 0, 1); PG8_STAGE(PG8_SB(0, 0), b2, voffB);
            PG8_BAR; PG8_WAIT_L(0); PG8_MMA(0, 1, At, B1); PG8_BAR;
            PG8_LDA(At, 0, 1); PG8_STAGE(PG8_SA(0, 0), a2, voffA);
            PG8_BAR; PG8_WAIT_L(0); PG8_MMA(1, 0, At, B0); PG8_BAR; PG8_SCHED;
            PG8_STAGE(PG8_SB(0, 1), b2 + hstepB, voffB);
            PG8_WAIT_V(6); PG8_BAR; PG8_MMA(1, 1, At, B1); PG8_BAR;
            PG8_LDB(B0, 1, 0); PG8_SCHED; PG8_LDA(At, 1, 0); PG8_STAGE(PG8_SA(0, 1), a2 + hstepA, voffA);
            PG8_WAIT_L(8); PG8_BAR; PG8_WAIT_L(0); PG8_MMA(0, 0, At, B0); PG8_BAR; PG8_SCHED;
            PG8_LDB(B1, 1, 1); PG8_STAGE(PG8_SB(1, 0), b3, voffB);
            PG8_BAR; PG8_WAIT_L(0); PG8_MMA(0, 1, At, B1); PG8_BAR;
            PG8_LDA(At, 1, 1); PG8_STAGE(PG8_SA(1, 0), a3, voffA);
            PG8_BAR; PG8_WAIT_L(0); PG8_MMA(1, 0, At, B0); PG8_BAR; PG8_SCHED;
            PG8_STAGE(PG8_SB(1, 1), b3 + hstepB, voffB);
            PG8_WAIT_V(6); PG8_BAR; PG8_MMA(1, 1, At, B1); PG8_BAR;
        }
        { int ln = lane; asm volatile("" : "+v"(ln)); E(acc, cur, wr, wc, ln & 15, ln >> 4); }
        if (!has_next) break;
#pragma unroll
        for (int a = 0; a < 2; ++a)
#pragma unroll
            for (int b = 0; b < 2; ++b)
#pragma unroll
                for (int m = 0; m < 4; ++m)
#pragma unroll
                    for (int n = 0; n < 2; ++n) acc[a][b][m][n] = (f32x4){0.f, 0.f, 0.f, 0.f};
        cur = nxt; cA = nA; cB = nB; ++ui;
    }
    PG8_WAIT_V(0);
    if (wr == 0) PG8_BAR;
    PG8_BAR;
#undef PG8_SA
#undef PG8_SB
#undef PG8_STAGE
#undef q64_voffA
#undef q64_voffB
#undef PG8_LDA
#undef PG8_LDB
#undef PG8_MMA
#undef PG8_WAIT_V
#undef PG8_WAIT_L
#undef PG8_BAR
#undef PG8_SCHED
}

struct SchedSimple {
    const char* A; const char* Bt; int nM, nN, G, c, poolmode, wgm; size_t tstepA, tstepB;
    __device__ __forceinline__ bool next(int i, Unit& u) const {
        const int L = i * G + c; if (L >= nM * nN) return false;
        int pm, pn; remap_tile(L, nM, nN, pm, pn, wgm);
        u.a = A + (size_t)pm * tstepA + (poolmode ? (size_t)(pn >> 1) * 1024 : 0); u.b = Bt + (size_t)pn * tstepB; u.pm = pm; u.pn = pn; u.job = 0; return true;
    }
};
struct SchedProj {
    const char* ws; int G, c;
    __device__ __forceinline__ bool next(int i, Unit& u) const {
        const int L = i * G + c; if (L >= 1728) return false;
        int job, l, nN; size_t bo, ao;
        if (L < 1536) { job = L >> 9; l = L & 511; nN = 8; bo = job == 0 ? O_WRT : (job == 1 ? O_WKT : O_WVT); ao = job == 0 ? 0 : (job == 1 ? 2 : 3); }
        else { const int q = L - 1536; job = 3 + (q >> 6); l = q & 63; nN = 1; bo = job == 3 ? O_W1C : (job == 4 ? O_A1C : O_G1C); ao = job == 3 ? 1 : (job == 4 ? 4 : 5); }
        int pm, pn; remap_tile(l, 64, nN, pm, pn, nN == 8 ? 4 : 8);
        u.a = ws + O_X6 + ao * (64 * MiB) + (size_t)pm * (256 * 2048 * 2); u.b = ws + bo + (size_t)pn * (256 * 2048 * 2); u.pm = pm; u.pn = pn; u.job = job; return true;
    }
};
struct SchedLora2 {
    const char* ws; int G, c;
    __device__ __forceinline__ bool next(int i, Unit& u) const {
        const int L = i * G + c; if (L >= 2560) return false;
        const int job = L >> 9, l = L & 511;
        const size_t ao = job < 2 ? O_LW : (job < 4 ? O_LA : O_LG);
        const size_t bo = job == 0 ? O_W2T0 : (job == 1 ? O_W2T1 : (job == 2 ? O_A2T0 : (job == 3 ? O_A2T1 : O_G2T)));
        int pm, pn; remap_tile(l, 64, 8, pm, pn, 4);
        u.a = ws + ao + (size_t)pm * (256 * 256 * 2); u.b = ws + bo + (size_t)pn * (256 * 256 * 2); u.pm = pm; u.pn = pn; u.job = job; return true;
    }
};

struct EpiSwiGLU {
    static constexpr bool PERM = true;
    bf16_t* U;
    __device__ __forceinline__ void operator()(const f32x4 (&acc)[2][2][4][2], const Unit& u, int wr, int wc, int fr, int fq) const {
        const int row0 = u.pm * BM + wr * 64 + fr, col0 = u.pn * 128 + wc * 32 + 8 * fq;
#pragma unroll
        for (int ai = 0; ai < 2; ++ai)
#pragma unroll
            for (int m = 0; m < 4; ++m) {
                bf16_t* rowp = U + (size_t)(row0 + ai * HALF + m * 16) * F_ + col0;
                float o[8];
#pragma unroll
                for (int n = 0; n < 2; ++n)
#pragma unroll
                    for (int j = 0; j < 4; ++j) { const float g = acc[ai][0][m][n][j], up = acc[ai][1][m][n][j]; o[4 * n + j] = g * sigmoidf_(g) * up; }
                u32x4 w; w.x = cvt_pk_bf16(o[0], o[1]); w.y = cvt_pk_bf16(o[2], o[3]); w.z = cvt_pk_bf16(o[4], o[5]); w.w = cvt_pk_bf16(o[6], o[7]);
                *(u32x4*)rowp = w;
            }
    }
};
struct EpiResid {
    static constexpr bool PERM = false;
    const float* src; float* dst; const float* colscale; float scale;
    __device__ __forceinline__ void operator()(const f32x4 (&acc)[2][2][4][2], const Unit& u, int wr, int wc, int fr, int fq) const {
        const int row0 = u.pm * BM + wr * 64 + fr, col0 = u.pn * BM + wc * 32 + 4 * fq;
        f32x4 sv[2][2];
#pragma unroll
        for (int bj = 0; bj < 2; ++bj)
#pragma unroll
            for (int n = 0; n < 2; ++n) sv[bj][n] = colscale ? *(const f32x4*)(colscale + col0 + bj * HALF + n * 16) * scale : (f32x4){scale, scale, scale, scale};
#pragma unroll
        for (int ai = 0; ai < 2; ++ai) {
            f32x4 base[4][2][2];
#pragma unroll
            for (int m = 0; m < 4; ++m)
#pragma unroll
                for (int bj = 0; bj < 2; ++bj)
#pragma unroll
                    for (int n = 0; n < 2; ++n) base[m][bj][n] = *(const f32x4*)(src + (size_t)(row0 + ai * HALF + m * 16) * D_ + col0 + bj * HALF + n * 16);
            __builtin_amdgcn_sched_barrier(0);
#pragma unroll
            for (int m = 0; m < 4; ++m)
#pragma unroll
                for (int bj = 0; bj < 2; ++bj)
#pragma unroll
                    for (int n = 0; n < 2; ++n) *(f32x4*)(dst + (size_t)(row0 + ai * HALF + m * 16) * D_ + col0 + bj * HALF + n * 16) = base[m][bj][n] + acc[ai][bj][m][n] * sv[bj][n];
            __builtin_amdgcn_sched_barrier(0);
        }
    }
};
struct EpiProj {
    static constexpr bool PERM = true;
    unsigned char* ws;
    __device__ __forceinline__ void operator()(const f32x4 (&acc)[2][2][4][2], const Unit& u, int wr, int wc, int fr, int fq) const {
        const int job = u.job;
        const int row0 = u.pm * BM + wr * 64 + fr, col0 = u.pn * BM + wc * 32 + 8 * fq;
        const size_t obase = job == 0 ? O_R : (job == 1 ? O_K : (job == 2 ? O_V : (job == 3 ? O_LW : (job == 4 ? O_LA : O_LG))));
        const int ldc = job < 3 ? D_ : 256;
        unsigned short* outp = (unsigned short*)(ws + obase) + (size_t)row0 * ldc + col0;
        const float c0 = job == 3 ? 1.f : 0.f, c1 = job == 3 ? -2.f : 1.f, c2 = job == 3 ? 2.f : -1.f;
        const bool act = (job == 3) || (job == 5), f16 = job < 3;
#pragma unroll
        for (int ai = 0; ai < 2; ++ai)
#pragma unroll
            for (int m = 0; m < 4; ++m) {
                unsigned short* rowp = outp + (size_t)(ai * HALF + m * 16) * ldc;
#pragma unroll
                for (int bj = 0; bj < 2; ++bj) {
                    f32x4 v0 = acc[ai][bj][m][0], v1 = acc[ai][bj][m][1];
                    if (act) {
#pragma unroll
                        for (int j = 0; j < 4; ++j) { v0[j] = c0 + c1 * __builtin_amdgcn_rcpf(1.f + __expf(c2 * v0[j])); v1[j] = c0 + c1 * __builtin_amdgcn_rcpf(1.f + __expf(c2 * v1[j])); }
                    }
                    u32x4 w;
                    if (f16) { w.x = pk_h2(v0[0], v0[1]); w.y = pk_h2(v0[2], v0[3]); w.z = pk_h2(v1[0], v1[1]); w.w = pk_h2(v1[2], v1[3]); }
                    else { w.x = cvt_pk_bf16(v0[0], v0[1]); w.y = cvt_pk_bf16(v0[2], v0[3]); w.z = cvt_pk_bf16(v1[0], v1[1]); w.w = cvt_pk_bf16(v1[2], v1[3]); }
                    *(u32x4*)(rowp + bj * HALF) = w;
                }
            }
    }
};
struct EpiLora2 {
    static constexpr bool PERM = true;
    unsigned char* ws; const float* w0; const float* a0;
    __device__ __forceinline__ void operator()(const f32x4 (&acc)[2][2][4][2], const Unit& u, int wr, int wc, int fr, int fq) const {
        const int job = u.job;
        const int row0 = u.pm * BM + wr * 64 + fr, col0 = u.pn * BM + wc * 32 + 8 * fq;
        const size_t obase = job == 0 ? O_E0 : (job == 1 ? O_E1 : (job == 2 ? O_A0 : (job == 3 ? O_A1 : O_G)));
        unsigned short* outp = (unsigned short*)(ws + obase) + (size_t)row0 * D_ + col0;
        const float* bias = (job < 2 ? (w0 + (size_t)job * D_) : (a0 + (size_t)(job & 1) * D_)) + col0;
        const float osc = job < 2 ? 0.60653065971f : 1.f;
        const bool act = job < 4;
#pragma unroll
        for (int bj = 0; bj < 2; ++bj) {
            f32x4 b0 = (f32x4){0.f, 0.f, 0.f, 0.f}, b1 = b0;
            if (act) { b0 = *(const f32x4*)(bias + bj * HALF); b1 = *(const f32x4*)(bias + bj * HALF + 4); }
#pragma unroll
            for (int ai = 0; ai < 2; ++ai)
#pragma unroll
                for (int m = 0; m < 4; ++m) {
                    unsigned short* rowp = outp + (size_t)(ai * HALF + m * 16) * D_;
                    f32x4 v0 = acc[ai][bj][m][0] + b0, v1 = acc[ai][bj][m][1] + b1;
                    if (act) {
#pragma unroll
                        for (int j = 0; j < 4; ++j) { v0[j] = osc * sigmoidf_(v0[j]); v1[j] = osc * sigmoidf_(v1[j]); }
                    }
                    u32x4 w; w.x = pk_h2(v0[0], v0[1]); w.y = pk_h2(v0[2], v0[3]); w.z = pk_h2(v1[0], v1[1]); w.w = pk_h2(v1[2], v1[3]);
                    *(u32x4*)(rowp + bj * HALF) = w;
                    __builtin_amdgcn_sched_barrier(0);
                }
        }
    }
};

constexpr int SC_T = 32;
constexpr int SC_AV = 0, SC_WR = SC_T * 32 * 4, SC_W = 2 * SC_T * 32 * 4, SC_BK = SC_W + SC_T * 64 * 4, SC_V = SC_BK + SC_T * 64 * 4, SC_SC = SC_V + SC_T * 64 * 4, SC_Y = SC_SC + SC_T * 2 * 4, SC_A = SC_Y + SC_T * 64 * 4, SC_BUF = SC_A + SC_T * 64 * 4;
constexpr int SC_ZERO = 2 * SC_BUF;
typedef _Float16 half2_t __attribute__((ext_vector_type(2)));
__device__ __forceinline__ float dot2h(unsigned a, unsigned b, float c) { return __builtin_amdgcn_fdot2(__builtin_bit_cast(half2_t, a), __builtin_bit_cast(half2_t, b), c, false); }
__device__ __forceinline__ void red8x4(float& a, float& b, float& c, float& d) {
    asm volatile("s_nop 1\n\t"
                 "v_add_f32_dpp %0, %0, %0 quad_perm:[1,0,3,2] row_mask:0xf bank_mask:0xf\n\t"
                 "v_add_f32_dpp %1, %1, %1 quad_perm:[1,0,3,2] row_mask:0xf bank_mask:0xf\n\t"
                 "v_add_f32_dpp %2, %2, %2 quad_perm:[1,0,3,2] row_mask:0xf bank_mask:0xf\n\t"
                 "v_add_f32_dpp %3, %3, %3 quad_perm:[1,0,3,2] row_mask:0xf bank_mask:0xf\n\t"
                 "v_add_f32_dpp %0, %0, %0 quad_perm:[2,3,0,1] row_mask:0xf bank_mask:0xf\n\t"
                 "v_add_f32_dpp %1, %1, %1 quad_perm:[2,3,0,1] row_mask:0xf bank_mask:0xf\n\t"
                 "v_add_f32_dpp %2, %2, %2 quad_perm:[2,3,0,1] row_mask:0xf bank_mask:0xf\n\t"
                 "v_add_f32_dpp %3, %3, %3 quad_perm:[2,3,0,1] row_mask:0xf bank_mask:0xf\n\t"
                 "v_add_f32_dpp %0, %0, %0 row_half_mirror row_mask:0xf bank_mask:0xf\n\t"
                 "v_add_f32_dpp %1, %1, %1 row_half_mirror row_mask:0xf bank_mask:0xf\n\t"
                 "v_add_f32_dpp %2, %2, %2 row_half_mirror row_mask:0xf bank_mask:0xf\n\t"
                 "v_add_f32_dpp %3, %3, %3 row_half_mirror row_mask:0xf bank_mask:0xf"
                 : "+v"(a), "+v"(b), "+v"(c), "+v"(d));
}
__device__ __forceinline__ void scan_phase(const Params& p, unsigned char* ws, LAS unsigned char* lds, int tid, int lane, int wave, int bid, int nb) {
    const float* k_k = pin(p, 25); const float* k_a = pin(p, 26); const float* r_k = pin(p, 27);
    for (int chain = bid; chain < 256; chain += nb) {
        const int d = chain & 1, hh = (chain >> 1) & 31, b = chain >> 6;
        const unsigned short* Rg = (const unsigned short*)(ws + O_R);
        const unsigned short* Kg = (const unsigned short*)(ws + O_K);
        const unsigned short* Vg = (const unsigned short*)(ws + O_V);
        unsigned short* Eg = (unsigned short*)(ws + (d ? O_E1 : O_E0));
        const unsigned short* Ag = (const unsigned short*)(ws + (d ? O_A1 : O_A0));
        float* BSg = (float*)(ws + O_BS) + (size_t)d * M_ * NH_;
        __syncthreads();
        if (wave >= 4) {
            const int lid = tid - 256, s = lid >> 3, j0 = 8 * (lid & 7), ch = hh * 64 + j0;
            float kkc[8], kac[8], rkc[8];
#pragma unroll
            for (int i = 0; i < 8; ++i) { kkc[i] = k_k[ch + i]; kac[i] = k_a[ch + i]; rkc[i] = r_k[ch + i]; }
            if (lid < 32) ((LAS unsigned*)(lds + SC_ZERO))[lid] = 0u;
            h8 r8, k8, v8, e8, a8;
            { const int t = d ? (S_ - 1 - s) : s; const size_t off = ((size_t)b * S_ + t) * D_ + ch;
              r8 = *(const h8*)(Rg + off); k8 = *(const h8*)(Kg + off); v8 = *(const h8*)(Vg + off); e8 = *(const h8*)(Eg + off); a8 = *(const h8*)(Ag + off); }
            for (int ci = -1; ci < S_ / SC_T; ++ci) {
                if (ci >= 1) {
                    const int cj = ci - 1; const int st = cj * SC_T + s; const int t = d ? (S_ - 1 - st) : st;
                    const LAS unsigned char* fb = lds + (cj & 1) * SC_BUF;
                    const LAS float* yb = (const LAS float*)(fb + SC_Y) + s * 64 + j0; const LAS float* ab = (const LAS float*)(fb + SC_A) + s * 64 + j0; const LAS float* vv = (const LAS float*)(fb + SC_V) + s * 64 + j0;
                    const f32x2 bk2 = *(const LAS f32x2*)((const LAS float*)(fb + SC_SC) + s * 2);
                    const f32x4 y0 = *(const LAS f32x4*)yb + *(const LAS f32x4*)ab * bk2.x + *(const LAS f32x4*)vv * bk2.y, y1 = *(const LAS f32x4*)(yb + 4) + *(const LAS f32x4*)(ab + 4) * bk2.x + *(const LAS f32x4*)(vv + 4) * bk2.y;
                    u32x4 w; w.x = cvt_pk_bf16(y0.x, y0.y); w.y = cvt_pk_bf16(y0.z, y0.w); w.z = cvt_pk_bf16(y1.x, y1.y); w.w = cvt_pk_bf16(y1.z, y1.w);
                    *(u32x4*)(Eg + ((size_t)b * S_ + t) * D_ + ch) = w;
                }
                if (ci + 1 < S_ / SC_T) {
                    const int cj = ci + 1; const int st = cj * SC_T + s; const int t = d ? (S_ - 1 - st) : st;
                    const size_t m = (size_t)b * S_ + t;
                    h8 r8n = r8, k8n = k8, v8n = v8, e8n = e8, a8n = a8;
                    if (cj + 1 < S_ / SC_T) {
                        const int st2 = (cj + 1) * SC_T + s; const int t2 = d ? (S_ - 1 - st2) : st2; const size_t off2 = ((size_t)b * S_ + t2) * D_ + ch;
                        r8n = *(const h8*)(Rg + off2); k8n = *(const h8*)(Kg + off2); v8n = *(const h8*)(Vg + off2); e8n = *(const h8*)(Eg + off2); a8n = *(const h8*)(Ag + off2);
                    }
                    float kk[8], ss = 0.f;
#pragma unroll
                    for (int i = 0; i < 8; ++i) { kk[i] = (float)k8[i] * kkc[i]; ss += kk[i] * kk[i]; }
                    ss = red8(ss);
                    const float inv = fminf(__builtin_amdgcn_rsqf(ss), 1e12f);
                    float ps[8];
                    const int wl = lid & 63;
#pragma unroll
                    for (int i = 0; i < 8; ++i) ps[i] = (float)e8[i];
#pragma unroll
                    for (int dd = 8; dd < 64; dd <<= 1) {
#pragma unroll
                        for (int i = 0; i < 8; ++i) { const float tup = __shfl_up(ps[i], dd); ps[i] += (wl >= dd) ? tup : 0.f; }
                    }
                    float av[8], wv[8], bb[8], kd[8], wrr[8], br = 0.f, kr = 0.f, bsum = 0.f;
#pragma unroll
                    for (int i = 0; i < 8; ++i) {
                        const float rr = (float)r8[i], kf = (float)k8[i], af = (float)a8[i], ei = (float)e8[i];
                        const float Pt = __expf(-ps[i]), Pm = __expf(ei - ps[i]), iP = __expf(ps[i]);
                        kk[i] *= inv; const float bt = kk[i] * af, kt = kf * (1.f + (af - 1.f) * kac[i]);
                        br += bt * rr; kr += kt * rr; bsum += rr * kt * rkc[i];
                        av[i] = -kk[i] * Pm; wrr[i] = Pt * rr; bb[i] = bt * iP; kd[i] = kt * iP; wv[i] = Pt;
                    }
                    br = red8(br); kr = red8(kr); bsum = red8(bsum);
                    LAS unsigned char* buf = lds + (cj & 1) * SC_BUF;
                    *(LAS u32x4*)((LAS unsigned*)(buf + SC_AV) + s * 32 + (j0 >> 1)) = (u32x4){pk_h2(av[0], av[1]), pk_h2(av[2], av[3]), pk_h2(av[4], av[5]), pk_h2(av[6], av[7])};
                    *(LAS u32x4*)((LAS unsigned*)(buf + SC_WR) + s * 32 + (j0 >> 1)) = (u32x4){pk_h2(wrr[0], wrr[1]), pk_h2(wrr[2], wrr[3]), pk_h2(wrr[4], wrr[5]), pk_h2(wrr[6], wrr[7])};
                    if ((s & 7) == 7) { LAS float* wp = (LAS float*)(buf + SC_W) + (s >> 3) * 64 + j0;
                      *(LAS f32x4*)wp = (f32x4){wv[0], wv[1], wv[2], wv[3]}; *(LAS f32x4*)(wp + 4) = (f32x4){wv[4], wv[5], wv[6], wv[7]}; }
                    LAS unsigned* bkp = (LAS unsigned*)(buf + SC_BK) + s * 64 + j0;
                    *(LAS u32x4*)bkp = (u32x4){pk_h2(bb[0], kd[0]), pk_h2(bb[1], kd[1]), pk_h2(bb[2], kd[2]), pk_h2(bb[3], kd[3])};
                    *(LAS u32x4*)(bkp + 4) = (u32x4){pk_h2(bb[4], kd[4]), pk_h2(bb[5], kd[5]), pk_h2(bb[6], kd[6]), pk_h2(bb[7], kd[7])};
                    LAS float* vb = (LAS float*)(buf + SC_V) + s * 64 + j0;
                    *(LAS f32x4*)vb = (f32x4){(float)v8[0], (float)v8[1], (float)v8[2], (float)v8[3]}; *(LAS f32x4*)(vb + 4) = (f32x4){(float)v8[4], (float)v8[5], (float)v8[6], (float)v8[7]};
                    if ((lid & 7) == 0) { *(LAS f32x2*)((LAS float*)(buf + SC_SC) + s * 2) = (f32x2){br, kr}; BSg[m * NH_ + hh] = bsum; }
                    r8 = r8n; k8 = k8n; v8 = v8n; e8 = e8n; a8 = a8n;
                }
                __syncthreads();
            }
            {
                const int cj = S_ / SC_T - 1; const int st = cj * SC_T + s; const int t = d ? (S_ - 1 - st) : st;
                const LAS unsigned char* fb = lds + (cj & 1) * SC_BUF;
                const LAS float* yb = (const LAS float*)(fb + SC_Y) + s * 64 + j0; const LAS float* ab = (const LAS float*)(fb + SC_A) + s * 64 + j0; const LAS float* vv = (const LAS float*)(fb + SC_V) + s * 64 + j0;
                const f32x2 bk2 = *(const LAS f32x2*)((const LAS float*)(fb + SC_SC) + s * 2);
                const f32x4 y0 = *(const LAS f32x4*)yb + *(const LAS f32x4*)ab * bk2.x + *(const LAS f32x4*)vv * bk2.y, y1 = *(const LAS f32x4*)(yb + 4) + *(const LAS f32x4*)(ab + 4) * bk2.x + *(const LAS f32x4*)(vv + 4) * bk2.y;
                u32x4 w; w.x = cvt_pk_bf16(y0.x, y0.y); w.y = cvt_pk_bf16(y0.z, y0.w); w.z = cvt_pk_bf16(y1.x, y1.y); w.w = cvt_pk_bf16(y1.z, y1.w);
                *(u32x4*)(Eg + ((size_t)b * S_ + t) * D_ + ch) = w;
            }
        } else {
            const int rl = lane & 15, g = lane >> 4, row = 16 * wave + rl, m4 = rl & 3;
            f32x2 S[8];
#pragma unroll
            for (int q = 0; q < 8; ++q) S[q] = (f32x2){0.f, 0.f};
            __syncthreads();
            for (int ci = 0; ci < S_ / SC_T; ++ci) {
                const LAS unsigned char* buf = lds + (ci & 1) * SC_BUF;
                const LAS unsigned char* xb = (m4 == 0 ? buf + SC_AV : (m4 == 1 ? buf + SC_WR : lds + SC_ZERO)) + 16 * g;
                const int xs = m4 < 2 ? 128 : 0;
                const LAS float* wb = (const LAS float*)(buf + SC_W) + 8 * g;
                const LAS unsigned* bkb = (const LAS unsigned*)(buf + SC_BK) + 8 * g;
                const LAS float* vb = (const LAS float*)(buf + SC_V) + row;
                LAS float* yb = (LAS float*)(lds + (ci & 1) * SC_BUF + SC_Y) + row;
#define SC_LOAD(P, s) do { \
                    P##x1 = *(const LAS h8*)(xb + (s) * xs); P##x2 = *(const LAS h8*)(xb + (s) * xs + 64); \
                                        P##k0 = *(const LAS u32x4*)(bkb + (s) * 64); P##k1 = *(const LAS u32x4*)(bkb + (s) * 64 + 4); P##k2 = *(const LAS u32x4*)(bkb + (s) * 64 + 32); P##k3 = *(const LAS u32x4*)(bkb + (s) * 64 + 36); \
                    P##v = *(vb + (s) * 64); } while (0)
#define SC_STEP(P, s) do { \
                    const u32x4 b1u = (u32x4){pk_h2(S[0].x, S[0].y), pk_h2(S[1].x, S[1].y), pk_h2(S[2].x, S[2].y), pk_h2(S[3].x, S[3].y)}; \
                    const u32x4 b2u = (u32x4){pk_h2(S[4].x, S[4].y), pk_h2(S[5].x, S[5].y), pk_h2(S[6].x, S[6].y), pk_h2(S[7].x, S[7].y)}; \
                    f32x4 acc = __builtin_amdgcn_mfma_f32_16x16x32_f16(P##x1, __builtin_bit_cast(h8, b1u), (f32x4){0.f, 0.f, 0.f, 0.f}, 0, 0, 0); \
                    acc = __builtin_amdgcn_mfma_f32_16x16x32_f16(P##x2, __builtin_bit_cast(h8, b2u), acc, 0, 0, 0); \
                    f32x2 t; \
                    const unsigned hh0 = pk_h2(acc[0], P##v); \
                    S[0].x = dot2h(hh0, P##k0.x, S[0].x); S[0].y = dot2h(hh0, P##k0.y, S[0].y); S[1].x = dot2h(hh0, P##k0.z, S[1].x); S[1].y = dot2h(hh0, P##k0.w, S[1].y); \
                    S[2].x = dot2h(hh0, P##k1.x, S[2].x); S[2].y = dot2h(hh0, P##k1.y, S[2].y); S[3].x = dot2h(hh0, P##k1.z, S[3].x); S[3].y = dot2h(hh0, P##k1.w, S[3].y); \
                    S[4].x = dot2h(hh0, P##k2.x, S[4].x); S[4].y = dot2h(hh0, P##k2.y, S[4].y); S[5].x = dot2h(hh0, P##k2.z, S[5].x); S[5].y = dot2h(hh0, P##k2.w, S[5].y); \
                    S[6].x = dot2h(hh0, P##k3.x, S[6].x); S[6].y = dot2h(hh0, P##k3.y, S[6].y); S[7].x = dot2h(hh0, P##k3.z, S[7].x); S[7].y = dot2h(hh0, P##k3.w, S[7].y); \
                    (void)t; if (g == 0) { *(yb + (s) * 64) = acc[1]; *(yb + (s) * 64 + SC_T * 64) = acc[0]; } } while (0)
                h8 Ax1, Ax2, Bx1, Bx2; u32x4 Ak0, Ak1, Ak2, Ak3, Bk0, Bk1, Bk2, Bk3; float Av, Bv;
                SC_LOAD(A, 0);
                for (int s = 0; s < SC_T; s += 2) {
                    SC_LOAD(B, s + 1);
                    __builtin_amdgcn_sched_barrier(0);
                    SC_STEP(A, s);
                    __builtin_amdgcn_sched_barrier(0);
                    SC_LOAD(A, s + 2);
                    __builtin_amdgcn_sched_barrier(0);
                    SC_STEP(B, s + 1);
                    __builtin_amdgcn_sched_barrier(0);
                    if ((s & 7) == 6) {
                        const LAS float* pg = wb + ((s + 1) >> 3) * 64;
                        const f32x4 p0 = *(const LAS f32x4*)pg, p1 = *(const LAS f32x4*)(pg + 4), p2 = *(const LAS f32x4*)(pg + 32), p3 = *(const LAS f32x4*)(pg + 36);
                        S[0] *= p0.xy; S[1] *= p0.zw; S[2] *= p1.xy; S[3] *= p1.zw; S[4] *= p2.xy; S[5] *= p2.zw; S[6] *= p3.xy; S[7] *= p3.zw;
                    }
                }
#undef SC_LOAD
#undef SC_STEP
                __syncthreads();
            }
        }
    }
}

__device__ __forceinline__ void post_phase(const Params& p, unsigned char* ws, int lane, int gw, int NGW) {
    const float* lnw = pin(p, 28); const float* lnb = pin(p, 29);
    const unsigned short* Y0 = (const unsigned short*)(ws + O_E0); const unsigned short* Y1 = (const unsigned short*)(ws + O_E1);
    const unsigned short* Vg = (const unsigned short*)(ws + O_V); const unsigned short* Gg = (const unsigned short*)(ws + O_G);
    const float* BS = (const float*)(ws + O_BS);
    unsigned short* P = (unsigned short*)(ws + O_POST);
    for (int m = gw; m < M_; m += NGW) {
#pragma unroll
        for (int j = 0; j < 4; ++j) {
            const int ch0 = 8 * (lane + 64 * j), head = ch0 >> 6;
            const size_t off = (size_t)m * D_ + ch0;
            const u32x4 a = *(const u32x4*)(Y0 + off), bq = *(const u32x4*)(Y1 + off);
            float ys[8];
            ys[0] = bf_lo(a.x) + bf_lo(bq.x); ys[1] = bf_hi(a.x) + bf_hi(bq.x); ys[2] = bf_lo(a.y) + bf_lo(bq.y); ys[3] = bf_hi(a.y) + bf_hi(bq.y);
            ys[4] = bf_lo(a.z) + bf_lo(bq.z); ys[5] = bf_hi(a.z) + bf_hi(bq.z); ys[6] = bf_lo(a.w) + bf_lo(bq.w); ys[7] = bf_hi(a.w) + bf_hi(bq.w);
            float s = 0.f;
#pragma unroll
            for (int i = 0; i < 8; ++i) s += ys[i];
            const float mean = red8(s) * (1.f / 64.f);
            float s2 = 0.f;
#pragma unroll
            for (int i = 0; i < 8; ++i) { ys[i] -= mean; s2 += ys[i] * ys[i]; }
            const float rs = rsqrtf(red8(s2) * (1.f / 64.f) + 64e-5f);
            const h8 v8 = *(const h8*)(Vg + off), g8 = *(const h8*)(Gg + off);
            const f32x4 w0 = *(const f32x4*)(lnw + ch0), w1 = *(const f32x4*)(lnw + ch0 + 4), b0 = *(const f32x4*)(lnb + ch0), b1 = *(const f32x4*)(lnb + ch0 + 4);
            const float bsum = BS[(size_t)m * NH_ + head] + BS[(size_t)M_ * NH_ + (size_t)m * NH_ + head];
            float o[8];
#pragma unroll
            for (int i = 0; i < 8; ++i) {
                const float lw = i < 4 ? w0[i] : w1[i - 4], lb = i < 4 ? b0[i] : b1[i - 4];
                o[i] = (ys[i] * rs * lw + lb + bsum * (float)v8[i]) * (float)g8[i];
            }
            u32x4 w; w.x = cvt_pk_bf16(o[0], o[1]); w.y = cvt_pk_bf16(o[2], o[3]); w.z = cvt_pk_bf16(o[4], o[5]); w.w = cvt_pk_bf16(o[6], o[7]);
            *(u32x4*)(P + off) = w;
        }
    }
}

__device__ __forceinline__ void ffn_g1(unsigned char* ws, LAS unsigned char* lds, int tid, int bid, int nb, size_t o_gu) {
    SchedSimple S; S.A = (const char*)(ws + O_XN); S.Bt = (const char*)(ws + o_gu); S.nM = 64; S.nN = 44; S.G = nb; S.c = bid; S.poolmode = 0; S.wgm = 8;
    S.tstepA = (size_t)256 * D_ * 2; S.tstepB = (size_t)256 * D_ * 2;
    EpiSwiGLU E; E.U = (bf16_t*)(ws + O_U);
    gemm_phase(lds, tid, D_, D_, D_, S, E);
}
__device__ __forceinline__ void gemm_resid(unsigned char* ws, float* hout, LAS unsigned char* lds, int tid, int bid, int nb, size_t o_a, int lda, size_t o_bt, int K, int poolmode, const float* src, const float* colscale, float scale) {
    SchedSimple S; S.A = (const char*)(ws + o_a); S.Bt = (const char*)(ws + o_bt); S.nM = 64; S.nN = 8; S.G = nb; S.c = bid; S.poolmode = poolmode; S.wgm = 4;
    S.tstepA = (size_t)256 * lda * 2; S.tstepB = (size_t)256 * K * 2;
    EpiResid E; E.src = src; E.dst = hout; E.colscale = colscale; E.scale = scale;
    gemm_phase(lds, tid, K, lda, K, S, E);
}

__global__ void __launch_bounds__(512) mega(Params p) {
    extern __shared__ __attribute__((aligned(16))) unsigned char smem[];
    LAS unsigned char* lds = (LAS unsigned char*)smem;
    cg::grid_group grid = cg::this_grid();
    XcdBarrier xb;
    {
        volatile LAS unsigned* st = (volatile LAS unsigned*)(lds + 131072);
        if (threadIdx.x == 0) { st[0] = 0u; st[1] = 0u; }
        __syncthreads();
        xb.bar = (unsigned*)(p.ws + O_BAR); xb.x = xb_xcc_id(); xb.st = st;
        if (threadIdx.x == 0) (void)xb_add(&xb.bar[XB_XCNT(xb.x)], 1u);
    }
    constexpr int nb = 256;
    const int wid_s = __builtin_amdgcn_readfirstlane((int)(threadIdx.x >> 6));
#define PROLOG int m1_ = -1; asm volatile("" : "+s"(m1_)); int tid = wid_s * 64 + (int)__builtin_amdgcn_mbcnt_hi(m1_, __builtin_amdgcn_mbcnt_lo(m1_, 0)); int bid = blockIdx.x; asm volatile("" : "+s"(bid)); \
        const int lane = tid & 63, wave = tid >> 6; const int gw = bid * 8 + wave, NGW = nb * 8; LAS float* scr = (LAS float*)(lds + wave * 8704); \
        unsigned char* ws = p.ws; asm volatile("" : "+s"(ws)); float* h = p.out; asm volatile("" : "+s"(h)); (void)lane; (void)gw; (void)NGW; (void)scr; (void)h; (void)ws;
    for (int ph = p.ph_lo; ph < p.ph_hi; ++ph) {
#if REP_MASK
      const int nrep = ((REP_MASK >> ph) & 1) + 1;
      for (int rep = 0; rep < nrep; ++rep) {
        const float rsc = (rep == nrep - 1) ? 1.f : 0.f;
        if (rep) grid.sync();
#else
      { constexpr float rsc = 1.f;
#endif
        switch (ph) {
        case 0: { PROLOG
            norm_phase<false>(pin(p, 0), pin(p, 1), (bf16_t*)(ws + O_XN), nullptr, lane, gw, NGW);
            conv_ffn(pin(p, 2), pin(p, 3), pin(p, 4), (bf16_t*)(ws + O_AGU), (bf16_t*)(ws + O_AD), scr, lane, gw, NGW);
            conv_ffn(pin(p, 7), pin(p, 8), pin(p, 9), (bf16_t*)(ws + O_BGU), (bf16_t*)(ws + O_BD), scr, lane, gw, NGW);
            conv_rwkv(p, ws, scr, lane, gw, NGW);
        } break;
        case 1: { PROLOG
            ffn_g1(ws, lds, tid, bid, nb, O_AGU);
        } break;
        case 2: { PROLOG
            gemm_resid(ws, h, lds, tid, bid, nb, O_U, F_, O_AD, F_, 0, pin(p, 0), nullptr, 0.5f * rsc);
        } break;
        case 3: { PROLOG
            pool_prep_phase(h, pin(p, 5), (bf16_t*)(ws + O_XN), lds, tid, lane, wave, bid, nb);
            __syncthreads();
            conv_ffn(pin(p, 2) + (size_t)D_ * F_, pin(p, 3) + (size_t)D_ * F_, pin(p, 4) + (size_t)D_ * F_, (bf16_t*)(ws + O_AGU), (bf16_t*)(ws + O_AD), scr, lane, gw, NGW);
        } break;
        case 4: { PROLOG
            gemm_resid(ws, h, lds, tid, bid, nb, O_XN, D_, O_POOLT, 512, 1, h, pin(p, 11), 1.f * rsc);
        } break;
        case 5: { PROLOG
            norm_phase<false>(h, pin(p, 6), (bf16_t*)(ws + O_XN), nullptr, lane, gw, NGW);
        } break;
        case 6: { PROLOG
            ffn_g1(ws, lds, tid, bid, nb, O_BGU);
        } break;
        case 7: { PROLOG
            gemm_resid(ws, h, lds, tid, bid, nb, O_U, F_, O_BD, F_, 0, h, nullptr, 0.5f * rsc);
        } break;
        case 8: { PROLOG
            norm_phase<false>(h, pin(p, 1) + D_, (bf16_t*)(ws + O_XN), nullptr, lane, gw, NGW);
        } break;
        case 9: { PROLOG
            ffn_g1(ws, lds, tid, bid, nb, O_AGU);
        } break;
        case 10: { PROLOG
            gemm_resid(ws, h, lds, tid, bid, nb, O_U, F_, O_AD, F_, 0, h, nullptr, 0.5f * rsc);
        } break;
        case 11: { PROLOG
            rwkv_prep_phase(h, pin(p, 5) + D_, pin(p, 12), (bf16_t*)(ws + O_X6), lane, gw, NGW);
        } break;
        case 12: { PROLOG
            {
            SchedProj S; S.ws = (const char*)ws; S.G = nb; S.c = bid;
            EpiProj E; E.ws = ws;
            gemm_phase(lds, tid, D_, D_, D_, S, E);
        }
        } break;
        case 13: { PROLOG
            {
            SchedLora2 S; S.ws = (const char*)ws; S.G = nb; S.c = bid;
            EpiLora2 E; E.ws = ws; E.w0 = pin(p, 17); E.a0 = pin(p, 20);
            gemm_phase(lds, tid, 256, 256, 256, S, E);
        }
        } break;
        case 14: { PROLOG
            scan_phase(p, ws, lds, tid, lane, wave, bid, nb);
        } break;
        case 15: { PROLOG
            post_phase(p, ws, lane, gw, NGW);
        } break;
        case 16: { PROLOG
            gemm_resid(ws, h, lds, tid, bid, nb, O_POST, D_, O_WOT, D_, 0, h, nullptr, 1.f * rsc);
        } break;
        case 17: { PROLOG
            norm_phase<false>(h, pin(p, 6) + D_, (bf16_t*)(ws + O_XN), nullptr, lane, gw, NGW);
            conv_ffn(pin(p, 7) + (size_t)D_ * F_, pin(p, 8) + (size_t)D_ * F_, pin(p, 9) + (size_t)D_ * F_, (bf16_t*)(ws + O_BGU), (bf16_t*)(ws + O_BD), scr, lane, gw, NGW);
        } break;
        case 18: { PROLOG
            ffn_g1(ws, lds, tid, bid, nb, O_BGU);
        } break;
        case 19: { PROLOG
            gemm_resid(ws, h, lds, tid, bid, nb, O_U, F_, O_BD, F_, 0, h, nullptr, 0.5f * rsc);
        } break;
        case 20: { PROLOG
            norm_phase<true>(h, pin(p, 30), nullptr, h, lane, gw, NGW);
        } break;
        default: break;
        }
      }
        if (ph + 1 < p.ph_hi) {
            if (p.ph_lo < 0) grid.sync();
            xcd_barrier(xb, threadIdx.x == 0);
        }
    }
}

extern "C" void kernel_launch(void* const* d_in, const int* in_sizes, int n_in, void* d_out, int out_size, void* d_ws, size_t ws_size, hipStream_t stream) {
    static int grid_blocks = 0;
    if (grid_blocks == 0) {
        if (n_in != 31 || out_size != M_ * D_ || ws_size < WS_NEED) { fprintf(stderr, "kernel_launch: unexpected shapes (n_in %d out %d ws %zu)\n", n_in, out_size, ws_size); grid_blocks = -1; return; }
        int dev = 0, cus = 0, per_cu = 0;
        hipGetDevice(&dev);
        hipDeviceGetAttribute(&cus, hipDeviceAttributeMultiprocessorCount, dev);
        if (hipFuncSetAttribute((const void*)mega, hipFuncAttributeMaxDynamicSharedMemorySize, LDS_BYTES) != hipSuccess) { fprintf(stderr, "kernel_launch: hipFuncSetAttribute failed\n"); grid_blocks = -1; return; }
        hipOccupancyMaxActiveBlocksPerMultiprocessor(&per_cu, (const void*)mega, 512, LDS_BYTES);
        if (per_cu < 1) per_cu = 1;
        if (cus * per_cu < 256) { fprintf(stderr, "kernel_launch: device holds only %d co-resident workgroups, 256 needed\n", cus * per_cu); grid_blocks = -1; (void)hipGetLastError(); return; }
        grid_blocks = 256;
        (void)hipGetLastError();
    }
    if (grid_blocks < 0) return;
    Params p{};
    for (int i = 0; i < 31; ++i) p.in[i] = (const float*)d_in[i];
    p.out = (float*)d_out; p.ws = (unsigned char*)d_ws;
#if MK_SINGLE
    (void)hipMemsetAsync((unsigned char*)d_ws + O_BAR, 0, XCD_BAR_WORDS * 4, stream);
    p.ph_lo = 0; p.ph_hi = NPHASE;
    void* args[] = {&p};
    hipError_t e = hipLaunchCooperativeKernel((const void*)mega, dim3(grid_blocks), dim3(512), args, LDS_BYTES, stream);
    if (e != hipSuccess) fprintf(stderr, "cooperative launch failed: %s (grid %d)\n", hipGetErrorString(e), grid_blocks);
#else
    for (int ph = 0; ph < NPHASE; ++ph) {
        p.ph_lo = ph; p.ph_hi = ph + 1;
        hipLaunchKernelGGL(mega, dim3(grid_blocks), dim3(512), LDS_BYTES, stream, p);
    }
#endif
}
```

```cpp
#include <hip/hip_runtime.h>
#include <hip/hip_cooperative_groups.h>
#include <cstdio>
namespace cg = cooperative_groups;

#ifndef REP_MASK
#define REP_MASK 0
#endif
#ifndef MK_SINGLE
#define MK_SINGLE 1
#endif

#define LAS __attribute__((address_space(3)))
typedef unsigned short bf16_t;
typedef short bf16x8 __attribute__((ext_vector_type(8)));
typedef float f32x4 __attribute__((ext_vector_type(4)));
typedef float f32x2 __attribute__((ext_vector_type(2)));
typedef unsigned u32x4 __attribute__((ext_vector_type(4)));
typedef unsigned u32x2 __attribute__((ext_vector_type(2)));
typedef _Float16 h8 __attribute__((ext_vector_type(8)));

constexpr int M_ = 16384, D_ = 2048, F_ = 5632, S_ = 4096, NH_ = 32;
constexpr int NPHASE = 21;
constexpr int LDS_BYTES = 131072 + 16;
constexpr size_t MiB = 1ull << 20;
constexpr size_t O_WRT = 0 * MiB, O_WKT = 8 * MiB, O_WVT = 16 * MiB, O_WOT = 24 * MiB, O_W1C = 32 * MiB, O_A1C = 33 * MiB, O_G1C = 34 * MiB;
constexpr size_t O_W2T0 = 35 * MiB, O_W2T1 = 36 * MiB, O_A2T0 = 37 * MiB, O_A2T1 = 38 * MiB, O_G2T = 39 * MiB, O_POOLT = 40 * MiB;
constexpr size_t O_BAR = 42 * MiB;
constexpr size_t O_XN = 70 * MiB;
constexpr size_t O_AGU = 134 * MiB, O_AD = 178 * MiB, O_BGU = 200 * MiB, O_BD = 244 * MiB;
constexpr size_t O_U = 266 * MiB;
constexpr size_t O_X6 = 70 * MiB;
constexpr size_t O_R = 454 * MiB, O_K = 518 * MiB, O_V = 582 * MiB, O_LW = 646 * MiB, O_LA = 654 * MiB, O_LG = 662 * MiB, O_BS = 670 * MiB;
constexpr size_t O_E0 = 70 * MiB, O_E1 = 134 * MiB, O_A0 = 198 * MiB, O_A1 = 262 * MiB, O_G = 326 * MiB, O_POST = 390 * MiB;
constexpr size_t WS_NEED = 674 * MiB;

struct Params {
    const float* in[31];
    float* out;
    unsigned char* ws;
    int ph_lo, ph_hi;
};

__device__ __forceinline__ const float* pin(const Params& p, int i) { asm volatile("" : "+s"(i)); return p.in[i]; }
__device__ __forceinline__ unsigned cvt_pk_bf16(float lo, float hi) { unsigned r; asm volatile("v_cvt_pk_bf16_f32 %0, %1, %2" : "=v"(r) : "v"(lo), "v"(hi)); return r; }
__device__ __forceinline__ unsigned pk_h2(float a, float b) { auto h = __builtin_amdgcn_cvt_pkrtz(a, b); return __builtin_bit_cast(unsigned, h); }
__device__ __forceinline__ float bf_lo(unsigned w) { return __builtin_bit_cast(float, w << 16); }
__device__ __forceinline__ float bf_hi(unsigned w) { return __builtin_bit_cast(float, w & 0xffff0000u); }
template <int CTRL> __device__ __forceinline__ float dpp_f(float v) {
    return __builtin_bit_cast(float, __builtin_amdgcn_update_dpp(0, __builtin_bit_cast(int, v), CTRL, 0xF, 0xF, true));
}
__device__ __forceinline__ float red8(float v) { v += dpp_f<0xB1>(v); v += dpp_f<0x4E>(v); v += dpp_f<0x141>(v); return v; }
__device__ __forceinline__ float wave_sum(float v) {
    v += dpp_f<0xB1>(v); v += dpp_f<0x4E>(v); v += dpp_f<0x141>(v); v += dpp_f<0x140>(v);
    const int iv = __builtin_bit_cast(int, v);
    const float r0 = __builtin_bit_cast(float, __builtin_amdgcn_readlane(iv, 0)), r1 = __builtin_bit_cast(float, __builtin_amdgcn_readlane(iv, 16));
    const float r2 = __builtin_bit_cast(float, __builtin_amdgcn_readlane(iv, 32)), r3 = __builtin_bit_cast(float, __builtin_amdgcn_readlane(iv, 48));
    return (r0 + r1) + (r2 + r3);
}
__device__ __forceinline__ float sigmoidf_(float x) { return __builtin_amdgcn_rcpf(1.f + __expf(-x)); }
#define LDS_WAIT() asm volatile("s_waitcnt lgkmcnt(0)" ::: "memory")


#define XB_TMO      128
#define XB_XCNT(j)  (256  + 64 * (j))
#define XB_XSUB(j)  (1280 + 64 * (j))
#define XB_XGEN(j)  (2304 + 64 * (j))
#define XB_TOP      3328
#define XB_TOPGEN   3392
#define XCD_BAR_WORDS 3456
#define XB_SPIN_CAP (1u << 18)
__device__ __forceinline__ unsigned xb_ld(unsigned* p)              { return __hip_atomic_load(p, __ATOMIC_RELAXED, __HIP_MEMORY_SCOPE_AGENT); }
__device__ __forceinline__ unsigned xb_add(unsigned* p, unsigned v) { return __hip_atomic_fetch_add(p, v, __ATOMIC_RELAXED, __HIP_MEMORY_SCOPE_AGENT); }
__device__ __forceinline__ unsigned xb_xcc_id() { return (unsigned)__builtin_amdgcn_s_getreg((3 << 11) | 20) & 0xFu; }
#define XB_SPIN(cond, bar) do { unsigned _sp = 0; while (cond) { __builtin_amdgcn_s_sleep(1); \
    if ((++_sp & 255u) == 0u) { if (xb_ld(&(bar)[XB_TMO])) break; if (_sp > XB_SPIN_CAP) { atomicAdd(&(bar)[XB_TMO], 1u); break; } } } } while (0)
struct XcdBarrier { unsigned* bar; unsigned x; volatile LAS unsigned* st; };
__device__ __forceinline__ void xcd_barrier_complete(unsigned* bar, unsigned x, unsigned& nloc, unsigned& nx) {
    const unsigned G = gridDim.x;
    unsigned sum, cnt, mine, sp = 0u;
    for (;;) {
        sum = 0u; cnt = 0u; mine = 0u;
#pragma unroll
        for (unsigned j = 0; j < 16; ++j) { const unsigned c = xb_ld(&bar[XB_XCNT(j)]); sum += c; cnt += (c > 0u) ? 1u : 0u; mine = (j == x) ? c : mine; }
        if (sum == G) break;
        __builtin_amdgcn_s_sleep(1);
        if ((++sp & 255u) == 0u) { if (xb_ld(&bar[XB_TMO])) break; if (sp > XB_SPIN_CAP) { atomicAdd(&bar[XB_TMO], 1u); break; } }
    }
    nloc = mine > 0u ? mine : 1u; nx = cnt > 0u ? cnt : 1u;
}
__device__ __forceinline__ void xcd_barrier(const XcdBarrier& b, bool leader_thread) {
    asm volatile("s_waitcnt vmcnt(0)" ::: "memory");
    __syncthreads();
    if (leader_thread) {
        unsigned* bar = b.bar;
        __builtin_amdgcn_s_waitcnt(0);
        unsigned nloc = b.st[0], nx = b.st[1];
        if (nloc == 0u) { xcd_barrier_complete(bar, b.x, nloc, nx); b.st[0] = nloc; b.st[1] = nx; }
        const unsigned old = xb_add(&bar[XB_XSUB(b.x)], 1u);
        const unsigned gen = old / nloc;
        if (old + 1u == (gen + 1u) * nloc) {
            __builtin_amdgcn_fence(__ATOMIC_RELEASE, "agent");
            asm volatile("s_waitcnt vmcnt(0)" ::: "memory");
            const unsigned og = xb_add(&bar[XB_TOP], 1u);
            const unsigned tg = og / nx;
            if (og + 1u == (tg + 1u) * nx) xb_add(&bar[XB_TOPGEN], 1u);
            else XB_SPIN(xb_ld(&bar[XB_TOPGEN]) == tg, bar);
            __builtin_amdgcn_fence(__ATOMIC_ACQUIRE, "agent");
            xb_add(&bar[XB_XGEN(b.x)], 1u);
            asm volatile("s_waitcnt vmcnt(0)" ::: "memory");
        } else {
            XB_SPIN(xb_ld(&bar[XB_XGEN(b.x)]) == gen, bar);
            __builtin_amdgcn_fence(__ATOMIC_ACQUIRE, "agent");
            asm volatile("s_waitcnt vmcnt(0)" ::: "memory");
        }
    }
    __syncthreads();
}

__device__ __forceinline__ void tr_load(const float* src, int N, int k0, int n0, float (&v)[32], int lane) {
#pragma unroll
    for (int i = 0; i < 32; ++i) v[i] = src[(size_t)(k0 + 2 * i + (lane >> 5)) * N + n0 + (lane & 31)];
}
__device__ __forceinline__ void tr_store(const float (&v)[32], int k0, int n0, bf16_t* dst, int ldd, int mode, int row0, int col0, const float* scale, LAS float* scr, int lane) {
#pragma unroll
    for (int i = 0; i < 32; ++i) {
        const int kk = 2 * i + (lane >> 5);
        float x = v[i];
        if (scale) x *= scale[k0 + kk];
        scr[kk * 33 + (lane & 31)] = x;
    }
    LDS_WAIT();
    const int c = lane & 7;
#pragma unroll
    for (int j = 0; j < 4; ++j) {
        const int n = (lane >> 3) + 8 * j; const LAS float* s = scr + (8 * c) * 33 + n;
        u32x4 o; o.x = cvt_pk_bf16(s[0 * 33], s[1 * 33]); o.y = cvt_pk_bf16(s[2 * 33], s[3 * 33]); o.z = cvt_pk_bf16(s[4 * 33], s[5 * 33]); o.w = cvt_pk_bf16(s[6 * 33], s[7 * 33]);
        const int ng = n0 + n;
        const int row = mode ? (256 * (ng >> 7) + row0 + (ng & 127)) : (row0 + ng);
        *(u32x4*)(dst + (size_t)row * ldd + col0 + k0 + 8 * c) = o;
    }
    LDS_WAIT();
}
__device__ __forceinline__ void tr_mat(const float* src, int K, int N, bf16_t* dst, int ldd, int mode, int row0, int col0, const float* scale, LAS float* scr, int lane, int gw, int NGW, int rot) {
    const int nblk = N / 32, items = (K / 64) * nblk;
    int it = gw - rot; while (it < 0) it += NGW;
    float va[32], vb[32];
    if (it < items) tr_load(src, N, 64 * (it / nblk), 32 * (it % nblk), va, lane);
    while (it < items) {
        const int nx = it + NGW;
        if (nx < items) tr_load(src, N, 64 * (nx / nblk), 32 * (nx % nblk), vb, lane);
        tr_store(va, 64 * (it / nblk), 32 * (it % nblk), dst, ldd, mode, row0, col0, scale, scr, lane);
#pragma unroll
        for (int i = 0; i < 32; ++i) va[i] = vb[i];
        it = nx;
    }
}
__device__ __forceinline__ void conv_ffn(const float* gate, const float* up, const float* down, bf16_t* gu, bf16_t* dn, LAS float* scr, int lane, int gw, int NGW) {
    tr_mat(gate, D_, F_, gu, D_, 1, 0, 0, nullptr, scr, lane, gw, NGW, 0);
    tr_mat(up, D_, F_, gu, D_, 1, 128, 0, nullptr, scr, lane, gw, NGW, 5632);
    tr_mat(down, F_, D_, dn, F_, 0, 0, 0, nullptr, scr, lane, gw, NGW, 11264);
}
__device__ __forceinline__ void conv_rwkv(const Params& p, unsigned char* ws, LAS float* scr, int lane, int gw, int NGW) {
    tr_mat(pin(p, 13), D_, D_, (bf16_t*)(ws + O_WRT), D_, 0, 0, 0, nullptr, scr, lane, gw, NGW, 0);
    tr_mat(pin(p, 14), D_, D_, (bf16_t*)(ws + O_WKT), D_, 0, 0, 0, nullptr, scr, lane, gw, NGW, 0);
    tr_mat(pin(p, 15), D_, D_, (bf16_t*)(ws + O_WVT), D_, 0, 0, 0, nullptr, scr, lane, gw, NGW, 0);
    tr_mat(pin(p, 16), D_, D_, (bf16_t*)(ws + O_WOT), D_, 0, 0, 0, nullptr, scr, lane, gw, NGW, 0);
    for (int d = 0; d < 2; ++d) {
        tr_mat(pin(p, 18) + (size_t)d * D_ * 96, D_, 96, (bf16_t*)(ws + O_W1C), D_, 0, d * 96, 0, nullptr, scr, lane, gw, NGW, d * 96);
        tr_mat(pin(p, 21) + (size_t)d * D_ * 96, D_, 96, (bf16_t*)(ws + O_A1C), D_, 0, d * 96, 0, nullptr, scr, lane, gw, NGW, 192 + d * 96);
    }
    tr_mat(pin(p, 23), D_, 256, (bf16_t*)(ws + O_G1C), D_, 0, 0, 0, nullptr, scr, lane, gw, NGW, 384);
    tr_mat(pin(p, 24), 256, D_, (bf16_t*)(ws + O_G2T), 256, 0, 0, 0, nullptr, scr, lane, gw, NGW, 1280);
    for (int g = 0; g < 4; ++g)
        tr_mat(pin(p, 10) + (size_t)g * 512 * 512, 512, 512, (bf16_t*)(ws + O_POOLT) + (size_t)g * 512 * 512, 512, 0, 0, 0, nullptr, scr, lane, gw, NGW, 1536 + g * 128);
    const int gt = gw * 64 + lane, NT = NGW * 64;
    for (int idx = gt; idx < 2 * 64 * 2048; idx += NT) {
        const int which = idx / (64 * 2048), r = idx % (64 * 2048);
        bf16_t* dst = (bf16_t*)(ws + (which ? O_A1C : O_W1C)) + (size_t)192 * 2048;
        dst[r] = 0;
    }
    for (int idx = gt; idx < 4 * 256 * 2048; idx += NT) {
        const int mat = idx / (256 * 2048), r = idx % (256 * 2048), kk = r / 2048, n = r % 2048;
        const int d = mat & 1; const bool isa = mat >= 2;
        const float* src = (isa ? pin(p, 22) : pin(p, 19)) + (size_t)d * 96 * D_;
        bf16_t* dst = (bf16_t*)(ws + (isa ? (d ? O_A2T1 : O_A2T0) : (d ? O_W2T1 : O_W2T0)));
        const int j = kk - d * 96;
        const float v = (j >= 0 && j < 96) ? src[(size_t)j * D_ + n] : 0.f;
        dst[(size_t)n * 256 + kk] = (bf16_t)(cvt_pk_bf16(v, 0.f) & 0xffffu);
    }
}

template <bool FINAL>
__device__ __forceinline__ void norm_phase(const float* src, const float* gain, bf16_t* dst, float* fdst, int lane, int gw, int NGW) {
    f32x4 gv[8];
#pragma unroll
    for (int j = 0; j < 8; ++j) gv[j] = ((const f32x4*)gain)[lane + 64 * j];
    for (int row = gw; row < M_; row += NGW) {
        const f32x4* xr = (const f32x4*)(src + (size_t)row * D_) + lane;
        f32x4 v[8]; float s = 0.f;
#pragma unroll
        for (int j = 0; j < 8; ++j) { v[j] = xr[64 * j]; s += (v[j].x * v[j].x + v[j].y * v[j].y) + (v[j].z * v[j].z + v[j].w * v[j].w); }
        const float rstd = rsqrtf(wave_sum(s) * (1.f / D_) + 1e-6f);
        if (FINAL) {
            f32x4* o = (f32x4*)(fdst + (size_t)row * D_) + lane;
#pragma unroll
            for (int j = 0; j < 8; ++j) o[64 * j] = v[j] * rstd * gv[j];
        } else {
            u32x2* o = (u32x2*)(dst + (size_t)row * D_) + lane;
#pragma unroll
            for (int j = 0; j < 8; ++j) { f32x4 t = v[j] * rstd * gv[j]; u32x2 w; w.x = cvt_pk_bf16(t.x, t.y); w.y = cvt_pk_bf16(t.z, t.w); o[64 * j] = w; }
        }
    }
}

__device__ __forceinline__ void load_norm_row(const float* src, int row, const f32x4 (&gv)[8], f32x4 (&o)[8], int lane) {
    const f32x4* xr = (const f32x4*)(src + (size_t)row * D_) + lane;
    float s = 0.f;
#pragma unroll
    for (int j = 0; j < 8; ++j) { o[j] = xr[64 * j]; s += (o[j].x * o[j].x + o[j].y * o[j].y) + (o[j].z * o[j].z + o[j].w * o[j].w); }
    const float rstd = rsqrtf(wave_sum(s) * (1.f / D_) + 1e-6f);
#pragma unroll
    for (int j = 0; j < 8; ++j) o[j] = o[j] * rstd * gv[j];
}
__device__ __forceinline__ void rwkv_prep_phase(const float* h, const float* gain, const float* mu, bf16_t* x6, int lane, int gw, int NGW) {
    f32x4 gv[8];
#pragma unroll
    for (int j = 0; j < 8; ++j) gv[j] = ((const f32x4*)gain)[lane + 64 * j];
    for (int run = gw; run < M_ / 8; run += NGW) {
        const int row0 = run * 8, t0 = row0 & (S_ - 1);
        f32x4 prev[8], cur[8], nxt[8];
        if (t0 > 0) load_norm_row(h, row0 - 1, gv, prev, lane);
        else {
#pragma unroll
            for (int j = 0; j < 8; ++j) prev[j] = (f32x4){0.f, 0.f, 0.f, 0.f};
        }
        load_norm_row(h, row0, gv, cur, lane);
        for (int i = 0; i < 8; ++i) {
            const int row = row0 + i, t = t0 + i;
            if (t + 1 < S_) load_norm_row(h, row + 1, gv, nxt, lane);
            else {
#pragma unroll
                for (int j = 0; j < 8; ++j) nxt[j] = (f32x4){0.f, 0.f, 0.f, 0.f};
            }
#pragma unroll
            for (int j = 0; j < 8; ++j) {
                const f32x4 xx = (prev[j] + nxt[j]) * 0.5f - cur[j];
#pragma unroll
                for (int q = 0; q < 6; ++q) {
                    const f32x4 m4 = ((const f32x4*)(mu + (size_t)q * D_))[lane + 64 * j];
                    const f32x4 xm = cur[j] + xx * m4;
                    u32x2 w; w.x = cvt_pk_bf16(xm.x, xm.y); w.y = cvt_pk_bf16(xm.z, xm.w);
                    ((u32x2*)(x6 + (size_t)q * M_ * D_ + (size_t)row * D_))[lane + 64 * j] = w;
                }
                prev[j] = cur[j]; cur[j] = nxt[j];
            }
        }
    }
}

__device__ __forceinline__ void pool_prep_phase(const float* h, const float* gain, bf16_t* outp, LAS unsigned char* lds, int tid, int lane, int wave, int bid, int nb) {
    LAS float* rs = (LAS float*)lds;
    for (int chunk = bid; chunk < M_ / 64; chunk += nb) {
        const int m0 = chunk * 64, b = m0 / S_, t0 = m0 % S_;
        __syncthreads();
        for (int rr = wave; rr < 80; rr += 8) {
            const int t = t0 - 8 + rr;
            if (t >= 0 && t < S_) {
                const f32x4* xr = (const f32x4*)(h + ((size_t)b * S_ + t) * D_) + lane;
                float s = 0.f;
#pragma unroll
                for (int j = 0; j < 8; ++j) { const f32x4 v = xr[64 * j]; s += (v.x * v.x + v.y * v.y) + (v.z * v.z + v.w * v.w); }
                s = wave_sum(s);
                if (lane == 0) rs[rr] = rsqrtf(s * (1.f / D_) + 1e-6f);
            }
        }
        __syncthreads();
        const int c = 4 * tid, g = tid >> 7, w = 2 << g, half = w >> 1;
        const f32x4 gn = *(const f32x4*)(gain + c);
        const float* hb = h + (size_t)b * S_ * D_ + c;
#define HN(t) ((*(const f32x4*)(hb + (size_t)(t) * D_)) * rs[(t) - t0 + 8] * gn)
        int lo = t0 - half; if (lo < 0) lo = 0;
        int hi = t0 + half; if (hi > S_) hi = S_;
        f32x4 sum = (f32x4){0.f, 0.f, 0.f, 0.f};
        for (int u = lo; u < hi; ++u) sum += HN(u);
#pragma unroll 8
        for (int i = 0; i < 64; ++i) {
            const int t = t0 + i;
            const f32x4 x = HN(t);
            const float inv = 1.f / (float)(hi - lo);
            const f32x4 o = sum * inv - x;
            u32x2 wv; wv.x = cvt_pk_bf16(o.x, o.y); wv.y = cvt_pk_bf16(o.z, o.w);
            *(u32x2*)(outp + ((size_t)b * S_ + t) * D_ + c) = wv;
            if (i < 63) {
                if (t + 1 - half > 0) { sum -= HN(lo); ++lo; }
                if (t + half < S_) { sum += HN(t + half); ++hi; }
            }
        }
#undef HN
    }
}

constexpr int BM = 256, BK = 64, HALF = 128, HTB = HALF * BK * 2;
__device__ __forceinline__ int lds_byte(int r, int c) { const int st = (r >> 4) * 2 + (c >> 5), rr = r & 15, cc = c & 31, ob = rr * 64 + cc * 2; return st * 1024 + (ob ^ (((ob >> 9) & 1) << 5)); }
__device__ __forceinline__ void stage_rc(int b, int& R, int& C) { const int st = b / 1024, sb = b % 1024, swz = sb ^ (((sb >> 9) & 1) << 5); R = (st >> 1) * 16 + swz / 64; C = (st & 1) * 32 + (swz % 64) / 2; }
__device__ __forceinline__ int perm32(int rho) { const int n = rho >> 4, i = rho & 15; return 8 * (i >> 2) + 4 * n + (i & 3); }

struct Unit { const char* a; const char* b; int pm, pn, job; };

__device__ __forceinline__ void remap_tile(int l, int nM, int nN, int& pm, int& pn, int wgm = 8) {
    const int nwg = nM * nN; int wgid = l;
    { const int q = nwg / 8, r = nwg % 8, xcd = wgid % 8, off = wgid / 8; wgid = (xcd < r ? xcd * (q + 1) : r * (q + 1) + (xcd - r) * q) + off; }
    const int nig = wgm * nN, gid = wgid / nig, fm = gid * wgm, gsz = (nM - fm) < wgm ? (nM - fm) : wgm;
    pm = fm + ((wgid % nig) % gsz); pn = (wgid % nig) / gsz;
}

template <class Epi, class Sched>
__device__ __forceinline__ void gemm_phase(LAS unsigned char* lds, const int tid, const int K, const int lda, const int ldb, const Sched& S, const Epi& E) {
    const int wid = __builtin_amdgcn_readfirstlane(tid >> 6), lane = tid & 63, wr = wid >> 2, wc = wid & 3, fr = lane & 15, fq = lane >> 4;
    const int nt = K / BK;
    unsigned voffA, voffB;
    { int R, C; stage_rc(tid * 16, R, C); const int Rb = Epi::PERM ? ((R & ~31) + perm32(R & 31)) : R;
        voffA = (unsigned)(R * lda + C) * 2u; voffB = (unsigned)(Rb * ldb + C) * 2u; }
    const size_t q64A = (size_t)64 * lda * 2, q64B = (size_t)64 * ldb * 2;
    const size_t kstep = (size_t)(BK * 2);
    const size_t hstepA = (size_t)HALF * lda * 2, hstepB = (size_t)HALF * ldb * 2;
    const unsigned ldsw = (unsigned)wid * 1024u;
    const int aoff = lds_byte(wr * 64 + fr, fq * 8), boff = lds_byte(wc * 32 + fr, fq * 8);
#define PG8_SA(b, h) (((b) * 2 + (h)) * HTB)
#define PG8_SB(b, h) ((4 + (b) * 2 + (h)) * HTB)
#define PG8_STAGE(bufoff, gbase, voff) do { \
        __builtin_amdgcn_global_load_lds((const unsigned*)((const char*)(gbase) + (voff)), (LAS unsigned*)(lds + (bufoff) + ldsw), 16, 0, 0); \
        __builtin_amdgcn_global_load_lds((const unsigned*)((const char*)(gbase) + q64_##voff + (voff)), (LAS unsigned*)(lds + (bufoff) + ldsw + 8192), 16, 0, 0); } while (0)
#define q64_voffA q64A
#define q64_voffB q64B
#define PG8_LDA(dst, b, h) do { _Pragma("unroll") for (int m = 0; m < 4; ++m) _Pragma("unroll") for (int k = 0; k < 2; ++k) dst[m][k] = *(const LAS bf16x8*)(lds + PG8_SA(b, h) + aoff + m * 2048 + k * 1024); } while (0)
#define PG8_LDB(dst, b, h) do { _Pragma("unroll") for (int n = 0; n < 2; ++n) _Pragma("unroll") for (int k = 0; k < 2; ++k) dst[n][k] = *(const LAS bf16x8*)(lds + PG8_SB(b, h) + boff + n * 2048 + k * 1024); } while (0)
#define PG8_MMA(ai, bj, At, Bt) do { __builtin_amdgcn_s_setprio(1); _Pragma("unroll") for (int m = 0; m < 4; ++m) _Pragma("unroll") for (int n = 0; n < 2; ++n) _Pragma("unroll") for (int k = 0; k < 2; ++k) \
        acc[ai][bj][m][n] = __builtin_amdgcn_mfma_f32_16x16x32_bf16(Bt[n][k], At[m][k], acc[ai][bj][m][n], 0, 0, 0); __builtin_amdgcn_s_setprio(0); } while (0)
#define PG8_WAIT_V(n) asm volatile("s_waitcnt vmcnt(" #n ")" ::: "memory")
#define PG8_WAIT_L(n) asm volatile("s_waitcnt lgkmcnt(" #n ")" ::: "memory")
#define PG8_BAR __builtin_amdgcn_s_barrier()
#define PG8_SCHED __builtin_amdgcn_sched_barrier(0)
    Unit cur, nxt; int ui = 0;
    if (!S.next(0, cur)) return;
    f32x4 acc[2][2][4][2];
#pragma unroll
    for (int a = 0; a < 2; ++a)
#pragma unroll
        for (int b = 0; b < 2; ++b)
#pragma unroll
            for (int m = 0; m < 4; ++m)
#pragma unroll
                for (int n = 0; n < 2; ++n) acc[a][b][m][n] = (f32x4){0.f, 0.f, 0.f, 0.f};
    bf16x8 At[4][2], B0[2][2], B1[2][2];
    const char* cA = cur.a; const char* cB = cur.b;
    PG8_STAGE(PG8_SB(0, 0), cB, voffB); PG8_STAGE(PG8_SA(0, 0), cA, voffA); PG8_STAGE(PG8_SB(0, 1), cB + hstepB, voffB); PG8_STAGE(PG8_SA(0, 1), cA + hstepA, voffA);
    if (wr == 1) PG8_BAR;
    PG8_WAIT_V(4); PG8_BAR;
    PG8_STAGE(PG8_SB(1, 0), cB + kstep, voffB); PG8_STAGE(PG8_SA(1, 0), cA + kstep, voffA); PG8_STAGE(PG8_SB(1, 1), cB + hstepB + kstep, voffB);
    PG8_WAIT_V(6); PG8_BAR;
    for (;;) {
        const bool has_next = S.next(ui + 1, nxt);
        const char* nA = has_next ? nxt.a : cA; const char* nB = has_next ? nxt.b : cB;
        for (int t = 0; t < nt; t += 2) {
            const bool last = (t == nt - 2);
            const char* a1 = cA + (size_t)(t + 1) * kstep;
            const char* a2 = last ? nA : cA + (size_t)(t + 2) * kstep; const char* b2 = last ? nB : cB + (size_t)(t + 2) * kstep;
            const char* a3 = a2 + kstep; const char* b3 = b2 + kstep;
            PG8_LDB(B0, 0, 0); PG8_SCHED; PG8_LDA(At, 0, 0); PG8_STAGE(PG8_SA(1, 1), a1 + hstepA, voffA);
            PG8_WAIT_L(8); PG8_BAR; PG8_WAIT_L(0); PG8_MMA(0, 0, At, B0); PG8_BAR; PG8_SCHED;
            PG8_LDB(B1, 0, 1); PG8_STAGE(PG8_SB(0, 0), b2, voffB);
            PG8_BAR; PG8_WAIT_L(0); PG8_MMA(0, 1, At, B1); PG8_BAR;
            PG8_LDA(At, 0, 1); PG8_STAGE(PG8_SA(0, 0), a2, voffA);
            PG8_BAR; PG8_WAIT_L(0); PG8_MMA(1, 0, At, B0); PG8_BAR; PG8_SCHED;
            PG8_STAGE(PG8_SB(0, 1), b2 + hstepB, voffB);
            PG8_WAIT_V(6); PG8_BAR; PG8_MMA(1, 1, At, B1); PG8_BAR;
            PG8_LDB(B0, 1, 0); PG8_SCHED; PG8_LDA(At, 1, 0); PG8_STAGE(PG8_SA(0, 1), a2 + hstepA, voffA);
            PG8_WAIT_L(8); PG8_BAR; PG8_WAIT_L(0); PG8_MMA(0, 0, At, B0); PG8_BAR; PG8_SCHED;
            PG8_LDB(B1, 1, 1); PG8_STAGE(PG8_SB(1, 0), b3, voffB);
            PG8_BAR; PG8_WAIT_L(0); PG8_MMA(0, 1, At, B1); PG8_BAR;
            PG8_LDA(At, 1, 1); PG8_STAGE(PG8_SA(1, 0), a3, voffA);
            PG8_BAR; PG8_WAIT_L(0); PG8_MMA(1, 0, At, B0); PG8_BAR; PG8_SCHED;
            PG8_STAGE(PG8_SB(1, 1), b3 + hstepB, voffB);
            PG8_WAIT_V(6); PG8_BAR; PG8_MMA(1, 1, At, B1); PG8_BAR;
        }
        { int ln = lane; asm volatile("" : "+v"(ln)); E(acc, cur, wr, wc, ln & 15, ln >> 4); }
        if (!has_next) break;
#pragma unroll
        for (int a = 0; a < 2; ++a)
#pragma unroll
            for (int b = 0; b < 2; ++b)
#pragma unroll
                for (int m = 0; m < 4; ++m)
#pragma unroll
                    for (int n = 0; n < 2; ++n) acc[a][b][m][n] = (f32x4){0.f, 0.f, 0.f, 0.f};
        cur = nxt; cA = nA; cB = nB; ++ui;
    }
    PG8_WAIT_V(0);
    if (wr == 0) PG8_BAR;
    PG8_BAR;
#undef PG8_SA
#undef PG8_SB
#undef PG8_STAGE
#undef q64_voffA
#undef q64_voffB
#undef PG8_LDA
#undef PG8_LDB
#undef PG8_MMA
#undef PG8_WAIT_V
#undef PG8_WAIT_L
#undef PG8_BAR
#undef PG8_SCHED
}

struct SchedSimple {
    const char* A; const char* Bt; int nM, nN, G, c, poolmode, wgm; size_t tstepA, tstepB;
    __device__ __forceinline__ bool next(int i, Unit& u) const {
        const int L = i * G + c; if (L >= nM * nN) return false;
        int pm, pn; remap_tile(L, nM, nN, pm, pn, wgm);
        u.a = A + (size_t)pm * tstepA + (poolmode ? (size_t)(pn >> 1) * 1024 : 0); u.b = Bt + (size_t)pn * tstepB; u.pm = pm; u.pn = pn; u.job = 0; return true;
    }
};
struct SchedProj {
    const char* ws; int G, c;
    __device__ __forceinline__ bool next(int i, Unit& u) const {
        const int L = i * G + c; if (L >= 1728) return false;
        int job, l, nN; size_t bo, ao;
        if (L < 1536) { job = L >> 9; l = L & 511; nN = 8; bo = job == 0 ? O_WRT : (job == 1 ? O_WKT : O_WVT); ao = job == 0 ? 0 : (job == 1 ? 2 : 3); }
        else { const int q = L - 1536; job = 3 + (q >> 6); l = q & 63; nN = 1; bo = job == 3 ? O_W1C : (job == 4 ? O_A1C : O_G1C); ao = job == 3 ? 1 : (job == 4 ? 4 : 5); }
        int pm, pn; remap_tile(l, 64, nN, pm, pn, nN == 8 ? 4 : 8);
        u.a = ws + O_X6 + ao * (64 * MiB) + (size_t)pm * (256 * 2048 * 2); u.b = ws + bo + (size_t)pn * (256 * 2048 * 2); u.pm = pm; u.pn = pn; u.job = job; return true;
    }
};
struct SchedLora2 {
    const char* ws; int G, c;
    __device__ __forceinline__ bool next(int i, Unit& u) const {
        const int L = i * G + c; if (L >= 2560) return false;
        const int job = L >> 9, l = L & 511;
        const size_t ao = job < 2 ? O_LW : (job < 4 ? O_LA : O_LG);
        const size_t bo = job == 0 ? O_W2T0 : (job == 1 ? O_W2T1 : (job == 2 ? O_A2T0 : (job == 3 ? O_A2T1 : O_G2T)));
        int pm, pn; remap_tile(l, 64, 8, pm, pn, 4);
        u.a = ws + ao + (size_t)pm * (256 * 256 * 2); u.b = ws + bo + (size_t)pn * (256 * 256 * 2); u.pm = pm; u.pn = pn; u.job = job; return true;
    }
};

struct EpiSwiGLU {
    static constexpr bool PERM = true;
    bf16_t* U;
    __device__ __forceinline__ void operator()(const f32x4 (&acc)[2][2][4][2], const Unit& u, int wr, int wc, int fr, int fq) const {
        const int row0 = u.pm * BM + wr * 64 + fr, col0 = u.pn * 128 + wc * 32 + 8 * fq;
#pragma unroll
        for (int ai = 0; ai < 2; ++ai)
#pragma unroll
            for (int m = 0; m < 4; ++m) {
                bf16_t* rowp = U + (size_t)(row0 + ai * HALF + m * 16) * F_ + col0;
                float o[8];
#pragma unroll
                for (int n = 0; n < 2; ++n)
#pragma unroll
                    for (int j = 0; j < 4; ++j) { const float g = acc[ai][0][m][n][j], up = acc[ai][1][m][n][j]; o[4 * n + j] = g * sigmoidf_(g) * up; }
                u32x4 w; w.x = cvt_pk_bf16(o[0], o[1]); w.y = cvt_pk_bf16(o[2], o[3]); w.z = cvt_pk_bf16(o[4], o[5]); w.w = cvt_pk_bf16(o[6], o[7]);
                *(u32x4*)rowp = w;
            }
    }
};
struct EpiResid {
    static constexpr bool PERM = false;
    const float* src; float* dst; const float* colscale; float scale;
    __device__ __forceinline__ void operator()(const f32x4 (&acc)[2][2][4][2], const Unit& u, int wr, int wc, int fr, int fq) const {
        const int row0 = u.pm * BM + wr * 64 + fr, col0 = u.pn * BM + wc * 32 + 4 * fq;
        f32x4 sv[2][2];
#pragma unroll
        for (int bj = 0; bj < 2; ++bj)
#pragma unroll
            for (int n = 0; n < 2; ++n) sv[bj][n] = colscale ? *(const f32x4*)(colscale + col0 + bj * HALF + n * 16) * scale : (f32x4){scale, scale, scale, scale};
#pragma unroll
        for (int ai = 0; ai < 2; ++ai) {
            f32x4 base[4][2][2];
#pragma unroll
            for (int m = 0; m < 4; ++m)
#pragma unroll
                for (int bj = 0; bj < 2; ++bj)
#pragma unroll
                    for (int n = 0; n < 2; ++n) base[m][bj][n] = *(const f32x4*)(src + (size_t)(row0 + ai * HALF + m * 16) * D_ + col0 + bj * HALF + n * 16);
            __builtin_amdgcn_sched_barrier(0);
#pragma unroll
            for (int m = 0; m < 4; ++m)
#pragma unroll
                for (int bj = 0; bj < 2; ++bj)
#pragma unroll
                    for (int n = 0; n < 2; ++n) *(f32x4*)(dst + (size_t)(row0 + ai * HALF + m * 16) * D_ + col0 + bj * HALF + n * 16) = base[m][bj][n] + acc[ai][bj][m][n] * sv[bj][n];
            __builtin_amdgcn_sched_barrier(0);
        }
    }
};
struct EpiProj {
    static constexpr bool PERM = true;
    unsigned char* ws;
    __device__ __forceinline__ void operator()(const f32x4 (&acc)[2][2][4][2], const Unit& u, int wr, int wc, int fr, int fq) const {
        const int job = u.job;
        const int row0 = u.pm * BM + wr * 64 + fr, col0 = u.pn * BM + wc * 32 + 8 * fq;
        const size_t obase = job == 0 ? O_R : (job == 1 ? O_K : (job == 2 ? O_V : (job == 3 ? O_LW : (job == 4 ? O_LA : O_LG))));
        const int ldc = job < 3 ? D_ : 256;
        unsigned short* outp = (unsigned short*)(ws + obase) + (size_t)row0 * ldc + col0;
        const float c0 = job == 3 ? 1.f : 0.f, c1 = job == 3 ? -2.f : 1.f, c2 = job == 3 ? 2.f : -1.f;
        const bool act = (job == 3) || (job == 5), f16 = job < 3;
#pragma unroll
        for (int ai = 0; ai < 2; ++ai)
#pragma unroll
            for (int m = 0; m < 4; ++m) {
                unsigned short* rowp = outp + (size_t)(ai * HALF + m * 16) * ldc;
#pragma unroll
                for (int bj = 0; bj < 2; ++bj) {
                    f32x4 v0 = acc[ai][bj][m][0], v1 = acc[ai][bj][m][1];
                    if (act) {
#pragma unroll
                        for (int j = 0; j < 4; ++j) { v0[j] = c0 + c1 * __builtin_amdgcn_rcpf(1.f + __expf(c2 * v0[j])); v1[j] = c0 + c1 * __builtin_amdgcn_rcpf(1.f + __expf(c2 * v1[j])); }
                    }
                    u32x4 w;
                    if (f16) { w.x = pk_h2(v0[0], v0[1]); w.y = pk_h2(v0[2], v0[3]); w.z = pk_h2(v1[0], v1[1]); w.w = pk_h2(v1[2], v1[3]); }
                    else { w.x = cvt_pk_bf16(v0[0], v0[1]); w.y = cvt_pk_bf16(v0[2], v0[3]); w.z = cvt_pk_bf16(v1[0], v1[1]); w.w = cvt_pk_bf16(v1[2], v1[3]); }
                    *(u32x4*)(rowp + bj * HALF) = w;
                }
            }
    }
};
struct EpiLora2 {
    static constexpr bool PERM = true;
    unsigned char* ws; const float* w0; const float* a0;
    __device__ __forceinline__ void operator()(const f32x4 (&acc)[2][2][4][2], const Unit& u, int wr, int wc, int fr, int fq) const {
        const int job = u.job;
        const int row0 = u.pm * BM + wr * 64 + fr, col0 = u.pn * BM + wc * 32 + 8 * fq;
        const size_t obase = job == 0 ? O_E0 : (job == 1 ? O_E1 : (job == 2 ? O_A0 : (job == 3 ? O_A1 : O_G)));
        unsigned short* outp = (unsigned short*)(ws + obase) + (size_t)row0 * D_ + col0;
        const float* bias = (job < 2 ? (w0 + (size_t)job * D_) : (a0 + (size_t)(job & 1) * D_)) + col0;
        const float osc = job < 2 ? 0.60653065971f : 1.f;
        const bool act = job < 4;
#pragma unroll
        for (int bj = 0; bj < 2; ++bj) {
            f32x4 b0 = (f32x4){0.f, 0.f, 0.f, 0.f}, b1 = b0;
            if (act) { b0 = *(const f32x4*)(bias + bj * HALF); b1 = *(const f32x4*)(bias + bj * HALF + 4); }
#pragma unroll
            for (int ai = 0; ai < 2; ++ai)
#pragma unroll
                for (int m = 0; m < 4; ++m) {
                    unsigned short* rowp = outp + (size_t)(ai * HALF + m * 16) * D_;
                    f32x4 v0 = acc[ai][bj][m][0] + b0, v1 = acc[ai][bj][m][1] + b1;
                    if (act) {
#pragma unroll
                        for (int j = 0; j < 4; ++j) { v0[j] = osc * sigmoidf_(v0[j]); v1[j] = osc * sigmoidf_(v1[j]); }
                    }
                    u32x4 w; w.x = pk_h2(v0[0], v0[1]); w.y = pk_h2(v0[2], v0[3]); w.z = pk_h2(v1[0], v1[1]); w.w = pk_h2(v1[2], v1[3]);
                    *(u32x4*)(rowp + bj * HALF) = w;
                    __builtin_amdgcn_sched_barrier(0);
                }
        }
    }
};

constexpr int SC_T = 32;
constexpr int SC_AV = 0, SC_WR = SC_T * 32 * 4, SC_W = 2 * SC_T * 32 * 4, SC_BK = SC_W + SC_T * 64 * 4, SC_V = SC_BK + SC_T * 64 * 4, SC_SC = SC_V + SC_T * 64 * 4, SC_Y = SC_SC + SC_T * 2 * 4, SC_A = SC_Y + SC_T * 64 * 4, SC_BUF = SC_A + SC_T * 64 * 4;
constexpr int SC_ZERO = 2 * SC_BUF;
typedef _Float16 half2_t __attribute__((ext_vector_type(2)));
__device__ __forceinline__ float dot2h(unsigned a, unsigned b, float c) { return __builtin_amdgcn_fdot2(__builtin_bit_cast(half2_t, a), __builtin_bit_cast(half2_t, b), c, false); }
__device__ __forceinline__ void red8x4(float& a, float& b, float& c, float& d) {
    asm volatile("s_nop 1\n\t"
                 "v_add_f32_dpp %0, %0, %0 quad_perm:[1,0,3,2] row_mask:0xf bank_mask:0xf\n\t"
                 "v_add_f32_dpp %1, %1, %1 quad_perm:[1,0,3,2] row_mask:0xf bank_mask:0xf\n\t"
                 "v_add_f32_dpp %2, %2, %2 quad_perm:[1,0,3,2] row_mask:0xf bank_mask:0xf\n\t"
                 "v_add_f32_dpp %3, %3, %3 quad_perm:[1,0,3,2] row_mask:0xf bank_mask:0xf\n\t"
                 "v_add_f32_dpp %0, %0, %0 quad_perm:[2,3,0,1] row_mask:0xf bank_mask:0xf\n\t"
                 "v_add_f32_dpp %1, %1, %1 quad_perm:[2,3,0,1] row_mask:0xf bank_mask:0xf\n\t"
                 "v_add_f32_dpp %2, %2, %2 quad_perm:[2,3,0,1] row_mask:0xf bank_mask:0xf\n\t"
                 "v_add_f32_dpp %3, %3, %3 quad_perm:[2,3,0,1] row_mask:0xf bank_mask:0xf\n\t"
                 "v_add_f32_dpp %0, %0, %0 row_half_mirror row_mask:0xf bank_mask:0xf\n\t"
                 "v_add_f32_dpp %1, %1, %1 row_half_mirror row_mask:0xf bank_mask:0xf\n\t"
                 "v_add_f32_dpp %2, %2, %2 row_half_mirror row_mask:0xf bank_mask:0xf\n\t"
                 "v_add_f32_dpp %3, %3, %3 row_half_mirror row_mask:0xf bank_mask:0xf"
                 : "+v"(a), "+v"(b), "+v"(c), "+v"(d));
}
__device__ __forceinline__ void scan_phase(const Params& p, unsigned char* ws, LAS unsigned char* lds, int tid, int lane, int wave, int bid, int nb) {
    const float* k_k = pin(p, 25); const float* k_a = pin(p, 26); const float* r_k = pin(p, 27);
    for (int chain = bid; chain < 256; chain += nb) {
        const int d = chain & 1, hh = (chain >> 1) & 31, b = chain >> 6;
        const unsigned short* Rg = (const unsigned short*)(ws + O_R);
        const unsigned short* Kg = (const unsigned short*)(ws + O_K);
        const unsigned short* Vg = (const unsigned short*)(ws + O_V);
        unsigned short* Eg = (unsigned short*)(ws + (d ? O_E1 : O_E0));
        const unsigned short* Ag = (const unsigned short*)(ws + (d ? O_A1 : O_A0));
        float* BSg = (float*)(ws + O_BS) + (size_t)d * M_ * NH_;
        __syncthreads();
        if (wave >= 4) {
            const int lid = tid - 256, s = lid >> 3, j0 = 8 * (lid & 7), ch = hh * 64 + j0;
            float kkc[8], kac[8], rkc[8];
#pragma unroll
            for (int i = 0; i < 8; ++i) { kkc[i] = k_k[ch + i]; kac[i] = k_a[ch + i]; rkc[i] = r_k[ch + i]; }
            if (lid < 32) ((LAS unsigned*)(lds + SC_ZERO))[lid] = 0u;
            h8 r8, k8, v8, e8, a8;
            { const int t = d ? (S_ - 1 - s) : s; const size_t off = ((size_t)b * S_ + t) * D_ + ch;
              r8 = *(const h8*)(Rg + off); k8 = *(const h8*)(Kg + off); v8 = *(const h8*)(Vg + off); e8 = *(const h8*)(Eg + off); a8 = *(const h8*)(Ag + off); }
            for (int ci = -1; ci < S_ / SC_T; ++ci) {
                if (ci >= 1) {
                    const int cj = ci - 1; const int st = cj * SC_T + s; const int t = d ? (S_ - 1 - st) : st;
                    const LAS unsigned char* fb = lds + (cj & 1) * SC_BUF;
                    const LAS float* yb = (const LAS float*)(fb + SC_Y) + s * 64 + j0; const LAS float* ab = (const LAS float*)(fb + SC_A) + s * 64 + j0; const LAS float* vv = (const LAS float*)(fb + SC_V) + s * 64 + j0;
                    const f32x2 bk2 = *(const LAS f32x2*)((const LAS float*)(fb + SC_SC) + s * 2);
                    const f32x4 y0 = *(const LAS f32x4*)yb + *(const LAS f32x4*)ab * bk2.x + *(const LAS f32x4*)vv * bk2.y, y1 = *(const LAS f32x4*)(yb + 4) + *(const LAS f32x4*)(ab + 4) * bk2.x + *(const LAS f32x4*)(vv + 4) * bk2.y;
                    u32x4 w; w.x = cvt_pk_bf16(y0.x, y0.y); w.y = cvt_pk_bf16(y0.z, y0.w); w.z = cvt_pk_bf16(y1.x, y1.y); w.w = cvt_pk_bf16(y1.z, y1.w);
                    *(u32x4*)(Eg + ((size_t)b * S_ + t) * D_ + ch) = w;
                }
                if (ci + 1 < S_ / SC_T) {
                    const int cj = ci + 1; const int st = cj * SC_T + s; const int t = d ? (S_ - 1 - st) : st;
                    const size_t m = (size_t)b * S_ + t;
                    h8 r8n = r8, k8n = k8, v8n = v8, e8n = e8, a8n = a8;
                    if (cj + 1 < S_ / SC_T) {
                        const int st2 = (cj + 1) * SC_T + s; const int t2 = d ? (S_ - 1 - st2) : st2; const size_t off2 = ((size_t)b * S_ + t2) * D_ + ch;
                        r8n = *(const h8*)(Rg + off2); k8n = *(const h8*)(Kg + off2); v8n = *(const h8*)(Vg + off2); e8n = *(const h8*)(Eg + off2); a8n = *(const h8*)(Ag + off2);
                    }
                    float kk[8], ss = 0.f;
#pragma unroll
                    for (int i = 0; i < 8; ++i) { kk[i] = (float)k8[i] * kkc[i]; ss += kk[i] * kk[i]; }
                    ss = red8(ss);
                    const float inv = fminf(__builtin_amdgcn_rsqf(ss), 1e12f);
                    float ps[8];
                    const int wl = lid & 63;
#pragma unroll
                    for (int i = 0; i < 8; ++i) ps[i] = (float)e8[i];
#pragma unroll
                    for (int dd = 8; dd < 64; dd <<= 1) {
#pragma unroll
                        for (int i = 0; i < 8; ++i) { const float tup = __shfl_up(ps[i], dd); ps[i] += (wl >= dd) ? tup : 0.f; }
                    }
                    float av[8], wv[8], bb[8], kd[8], wrr[8], br = 0.f, kr = 0.f, bsum = 0.f;
#pragma unroll
                    for (int i = 0; i < 8; ++i) {
                        const float rr = (float)r8[i], kf = (float)k8[i], af = (float)a8[i], ei = (float)e8[i];
                        const float Pt = __expf(-ps[i]), Pm = __expf(ei - ps[i]), iP = __expf(ps[i]);
                        kk[i] *= inv; const float bt = kk[i] * af, kt = kf * (1.f + (af - 1.f) * kac[i]);
                        br += bt * rr; kr += kt * rr; bsum += rr * kt * rkc[i];
                        av[i] = -kk[i] * Pm; wrr[i] = Pt * rr; bb[i] = bt * iP; kd[i] = kt * iP; wv[i] = Pt;
                    }
                    br = red8(br); kr = red8(kr); bsum = red8(bsum);
                    LAS unsigned char* buf = lds + (cj & 1) * SC_BUF;
                    *(LAS u32x4*)((LAS unsigned*)(buf + SC_AV) + s * 32 + (j0 >> 1)) = (u32x4){pk_h2(av[0], av[1]), pk_h2(av[2], av[3]), pk_h2(av[4], av[5]), pk_h2(av[6], av[7])};
                    *(LAS u32x4*)((LAS unsigned*)(buf + SC_WR) + s * 32 + (j0 >> 1)) = (u32x4){pk_h2(wrr[0], wrr[1]), pk_h2(wrr[2], wrr[3]), pk_h2(wrr[4], wrr[5]), pk_h2(wrr[6], wrr[7])};
                    if ((s & 7) == 7) { LAS float* wp = (LAS float*)(buf + SC_W) + (s >> 3) * 64 + j0;
                      *(LAS f32x4*)wp = (f32x4){wv[0], wv[1], wv[2], wv[3]}; *(LAS f32x4*)(wp + 4) = (f32x4){wv[4], wv[5], wv[6], wv[7]}; }
                    LAS unsigned* bkp = (LAS unsigned*)(buf + SC_BK) + s * 64 + j0;
                    *(LAS u32x4*)bkp = (u32x4){pk_h2(bb[0], kd[0]), pk_h2(bb[1], kd[1]), pk_h2(bb[2], kd[2]), pk_h2(bb[3], kd[3])};
                    *(LAS u32x4*)(bkp + 4) = (u32x4){pk_h2(bb[4], kd[4]), pk_h2(bb[5], kd[5]), pk_h2(bb[6], kd[6]), pk_h2(bb[7], kd[7])};
                    LAS float* vb = (LAS float*)(buf + SC_V) + s * 64 + j0;
                    *(LAS f32x4*)vb = (f32x4){(float)v8[0], (float)v8[1], (float)v8[2], (float)v8[3]}; *(LAS f32x4*)(vb + 4) = (f32x4){(float)v8[4], (float)v8[5], (float)v8[6], (float)v8[7]};
                    if ((lid & 7) == 0) { *(LAS f32x2*)((LAS float*)(buf + SC_SC) + s * 2) = (f32x2){br, kr}; BSg[m * NH_ + hh] = bsum; }
                    r8 = r8n; k8 = k8n; v8 = v8n; e8 = e8n; a8 = a8n;
                }
                __syncthreads();
            }
            {
                const int cj = S_ / SC_T - 1; const int st = cj * SC_T + s; const int t = d ? (S_ - 1 - st) : st;
                const LAS unsigned char* fb = lds + (cj & 1) * SC_BUF;
                const LAS float* yb = (const LAS float*)(fb + SC_Y) + s * 64 + j0; const LAS float* ab = (const LAS float*)(fb + SC_A) + s * 64 + j0; const LAS float* vv = (const LAS float*)(fb + SC_V) + s * 64 + j0;
                const f32x2 bk2 = *(const LAS f32x2*)((const LAS float*)(fb + SC_SC) + s * 2);
                const f32x4 y0 = *(const LAS f32x4*)yb + *(const LAS f32x4*)ab * bk2.x + *(const LAS f32x4*)vv * bk2.y, y1 = *(const LAS f32x4*)(yb + 4) + *(const LAS f32x4*)(ab + 4) * bk2.x + *(const LAS f32x4*)(vv + 4) * bk2.y;
                u32x4 w; w.x = cvt_pk_bf16(y0.x, y0.y); w.y = cvt_pk_bf16(y0.z, y0.w); w.z = cvt_pk_bf16(y1.x, y1.y); w.w = cvt_pk_bf16(y1.z, y1.w);
                *(u32x4*)(Eg + ((size_t)b * S_ + t) * D_ + ch) = w;
            }
        } else {
            const int rl = lane & 15, g = lane >> 4, row = 16 * wave + rl, m4 = rl & 3;
            f32x2 S[8];
#pragma unroll
            for (int q = 0; q < 8; ++q) S[q] = (f32x2){0.f, 0.f};
            __syncthreads();
            for (int ci = 0; ci < S_ / SC_T; ++ci) {
                const LAS unsigned char* buf = lds + (ci & 1) * SC_BUF;
                const LAS unsigned char* xb = (m4 == 0 ? buf + SC_AV : (m4 == 1 ? buf + SC_WR : lds + SC_ZERO)) + 16 * g;
                const int xs = m4 < 2 ? 128 : 0;
                const LAS float* wb = (const LAS float*)(buf + SC_W) + 8 * g;
                const LAS unsigned* bkb = (const LAS unsigned*)(buf + SC_BK) + 8 * g;
                const LAS float* vb = (const LAS float*)(buf + SC_V) + row;
                LAS float* yb = (LAS float*)(lds + (ci & 1) * SC_BUF + SC_Y) + row;
#define SC_LOAD(P, s) do { \
                    P##x1 = *(const LAS h8*)(xb + (s) * xs); P##x2 = *(const LAS h8*)(xb + (s) * xs + 64); \
                                        P##k0 = *(const LAS u32x4*)(bkb + (s) * 64); P##k1 = *(const LAS u32x4*)(bkb + (s) * 64 + 4); P##k2 = *(const LAS u32x4*)(bkb + (s) * 64 + 32); P##k3 = *(const LAS u32x4*)(bkb + (s) * 64 + 36); \
                    P##v = *(vb + (s) * 64); } while (0)
#define SC_STEP(P, s) do { \
                    const u32x4 b1u = (u32x4){pk_h2(S[0].x, S[0].y), pk_h2(S[1].x, S[1].y), pk_h2(S[2].x, S[2].y), pk_h2(S[3].x, S[3].y)}; \
                    const u32x4 b2u = (u32x4){pk_h2(S[4].x, S[4].y), pk_h2(S[5].x, S[5].y), pk_h2(S[6].x, S[6].y), pk_h2(S[7].x, S[7].y)}; \
                    f32x4 acc = __builtin_amdgcn_mfma_f32_16x16x32_f16(P##x1, __builtin_bit_cast(h8, b1u), (f32x4){0.f, 0.f, 0.f, 0.f}, 0, 0, 0); \
                    acc = __builtin_amdgcn_mfma_f32_16x16x32_f16(P##x2, __builtin_bit_cast(h8, b2u), acc, 0, 0, 0); \
                    f32x2 t; \
                    const unsigned hh0 = pk_h2(acc[0], P##v); \
                    S[0].x = dot2h(hh0, P##k0.x, S[0].x); S[0].y = dot2h(hh0, P##k0.y, S[0].y); S[1].x = dot2h(hh0, P##k0.z, S[1].x); S[1].y = dot2h(hh0, P##k0.w, S[1].y); \
                    S[2].x = dot2h(hh0, P##k1.x, S[2].x); S[2].y = dot2h(hh0, P##k1.y, S[2].y); S[3].x = dot2h(hh0, P##k1.z, S[3].x); S[3].y = dot2h(hh0, P##k1.w, S[3].y); \
                    S[4].x = dot2h(hh0, P##k2.x, S[4].x); S[4].y = dot2h(hh0, P##k2.y, S[4].y); S[5].x = dot2h(hh0, P##k2.z, S[5].x); S[5].y = dot2h(hh0, P##k2.w, S[5].y); \
                    S[6].x = dot2h(hh0, P##k3.x, S[6].x); S[6].y = dot2h(hh0, P##k3.y, S[6].y); S[7].x = dot2h(hh0, P##k3.z, S[7].x); S[7].y = dot2h(hh0, P##k3.w, S[7].y); \
                    (void)t; if (g == 0) { *(yb + (s) * 64) = acc[1]; *(yb + (s) * 64 + SC_T * 64) = acc[0]; } } while (0)
                h8 Ax1, Ax2, Bx1, Bx2; u32x4 Ak0, Ak1, Ak2, Ak3, Bk0, Bk1, Bk2, Bk3; float Av, Bv;
                f32x4 p0 = {1.f, 1.f, 1.f, 1.f}, p1 = p0, p2 = p0, p3 = p0;
                SC_LOAD(A, 0);
                for (int s = 0; s < SC_T; s += 2) {
                    SC_LOAD(B, s + 1);
                    __builtin_amdgcn_sched_barrier(0);
                    SC_STEP(A, s);
                    __builtin_amdgcn_sched_barrier(0);
                    SC_LOAD(A, s + 2);
                    __builtin_amdgcn_sched_barrier(0);
                    SC_STEP(B, s + 1);
                    __builtin_amdgcn_sched_barrier(0);
                    if ((s & 7) == 2) {
                        const LAS float* pg = wb + (s >> 3) * 64;
                        p0 = *(const LAS f32x4*)pg; p1 = *(const LAS f32x4*)(pg + 4); p2 = *(const LAS f32x4*)(pg + 32); p3 = *(const LAS f32x4*)(pg + 36);
                    }
                    if ((s & 7) == 6) {
                        S[0] *= p0.xy; S[1] *= p0.zw; S[2] *= p1.xy; S[3] *= p1.zw; S[4] *= p2.xy; S[5] *= p2.zw; S[6] *= p3.xy; S[7] *= p3.zw;
                    }
                }
#undef SC_LOAD
#undef SC_STEP
                __syncthreads();
            }
        }
    }
}

__device__ __forceinline__ void post_phase(const Params& p, unsigned char* ws, int lane, int gw, int NGW) {
    const float* lnw = pin(p, 28); const float* lnb = pin(p, 29);
    const unsigned short* Y0 = (const unsigned short*)(ws + O_E0); const unsigned short* Y1 = (const unsigned short*)(ws + O_E1);
    const unsigned short* Vg = (const unsigned short*)(ws + O_V); const unsigned short* Gg = (const unsigned short*)(ws + O_G);
    const float* BS = (const float*)(ws + O_BS);
    unsigned short* P = (unsigned short*)(ws + O_POST);
    for (int m = gw; m < M_; m += NGW) {
#pragma unroll
        for (int j = 0; j < 4; ++j) {
            const int ch0 = 8 * (lane + 64 * j), head = ch0 >> 6;
            const size_t off = (size_t)m * D_ + ch0;
            const u32x4 a = *(const u32x4*)(Y0 + off), bq = *(const u32x4*)(Y1 + off);
            float ys[8];
            ys[0] = bf_lo(a.x) + bf_lo(bq.x); ys[1] = bf_hi(a.x) + bf_hi(bq.x); ys[2] = bf_lo(a.y) + bf_lo(bq.y); ys[3] = bf_hi(a.y) + bf_hi(bq.y);
            ys[4] = bf_lo(a.z) + bf_lo(bq.z); ys[5] = bf_hi(a.z) + bf_hi(bq.z); ys[6] = bf_lo(a.w) + bf_lo(bq.w); ys[7] = bf_hi(a.w) + bf_hi(bq.w);
            float s = 0.f;
#pragma unroll
            for (int i = 0; i < 8; ++i) s += ys[i];
            const float mean = red8(s) * (1.f / 64.f);
            float s2 = 0.f;
#pragma unroll
            for (int i = 0; i < 8; ++i) { ys[i] -= mean; s2 += ys[i] * ys[i]; }
            const float rs = rsqrtf(red8(s2) * (1.f / 64.f) + 64e-5f);
            const h8 v8 = *(const h8*)(Vg + off), g8 = *(const h8*)(Gg + off);
            const f32x4 w0 = *(const f32x4*)(lnw + ch0), w1 = *(const f32x4*)(lnw + ch0 + 4), b0 = *(const f32x4*)(lnb + ch0), b1 = *(const f32x4*)(lnb + ch0 + 4);
            const float bsum = BS[(size_t)m * NH_ + head] + BS[(size_t)M_ * NH_ + (size_t)m * NH_ + head];
            float o[8];
#pragma unroll
            for (int i = 0; i < 8; ++i) {
                const float lw = i < 4 ? w0[i] : w1[i - 4], lb = i < 4 ? b0[i] : b1[i - 4];
                o[i] = (ys[i] * rs * lw + lb + bsum * (float)v8[i]) * (float)g8[i];
            }
            u32x4 w; w.x = cvt_pk_bf16(o[0], o[1]); w.y = cvt_pk_bf16(o[2], o[3]); w.z = cvt_pk_bf16(o[4], o[5]); w.w = cvt_pk_bf16(o[6], o[7]);
            *(u32x4*)(P + off) = w;
        }
    }
}

__device__ __forceinline__ void ffn_g1(unsigned char* ws, LAS unsigned char* lds, int tid, int bid, int nb, size_t o_gu) {
    SchedSimple S; S.A = (const char*)(ws + O_XN); S.Bt = (const char*)(ws + o_gu); S.nM = 64; S.nN = 44; S.G = nb; S.c = bid; S.poolmode = 0; S.wgm = 8;
    S.tstepA = (size_t)256 * D_ * 2; S.tstepB = (size_t)256 * D_ * 2;
    EpiSwiGLU E; E.U = (bf16_t*)(ws + O_U);
    gemm_phase(lds, tid, D_, D_, D_, S, E);
}
__device__ __forceinline__ void gemm_resid(unsigned char* ws, float* hout, LAS unsigned char* lds, int tid, int bid, int nb, size_t o_a, int lda, size_t o_bt, int K, int poolmode, const float* src, const float* colscale, float scale) {
    SchedSimple S; S.A = (const char*)(ws + o_a); S.Bt = (const char*)(ws + o_bt); S.nM = 64; S.nN = 8; S.G = nb; S.c = bid; S.poolmode = poolmode; S.wgm = 4;
    S.tstepA = (size_t)256 * lda * 2; S.tstepB = (size_t)256 * K * 2;
    EpiResid E; E.src = src; E.dst = hout; E.colscale = colscale; E.scale = scale;
    gemm_phase(lds, tid, K, lda, K, S, E);
}

__global__ void __launch_bounds__(512) mega(Params p) {
    extern __shared__ __attribute__((aligned(16))) unsigned char smem[];
    LAS unsigned char* lds = (LAS unsigned char*)smem;
    cg::grid_group grid = cg::this_grid();
    XcdBarrier xb;
    {
        volatile LAS unsigned* st = (volatile LAS unsigned*)(lds + 131072);
        if (threadIdx.x == 0) { st[0] = 0u; st[1] = 0u; }
        __syncthreads();
        xb.bar = (unsigned*)(p.ws + O_BAR); xb.x = xb_xcc_id(); xb.st = st;
        if (threadIdx.x == 0) (void)xb_add(&xb.bar[XB_XCNT(xb.x)], 1u);
    }
    constexpr int nb = 256;
    const int wid_s = __builtin_amdgcn_readfirstlane((int)(threadIdx.x >> 6));
#define PROLOG int m1_ = -1; asm volatile("" : "+s"(m1_)); int tid = wid_s * 64 + (int)__builtin_amdgcn_mbcnt_hi(m1_, __builtin_amdgcn_mbcnt_lo(m1_, 0)); int bid = blockIdx.x; asm volatile("" : "+s"(bid)); \
        const int lane = tid & 63, wave = tid >> 6; const int gw = bid * 8 + wave, NGW = nb * 8; LAS float* scr = (LAS float*)(lds + wave * 8704); \
        unsigned char* ws = p.ws; asm volatile("" : "+s"(ws)); float* h = p.out; asm volatile("" : "+s"(h)); (void)lane; (void)gw; (void)NGW; (void)scr; (void)h; (void)ws;
    for (int ph = p.ph_lo; ph < p.ph_hi; ++ph) {
#if REP_MASK
      const int nrep = ((REP_MASK >> ph) & 1) + 1;
      for (int rep = 0; rep < nrep; ++rep) {
        const float rsc = (rep == nrep - 1) ? 1.f : 0.f;
        if (rep) grid.sync();
#else
      { constexpr float rsc = 1.f;
#endif
        switch (ph) {
        case 0: { PROLOG
            norm_phase<false>(pin(p, 0), pin(p, 1), (bf16_t*)(ws + O_XN), nullptr, lane, gw, NGW);
            conv_ffn(pin(p, 2), pin(p, 3), pin(p, 4), (bf16_t*)(ws + O_AGU), (bf16_t*)(ws + O_AD), scr, lane, gw, NGW);
            conv_ffn(pin(p, 7), pin(p, 8), pin(p, 9), (bf16_t*)(ws + O_BGU), (bf16_t*)(ws + O_BD), scr, lane, gw, NGW);
            conv_rwkv(p, ws, scr, lane, gw, NGW);
        } break;
        case 1: { PROLOG
            ffn_g1(ws, lds, tid, bid, nb, O_AGU);
        } break;
        case 2: { PROLOG
            gemm_resid(ws, h, lds, tid, bid, nb, O_U, F_, O_AD, F_, 0, pin(p, 0), nullptr, 0.5f * rsc);
        } break;
        case 3: { PROLOG
            pool_prep_phase(h, pin(p, 5), (bf16_t*)(ws + O_XN), lds, tid, lane, wave, bid, nb);
            __syncthreads();
            conv_ffn(pin(p, 2) + (size_t)D_ * F_, pin(p, 3) + (size_t)D_ * F_, pin(p, 4) + (size_t)D_ * F_, (bf16_t*)(ws + O_AGU), (bf16_t*)(ws + O_AD), scr, lane, gw, NGW);
        } break;
        case 4: { PROLOG
            gemm_resid(ws, h, lds, tid, bid, nb, O_XN, D_, O_POOLT, 512, 1, h, pin(p, 11), 1.f * rsc);
        } break;
        case 5: { PROLOG
            norm_phase<false>(h, pin(p, 6), (bf16_t*)(ws + O_XN), nullptr, lane, gw, NGW);
        } break;
        case 6: { PROLOG
            ffn_g1(ws, lds, tid, bid, nb, O_BGU);
        } break;
        case 7: { PROLOG
            gemm_resid(ws, h, lds, tid, bid, nb, O_U, F_, O_BD, F_, 0, h, nullptr, 0.5f * rsc);
        } break;
        case 8: { PROLOG
            norm_phase<false>(h, pin(p, 1) + D_, (bf16_t*)(ws + O_XN), nullptr, lane, gw, NGW);
        } break;
        case 9: { PROLOG
            ffn_g1(ws, lds, tid, bid, nb, O_AGU);
        } break;
        case 10: { PROLOG
            gemm_resid(ws, h, lds, tid, bid, nb, O_U, F_, O_AD, F_, 0, h, nullptr, 0.5f * rsc);
        } break;
        case 11: { PROLOG
            rwkv_prep_phase(h, pin(p, 5) + D_, pin(p, 12), (bf16_t*)(ws + O_X6), lane, gw, NGW);
        } break;
        case 12: { PROLOG
            {
            SchedProj S; S.ws = (const char*)ws; S.G = nb; S.c = bid;
            EpiProj E; E.ws = ws;
            gemm_phase(lds, tid, D_, D_, D_, S, E);
        }
        } break;
        case 13: { PROLOG
            {
            SchedLora2 S; S.ws = (const char*)ws; S.G = nb; S.c = bid;
            EpiLora2 E; E.ws = ws; E.w0 = pin(p, 17); E.a0 = pin(p, 20);
            gemm_phase(lds, tid, 256, 256, 256, S, E);
        }
        } break;
        case 14: { PROLOG
            scan_phase(p, ws, lds, tid, lane, wave, bid, nb);
        } break;
        case 15: { PROLOG
            post_phase(p, ws, lane, gw, NGW);
        } break;
        case 16: { PROLOG
            gemm_resid(ws, h, lds, tid, bid, nb, O_POST, D_, O_WOT, D_, 0, h, nullptr, 1.f * rsc);
        } break;
        case 17: { PROLOG
            norm_phase<false>(h, pin(p, 6) + D_, (bf16_t*)(ws + O_XN), nullptr, lane, gw, NGW);
            conv_ffn(pin(p, 7) + (size_t)D_ * F_, pin(p, 8) + (size_t)D_ * F_, pin(p, 9) + (size_t)D_ * F_, (bf16_t*)(ws + O_BGU), (bf16_t*)(ws + O_BD), scr, lane, gw, NGW);
        } break;
        case 18: { PROLOG
            ffn_g1(ws, lds, tid, bid, nb, O_BGU);
        } break;
        case 19: { PROLOG
            gemm_resid(ws, h, lds, tid, bid, nb, O_U, F_, O_BD, F_, 0, h, nullptr, 0.5f * rsc);
        } break;
        case 20: { PROLOG
            norm_phase<true>(h, pin(p, 30), nullptr, h, lane, gw, NGW);
        } break;
        default: break;
        }
      }
        if (ph + 1 < p.ph_hi) {
            if (p.ph_lo < 0) grid.sync();
            xcd_barrier(xb, threadIdx.x == 0);
        }
    }
}

extern "C" void kernel_launch(void* const* d_in, const int* in_sizes, int n_in, void* d_out, int out_size, void* d_ws, size_t ws_size, hipStream_t stream) {
    static int grid_blocks = 0;
    if (grid_blocks == 0) {
        if (n_in != 31 || out_size != M_ * D_ || ws_size < WS_NEED) { fprintf(stderr, "kernel_launch: unexpected shapes (n_in %d out %d ws %zu)\n", n_in, out_size, ws_size); grid_blocks = -1; return; }
        int dev = 0, cus = 0, per_cu = 0;
        hipGetDevice(&dev);
        hipDeviceGetAttribute(&cus, hipDeviceAttributeMultiprocessorCount, dev);
        if (hipFuncSetAttribute((const void*)mega, hipFuncAttributeMaxDynamicSharedMemorySize, LDS_BYTES) != hipSuccess) { fprintf(stderr, "kernel_launch: hipFuncSetAttribute failed\n"); grid_blocks = -1; return; }
        hipOccupancyMaxActiveBlocksPerMultiprocessor(&per_cu, (const void*)mega, 512, LDS_BYTES);
        if (per_cu < 1) per_cu = 1;
        if (cus * per_cu < 256) { fprintf(stderr, "kernel_launch: device holds only %d co-resident workgroups, 256 needed\n", cus * per_cu); grid_blocks = -1; (void)hipGetLastError(); return; }
        grid_blocks = 256;
        (void)hipGetLastError();
    }
    if (grid_blocks < 0) return;
    Params p{};
    for (int i = 0; i < 31; ++i) p.in[i] = (const float*)d_in[i];
    p.out = (float*)d_out; p.ws = (unsigned char*)d_ws;
#if MK_SINGLE
    (void)hipMemsetAsync((unsigned char*)d_ws + O_BAR, 0, XCD_BAR_WORDS * 4, stream);
    p.ph_lo = 0; p.ph_hi = NPHASE;
    void* args[] = {&p};
    hipError_t e = hipLaunchCooperativeKernel((const void*)mega, dim3(grid_blocks), dim3(512), args, LDS_BYTES, stream);
    if (e != hipSuccess) fprintf(stderr, "cooperative launch failed: %s (grid %d)\n", hipGetErrorString(e), grid_blocks);
#else
    for (int ph = 0; ph < NPHASE; ++ph) {
        p.ph_lo = ph; p.ph_hi = ph + 1;
        hipLaunchKernelGGL(mega, dim3(grid_blocks), dim3(512), LDS_BYTES, stream, p);
    }
#endif
}
```

```cpp
#include <hip/hip_runtime.h>
#include <hip/hip_cooperative_groups.h>
#include <cstdio>
namespace cg = cooperative_groups;

#ifndef REP_MASK
#define REP_MASK 0
#endif
#ifndef MK_SINGLE
#define MK_SINGLE 1
#endif

#define LAS __attribute__((address_space(3)))
typedef unsigned short bf16_t;
typedef short bf16x8 __attribute__((ext_vector_type(8)));
typedef float f32x4 __attribute__((ext_vector_type(4)));
typedef float f32x2 __attribute__((ext_vector_type(2)));
typedef unsigned u32x4 __attribute__((ext_vector_type(4)));
typedef unsigned u32x2 __attribute__((ext_vector_type(2)));
typedef _Float16 h8 __attribute__((ext_vector_type(8)));

constexpr int M_ = 16384, D_ = 2048, F_ = 5632, S_ = 4096, NH_ = 32;
constexpr int NPHASE = 21;
constexpr int LDS_BYTES = 131072 + 16;
constexpr size_t MiB = 1ull << 20;
constexpr size_t O_WRT = 0 * MiB, O_WKT = 8 * MiB, O_WVT = 16 * MiB, O_WOT = 24 * MiB, O_W1C = 32 * MiB, O_A1C = 33 * MiB, O_G1C = 34 * MiB;
constexpr size_t O_W2T0 = 35 * MiB, O_W2T1 = 36 * MiB, O_A2T0 = 37 * MiB, O_A2T1 = 38 * MiB, O_G2T = 39 * MiB, O_POOLT = 40 * MiB;
constexpr size_t O_BAR = 42 * MiB;
constexpr size_t O_XN = 70 * MiB;
constexpr size_t O_AGU = 134 * MiB, O_AD = 178 * MiB, O_BGU = 200 * MiB, O_BD = 244 * MiB;
constexpr size_t O_U = 266 * MiB;
constexpr size_t O_X6 = 70 * MiB;
constexpr size_t O_R = 454 * MiB, O_K = 518 * MiB, O_V = 582 * MiB, O_LW = 646 * MiB, O_LA = 654 * MiB, O_LG = 662 * MiB, O_BS = 670 * MiB;
constexpr size_t O_E0 = 70 * MiB, O_E1 = 134 * MiB, O_A0 = 198 * MiB, O_A1 = 262 * MiB, O_G = 326 * MiB, O_POST = 390 * MiB;
constexpr size_t WS_NEED = 674 * MiB;

struct Params {
    const float* in[31];
    float* out;
    unsigned char* ws;
    int ph_lo, ph_hi;
};

__device__ __forceinline__ const float* pin(const Params& p, int i) { asm volatile("" : "+s"(i)); return p.in[i]; }
__device__ __forceinline__ unsigned cvt_pk_bf16(float lo, float hi) { unsigned r; asm volatile("v_cvt_pk_bf16_f32 %0, %1, %2" : "=v"(r) : "v"(lo), "v"(hi)); return r; }
__device__ __forceinline__ unsigned pk_h2(float a, float b) { auto h = __builtin_amdgcn_cvt_pkrtz(a, b); return __builtin_bit_cast(unsigned, h); }
__device__ __forceinline__ float bf_lo(unsigned w) { return __builtin_bit_cast(float, w << 16); }
__device__ __forceinline__ float bf_hi(unsigned w) { return __builtin_bit_cast(float, w & 0xffff0000u); }
template <int CTRL> __device__ __forceinline__ float dpp_f(float v) {
    return __builtin_bit_cast(float, __builtin_amdgcn_update_dpp(0, __builtin_bit_cast(int, v), CTRL, 0xF, 0xF, true));
}
__device__ __forceinline__ float red8(float v) { v += dpp_f<0xB1>(v); v += dpp_f<0x4E>(v); v += dpp_f<0x141>(v); return v; }
__device__ __forceinline__ float wave_sum(float v) {
    v += dpp_f<0xB1>(v); v += dpp_f<0x4E>(v); v += dpp_f<0x141>(v); v += dpp_f<0x140>(v);
    const int iv = __builtin_bit_cast(int, v);
    const float r0 = __builtin_bit_cast(float, __builtin_amdgcn_readlane(iv, 0)), r1 = __builtin_bit_cast(float, __builtin_amdgcn_readlane(iv, 16));
    const float r2 = __builtin_bit_cast(float, __builtin_amdgcn_readlane(iv, 32)), r3 = __builtin_bit_cast(float, __builtin_amdgcn_readlane(iv, 48));
    return (r0 + r1) + (r2 + r3);
}
__device__ __forceinline__ float sigmoidf_(float x) { return __builtin_amdgcn_rcpf(1.f + __expf(-x)); }
#define LDS_WAIT() asm volatile("s_waitcnt lgkmcnt(0)" ::: "memory")


#define XB_TMO      128
#define XB_XCNT(j)  (256  + 64 * (j))
#define XB_XSUB(j)  (1280 + 64 * (j))
#define XB_XGEN(j)  (2304 + 64 * (j))
#define XB_TOP      3328
#define XB_TOPGEN   3392
#define XCD_BAR_WORDS 3456
#define XB_SPIN_CAP (1u << 18)
__device__ __forceinline__ unsigned xb_ld(unsigned* p)              { return __hip_atomic_load(p, __ATOMIC_RELAXED, __HIP_MEMORY_SCOPE_AGENT); }
__device__ __forceinline__ unsigned xb_add(unsigned* p, unsigned v) { return __hip_atomic_fetch_add(p, v, __ATOMIC_RELAXED, __HIP_MEMORY_SCOPE_AGENT); }
__device__ __forceinline__ unsigned xb_xcc_id() { return (unsigned)__builtin_amdgcn_s_getreg((3 << 11) | 20) & 0xFu; }
#define XB_SPIN(cond, bar) do { unsigned _sp = 0; while (cond) { __builtin_amdgcn_s_sleep(1); \
    if ((++_sp & 255u) == 0u) { if (xb_ld(&(bar)[XB_TMO])) break; if (_sp > XB_SPIN_CAP) { atomicAdd(&(bar)[XB_TMO], 1u); break; } } } } while (0)
struct XcdBarrier { unsigned* bar; unsigned x; volatile LAS unsigned* st; };
__device__ __forceinline__ void xcd_barrier_complete(unsigned* bar, unsigned x, unsigned& nloc, unsigned& nx) {
    const unsigned G = gridDim.x;
    unsigned sum, cnt, mine, sp = 0u;
    for (;;) {
        sum = 0u; cnt = 0u; mine = 0u;
#pragma unroll
        for (unsigned j = 0; j < 16; ++j) { const unsigned c = xb_ld(&bar[XB_XCNT(j)]); sum += c; cnt += (c > 0u) ? 1u : 0u; mine = (j == x) ? c : mine; }
        if (sum == G) break;
        __builtin_amdgcn_s_sleep(1);
        if ((++sp & 255u) == 0u) { if (xb_ld(&bar[XB_TMO])) break; if (sp > XB_SPIN_CAP) { atomicAdd(&bar[XB_TMO], 1u); break; } }
    }
    nloc = mine > 0u ? mine : 1u; nx = cnt > 0u ? cnt : 1u;
}
__device__ __forceinline__ void xcd_barrier(const XcdBarrier& b, bool leader_thread) {
    asm volatile("s_waitcnt vmcnt(0)" ::: "memory");
    __syncthreads();
    if (leader_thread) {
        unsigned* bar = b.bar;
        __builtin_amdgcn_s_waitcnt(0);
        unsigned nloc = b.st[0], nx = b.st[1];
        if (nloc == 0u) { xcd_barrier_complete(bar, b.x, nloc, nx); b.st[0] = nloc; b.st[1] = nx; }
        const unsigned old = xb_add(&bar[XB_XSUB(b.x)], 1u);
        const unsigned gen = old / nloc;
        if (old + 1u == (gen + 1u) * nloc) {
            __builtin_amdgcn_fence(__ATOMIC_RELEASE, "agent");
            asm volatile("s_waitcnt vmcnt(0)" ::: "memory");
            const unsigned og = xb_add(&bar[XB_TOP], 1u);
            const unsigned tg = og / nx;
            if (og + 1u == (tg + 1u) * nx) xb_add(&bar[XB_TOPGEN], 1u);
            else XB_SPIN(xb_ld(&bar[XB_TOPGEN]) == tg, bar);
            __builtin_amdgcn_fence(__ATOMIC_ACQUIRE, "agent");
            xb_add(&bar[XB_XGEN(b.x)], 1u);
            asm volatile("s_waitcnt vmcnt(0)" ::: "memory");
        } else {
            XB_SPIN(xb_ld(&bar[XB_XGEN(b.x)]) == gen, bar);
            __builtin_amdgcn_fence(__ATOMIC_ACQUIRE, "agent");
            asm volatile("s_waitcnt vmcnt(0)" ::: "memory");
        }
    }
    __syncthreads();
}

__device__ __forceinline__ void tr_load(const float* src, int N, int k0, int n0, float (&v)[32], int lane) {
#pragma unroll
    for (int i = 0; i < 32; ++i) v[i] = src[(size_t)(k0 + 2 * i + (lane >> 5)) * N + n0 + (lane & 31)];
}
__device__ __forceinline__ void tr_store(const float (&v)[32], int k0, int n0, bf16_t* dst, int ldd, int mode, int row0, int col0, const float* scale, LAS float* scr, int lane) {
#pragma unroll
    for (int i = 0; i < 32; ++i) {
        const int kk = 2 * i + (lane >> 5);
        float x = v[i];
        if (scale) x *= scale[k0 + kk];
        scr[kk * 33 + (lane & 31)] = x;
    }
    LDS_WAIT();
    const int c = lane & 7;
#pragma unroll
    for (int j = 0; j < 4; ++j) {
        const int n = (lane >> 3) + 8 * j; const LAS float* s = scr + (8 * c) * 33 + n;
        u32x4 o; o.x = cvt_pk_bf16(s[0 * 33], s[1 * 33]); o.y = cvt_pk_bf16(s[2 * 33], s[3 * 33]); o.z = cvt_pk_bf16(s[4 * 33], s[5 * 33]); o.w = cvt_pk_bf16(s[6 * 33], s[7 * 33]);
        const int ng = n0 + n;
        const int row = mode ? (256 * (ng >> 7) + row0 + (ng & 127)) : (row0 + ng);
        *(u32x4*)(dst + (size_t)row * ldd + col0 + k0 + 8 * c) = o;
    }
    LDS_WAIT();
}
__device__ __forceinline__ void tr_mat(const float* src, int K, int N, bf16_t* dst, int ldd, int mode, int row0, int col0, const float* scale, LAS float* scr, int lane, int gw, int NGW, int rot) {
    const int nblk = N / 32, items = (K / 64) * nblk;
    int it = gw - rot; while (it < 0) it += NGW;
    float va[32], vb[32];
    if (it < items) tr_load(src, N, 64 * (it / nblk), 32 * (it % nblk), va, lane);
    while (it < items) {
        const int nx = it + NGW;
        if (nx < items) tr_load(src, N, 64 * (nx / nblk), 32 * (nx % nblk), vb, lane);
        tr_store(va, 64 * (it / nblk), 32 * (it % nblk), dst, ldd, mode, row0, col0, scale, scr, lane);
#pragma unroll
        for (int i = 0; i < 32; ++i) va[i] = vb[i];
        it = nx;
    }
}
__device__ __forceinline__ void conv_ffn(const float* gate, const float* up, const float* down, bf16_t* gu, bf16_t* dn, LAS float* scr, int lane, int gw, int NGW) {
    tr_mat(gate, D_, F_, gu, D_, 1, 0, 0, nullptr, scr, lane, gw, NGW, 0);
    tr_mat(up, D_, F_, gu, D_, 1, 128, 0, nullptr, scr, lane, gw, NGW, 5632);
    tr_mat(down, F_, D_, dn, F_, 0, 0, 0, nullptr, scr, lane, gw, NGW, 11264);
}
__device__ __forceinline__ void conv_rwkv(const Params& p, unsigned char* ws, LAS float* scr, int lane, int gw, int NGW) {
    tr_mat(pin(p, 13), D_, D_, (bf16_t*)(ws + O_WRT), D_, 0, 0, 0, nullptr, scr, lane, gw, NGW, 0);
    tr_mat(pin(p, 14), D_, D_, (bf16_t*)(ws + O_WKT), D_, 0, 0, 0, nullptr, scr, lane, gw, NGW, 0);
    tr_mat(pin(p, 15), D_, D_, (bf16_t*)(ws + O_WVT), D_, 0, 0, 0, nullptr, scr, lane, gw, NGW, 0);
    tr_mat(pin(p, 16), D_, D_, (bf16_t*)(ws + O_WOT), D_, 0, 0, 0, nullptr, scr, lane, gw, NGW, 0);
    for (int d = 0; d < 2; ++d) {
        tr_mat(pin(p, 18) + (size_t)d * D_ * 96, D_, 96, (bf16_t*)(ws + O_W1C), D_, 0, d * 96, 0, nullptr, scr, lane, gw, NGW, d * 96);
        tr_mat(pin(p, 21) + (size_t)d * D_ * 96, D_, 96, (bf16_t*)(ws + O_A1C), D_, 0, d * 96, 0, nullptr, scr, lane, gw, NGW, 192 + d * 96);
    }
    tr_mat(pin(p, 23), D_, 256, (bf16_t*)(ws + O_G1C), D_, 0, 0, 0, nullptr, scr, lane, gw, NGW, 384);
    tr_mat(pin(p, 24), 256, D_, (bf16_t*)(ws + O_G2T), 256, 0, 0, 0, nullptr, scr, lane, gw, NGW, 1280);
    for (int g = 0; g < 4; ++g)
        tr_mat(pin(p, 10) + (size_t)g * 512 * 512, 512, 512, (bf16_t*)(ws + O_POOLT) + (size_t)g * 512 * 512, 512, 0, 0, 0, nullptr, scr, lane, gw, NGW, 1536 + g * 128);
    const int gt = gw * 64 + lane, NT = NGW * 64;
    for (int idx = gt; idx < 2 * 64 * 2048; idx += NT) {
        const int which = idx / (64 * 2048), r = idx % (64 * 2048);
        bf16_t* dst = (bf16_t*)(ws + (which ? O_A1C : O_W1C)) + (size_t)192 * 2048;
        dst[r] = 0;
    }
    for (int idx = gt; idx < 4 * 256 * 2048; idx += NT) {
        const int mat = idx / (256 * 2048), r = idx % (256 * 2048), kk = r / 2048, n = r % 2048;
        const int d = mat & 1; const bool isa = mat >= 2;
        const float* src = (isa ? pin(p, 22) : pin(p, 19)) + (size_t)d * 96 * D_;
        bf16_t* dst = (bf16_t*)(ws + (isa ? (d ? O_A2T1 : O_A2T0) : (d ? O_W2T1 : O_W2T0)));
        const int j = kk - d * 96;
        const float v = (j >= 0 && j < 96) ? src[(size_t)j * D_ + n] : 0.f;
        dst[(size_t)n * 256 + kk] = (bf16_t)(cvt_pk_bf16(v, 0.f) & 0xffffu);
    }
}

template <bool FINAL>
__device__ __forceinline__ void norm_phase(const float* src, const float* gain, bf16_t* dst, float* fdst, int lane, int gw, int NGW) {
    f32x4 gv[8];
#pragma unroll
    for (int j = 0; j < 8; ++j) gv[j] = ((const f32x4*)gain)[lane + 64 * j];
    for (int row = gw; row < M_; row += NGW) {
        const f32x4* xr = (const f32x4*)(src + (size_t)row * D_) + lane;
        f32x4 v[8]; float s = 0.f;
#pragma unroll
        for (int j = 0; j < 8; ++j) { v[j] = xr[64 * j]; s += (v[j].x * v[j].x + v[j].y * v[j].y) + (v[j].z * v[j].z + v[j].w * v[j].w); }
        const float rstd = rsqrtf(wave_sum(s) * (1.f / D_) + 1e-6f);
        if (FINAL) {
            f32x4* o = (f32x4*)(fdst + (size_t)row * D_) + lane;
#pragma unroll
            for (int j = 0; j < 8; ++j) o[64 * j] = v[j] * rstd * gv[j];
        } else {
            u32x2* o = (u32x2*)(dst + (size_t)row * D_) + lane;
#pragma unroll
            for (int j = 0; j < 8; ++j) { f32x4 t = v[j] * rstd * gv[j]; u32x2 w; w.x = cvt_pk_bf16(t.x, t.y); w.y = cvt_pk_bf16(t.z, t.w); o[64 * j] = w; }
        }
    }
}

__device__ __forceinline__ void load_norm_row(const float* src, int row, const f32x4 (&gv)[8], f32x4 (&o)[8], int lane) {
    const f32x4* xr = (const f32x4*)(src + (size_t)row * D_) + lane;
    float s = 0.f;
#pragma unroll
    for (int j = 0; j < 8; ++j) { o[j] = xr[64 * j]; s += (o[j].x * o[j].x + o[j].y * o[j].y) + (o[j].z * o[j].z + o[j].w * o[j].w); }
    const float rstd = rsqrtf(wave_sum(s) * (1.f / D_) + 1e-6f);
#pragma unroll
    for (int j = 0; j < 8; ++j) o[j] = o[j] * rstd * gv[j];
}
__device__ __forceinline__ void rwkv_prep_phase(const float* h, const float* gain, const float* mu, bf16_t* x6, int lane, int gw, int NGW) {
    f32x4 gv[8];
#pragma unroll
    for (int j = 0; j < 8; ++j) gv[j] = ((const f32x4*)gain)[lane + 64 * j];
    for (int run = gw; run < M_ / 8; run += NGW) {
        const int row0 = run * 8, t0 = row0 & (S_ - 1);
        f32x4 prev[8], cur[8], nxt[8];
        if (t0 > 0) load_norm_row(h, row0 - 1, gv, prev, lane);
        else {
#pragma unroll
            for (int j = 0; j < 8; ++j) prev[j] = (f32x4){0.f, 0.f, 0.f, 0.f};
        }
        load_norm_row(h, row0, gv, cur, lane);
        for (int i = 0; i < 8; ++i) {
            const int row = row0 + i, t = t0 + i;
            if (t + 1 < S_) load_norm_row(h, row + 1, gv, nxt, lane);
            else {
#pragma unroll
                for (int j = 0; j < 8; ++j) nxt[j] = (f32x4){0.f, 0.f, 0.f, 0.f};
            }
#pragma unroll
            for (int j = 0; j < 8; ++j) {
                const f32x4 xx = (prev[j] + nxt[j]) * 0.5f - cur[j];
#pragma unroll
                for (int q = 0; q < 6; ++q) {
                    const f32x4 m4 = ((const f32x4*)(mu + (size_t)q * D_))[lane + 64 * j];
                    const f32x4 xm = cur[j] + xx * m4;
                    u32x2 w; w.x = cvt_pk_bf16(xm.x, xm.y); w.y = cvt_pk_bf16(xm.z, xm.w);
                    ((u32x2*)(x6 + (size_t)q * M_ * D_ + (size_t)row * D_))[lane + 64 * j] = w;
                }
                prev[j] = cur[j]; cur[j] = nxt[j];
            }
        }
    }
}

__device__ __forceinline__ void pool_prep_phase(const float* h, const float* gain, bf16_t* outp, LAS unsigned char* lds, int tid, int lane, int wave, int bid, int nb) {
    LAS float* rs = (LAS float*)lds;
    for (int chunk = bid; chunk < M_ / 64; chunk += nb) {
        const int m0 = chunk * 64, b = m0 / S_, t0 = m0 % S_;
        __syncthreads();
        for (int rr = wave; rr < 80; rr += 8) {
            const int t = t0 - 8 + rr;
            if (t >= 0 && t < S_) {
                const f32x4* xr = (const f32x4*)(h + ((size_t)b * S_ + t) * D_) + lane;
                float s = 0.f;
#pragma unroll
                for (int j = 0; j < 8; ++j) { const f32x4 v = xr[64 * j]; s += (v.x * v.x + v.y * v.y) + (v.z * v.z + v.w * v.w); }
                s = wave_sum(s);
                if (lane == 0) rs[rr] = rsqrtf(s * (1.f / D_) + 1e-6f);
            }
        }
        __syncthreads();
        const int c = 4 * tid, g = tid >> 7, w = 2 << g, half = w >> 1;
        const f32x4 gn = *(const f32x4*)(gain + c);
        const float* hb = h + (size_t)b * S_ * D_ + c;
#define HN(t) ((*(const f32x4*)(hb + (size_t)(t) * D_)) * rs[(t) - t0 + 8] * gn)
        int lo = t0 - half; if (lo < 0) lo = 0;
        int hi = t0 + half; if (hi > S_) hi = S_;
        f32x4 sum = (f32x4){0.f, 0.f, 0.f, 0.f};
        for (int u = lo; u < hi; ++u) sum += HN(u);
#pragma unroll 8
        for (int i = 0; i < 64; ++i) {
            const int t = t0 + i;
            const f32x4 x = HN(t);
            const float inv = 1.f / (float)(hi - lo);
            const f32x4 o = sum * inv - x;
            u32x2 wv; wv.x = cvt_pk_bf16(o.x, o.y); wv.y = cvt_pk_bf16(o.z, o.w);
            *(u32x2*)(outp + ((size_t)b * S_ + t) * D_ + c) = wv;
            if (i < 63) {
                if (t + 1 - half > 0) { sum -= HN(lo); ++lo; }
                if (t + half < S_) { sum += HN(t + half); ++hi; }
            }
        }
#undef HN
    }
}

constexpr int BM = 256, BK = 64, HALF = 128, HTB = HALF * BK * 2;
__device__ __forceinline__ int lds_byte(int r, int c) { const int st = (r >> 4) * 2 + (c >> 5), rr = r & 15, cc = c & 31, ob = rr * 64 + cc * 2; return st * 1024 + (ob ^ (((ob >> 9) & 1) << 5)); }
__device__ __forceinline__ void stage_rc(int b, int& R, int& C) { const int st = b / 1024, sb = b % 1024, swz = sb ^ (((sb >> 9) & 1) << 5); R = (st >> 1) * 16 + swz / 64; C = (st & 1) * 32 + (swz % 64) / 2; }
__device__ __forceinline__ int perm32(int rho) { const int n = rho >> 4, i = rho & 15; return 8 * (i >> 2) + 4 * n + (i & 3); }

struct Unit { const char* a; const char* b; int pm, pn, job; };

__device__ __forceinline__ void remap_tile(int l, int nM, int nN, int& pm, int& pn, int wgm = 8) {
    const int nwg = nM * nN; int wgid = l;
    { const int q = nwg / 8, r = nwg % 8, xcd = wgid % 8, off = wgid / 8; wgid = (xcd < r ? xcd * (q + 1) : r * (q + 1) + (xcd - r) * q) + off; }
    const int nig = wgm * nN, gid = wgid / nig, fm = gid * wgm, gsz = (nM - fm) < wgm ? (nM - fm) : wgm;
    pm = fm + ((wgid % nig) % gsz); pn = (wgid % nig) / gsz;
}

template <class Epi, class Sched>
__device__ __forceinline__ void gemm_phase(LAS unsigned char* lds, const int tid, const int K, const int lda, const int ldb, const Sched& S, const Epi& E) {
    const int wid = __builtin_amdgcn_readfirstlane(tid >> 6), lane = tid & 63, wr = wid >> 2, wc = wid & 3, fr = lane & 15, fq = lane >> 4;
    const int nt = K / BK;
    unsigned voffA, voffB;
    { int R, C; stage_rc(tid * 16, R, C); const int Rb = Epi::PERM ? ((R & ~31) + perm32(R & 31)) : R;
        voffA = (unsigned)(R * lda + C) * 2u; voffB = (unsigned)(Rb * ldb + C) * 2u; }
    const size_t q64A = (size_t)64 * lda * 2, q64B = (size_t)64 * ldb * 2;
    const size_t kstep = (size_t)(BK * 2);
    const size_t hstepA = (size_t)HALF * lda * 2, hstepB = (size_t)HALF * ldb * 2;
    const unsigned ldsw = (unsigned)wid * 1024u;
    const int aoff = lds_byte(wr * 64 + fr, fq * 8), boff = lds_byte(wc * 32 + fr, fq * 8);
#define PG8_SA(b, h) (((b) * 2 + (h)) * HTB)
#define PG8_SB(b, h) ((4 + (b) * 2 + (h)) * HTB)
#define PG8_STAGE(bufoff, gbase, voff) do { \
        __builtin_amdgcn_global_load_lds((const unsigned*)((const char*)(gbase) + (voff)), (LAS unsigned*)(lds + (bufoff) + ldsw), 16, 0, 0); \
        __builtin_amdgcn_global_load_lds((const unsigned*)((const char*)(gbase) + q64_##voff + (voff)), (LAS unsigned*)(lds + (bufoff) + ldsw + 8192), 16, 0, 0); } while (0)
#define q64_voffA q64A
#define q64_voffB q64B
#define PG8_LDA(dst, b, h) do { _Pragma("unroll") for (int m = 0; m < 4; ++m) _Pragma("unroll") for (int k = 0; k < 2; ++k) dst[m][k] = *(const LAS bf16x8*)(lds + PG8_SA(b, h) + aoff + m * 2048 + k * 1024); } while (0)
#define PG8_LDB(dst, b, h) do { _Pragma("unroll") for (int n = 0; n < 2; ++n) _Pragma("unroll") for (int k = 0; k < 2; ++k) dst[n][k] = *(const LAS bf16x8*)(lds + PG8_SB(b, h) + boff + n * 2048 + k * 1024); } while (0)
#define PG8_MMA(ai, bj, At, Bt) do { __builtin_amdgcn_s_setprio(1); _Pragma("unroll") for (int m = 0; m < 4; ++m) _Pragma("unroll") for (int n = 0; n < 2; ++n) _Pragma("unroll") for (int k = 0; k < 2; ++k) \
        acc[ai][bj][m][n] = __builtin_amdgcn_mfma_f32_16x16x32_bf16(Bt[n][k], At[m][k], acc[ai][bj][m][n], 0, 0, 0); __builtin_amdgcn_s_setprio(0); } while (0)
#define PG8_WAIT_V(n) asm volatile("s_waitcnt vmcnt(" #n ")" ::: "memory")
#define PG8_WAIT_L(n) asm volatile("s_waitcnt lgkmcnt(" #n ")" ::: "memory")
#define PG8_BAR __builtin_amdgcn_s_barrier()
#define PG8_SCHED __builtin_amdgcn_sched_barrier(0)
    Unit cur, nxt; int ui = 0;
    if (!S.next(0, cur)) return;
    f32x4 acc[2][2][4][2];
#pragma unroll
    for (int a = 0; a < 2; ++a)
#pragma unroll
        for (int b = 0; b < 2; ++b)
#pragma unroll
            for (int m = 0; m < 4; ++m)
#pragma unroll
                for (int n = 0; n < 2; ++n) acc[a][b][m][n] = (f32x4){0.f, 0.f, 0.f, 0.f};
    bf16x8 At[4][2], B0[2][2], B1[2][2];
    const char* cA = cur.a; const char* cB = cur.b;
    PG8_STAGE(PG8_SB(0, 0), cB, voffB); PG8_STAGE(PG8_SA(0, 0), cA, voffA); PG8_STAGE(PG8_SB(0, 1), cB + hstepB, voffB); PG8_STAGE(PG8_SA(0, 1), cA + hstepA, voffA);
    if (wr == 1) PG8_BAR;
    PG8_WAIT_V(4); PG8_BAR;
    PG8_STAGE(PG8_SB(1, 0), cB + kstep, voffB); PG8_STAGE(PG8_SA(1, 0), cA + kstep, voffA); PG8_STAGE(PG8_SB(1, 1), cB + hstepB + kstep, voffB);
    PG8_WAIT_V(6); PG8_BAR;
    for (;;) {
        const bool has_next = S.next(ui + 1, nxt);
        const char* nA = has_next ? nxt.a : cA; const char* nB = has_next ? nxt.b : cB;
        for (int t = 0; t < nt; t += 2) {
            const bool last = (t == nt - 2);
            const char* a1 = cA + (size_t)(t + 1) * kstep;
            const char* a2 = last ? nA : cA + (size_t)(t + 2) * kstep; const char* b2 = last ? nB : cB + (size_t)(t + 2) * kstep;
            const char* a3 = a2 + kstep; const char* b3 = b2 + kstep;
            PG8_LDB(B0, 0, 0); PG8_SCHED; PG8_LDA(At, 0, 0); PG8_STAGE(PG8_SA(1, 1), a1 + hstepA, voffA);
            PG8_WAIT_L(8); PG8_BAR; PG8_WAIT_L(0); PG8_MMA(0, 0, At, B0); PG8_BAR; PG8_SCHED;
            PG8_LDB(B1, 0, 1); PG8_STAGE(PG8_SB(0, 0), b2, voffB);
            PG8_BAR; PG8_WAIT_L(0); PG8_MMA(0, 1, At, B1); PG8_BAR;
            PG8_LDA(At, 0, 1); PG8_STAGE(PG8_SA(0, 0), a2, voffA);
            PG8_BAR; PG8_WAIT_L(0); PG8_MMA(1, 0, At, B0); PG8_BAR; PG8_SCHED;
            PG8_STAGE(PG8_SB(0, 1), b2 + hstepB, voffB);
            PG8_WAIT_V(6); PG8_BAR; PG8_MMA(1, 1, At, B1); PG8_BAR;
            PG8_LDB(B0, 1, 0); PG8_SCHED; PG8_LDA(At, 1, 0); PG8_STAGE(PG8_SA(0, 1), a2 + hstepA, voffA);
            PG8_WAIT_L(8); PG8_BAR; PG8_WAIT_L(0); PG8_MMA(0, 0, At, B0); PG8_BAR; PG8_SCHED;
            PG8_LDB(B1, 1, 1); PG8_STAGE(PG8_SB(1, 0), b3, voffB);
            PG8_BAR; PG8_WAIT_L(0); PG8_MMA(0, 1, At, B1); PG8_BAR;
            PG8_LDA(At, 1, 1); PG8_STAGE(PG8_SA(1, 0), a3, voffA);
            PG8_BAR; PG8_WAIT_L(0); PG8_MMA(1, 0, At, B0); PG8_BAR; PG8_SCHED;
            PG8_STAGE(PG8_SB(1, 1), b3 + hstepB, voffB);
            PG8_WAIT_V(6); PG8_BAR; PG8_MMA(1, 1, At, B1); PG8_BAR;
        }
        { int ln = lane; asm volatile("" : "+v"(ln)); E(acc, cur, wr, wc, ln & 15, ln >> 4); }
        if (!has_next) break;
#pragma unroll
        for (int a = 0; a < 2; ++a)
#pragma unroll
            for (int b = 0; b < 2; ++b)
#pragma unroll
                for (int m = 0; m < 4; ++m)
#pragma unroll
                    for (int n = 0; n < 2; ++n) acc[a][b][m][n] = (f32x4){0.f, 0.f, 0.f, 0.f};
        cur = nxt; cA = nA; cB = nB; ++ui;
    }
    PG8_WAIT_V(0);
    if (wr == 0) PG8_BAR;
    PG8_BAR;
#undef PG8_SA
#undef PG8_SB
#undef PG8_STAGE
#undef q64_voffA
#undef q64_voffB
#undef PG8_LDA
#undef PG8_LDB
#undef PG8_MMA
#undef PG8_WAIT_V
#undef PG8_WAIT_L
#undef PG8_BAR
#undef PG8_SCHED
}

struct SchedSimple {
    const char* A; const char* Bt; int nM, nN, G, c, poolmode, wgm; size_t tstepA, tstepB;
    __device__ __forceinline__ bool next(int i, Unit& u) const {
        const int L = i * G + c; if (L >= nM * nN) return false;
        int pm, pn; remap_tile(L, nM, nN, pm, pn, wgm);
        u.a = A + (size_t)pm * tstepA + (poolmode ? (size_t)(pn >> 1) * 1024 : 0); u.b = Bt + (size_t)pn * tstepB; u.pm = pm; u.pn = pn; u.job = 0; return true;
    }
};
struct SchedProj {
    const char* ws; int G, c;
    __device__ __forceinline__ bool next(int i, Unit& u) const {
        const int L = i * G + c; if (L >= 1728) return false;
        int job, l, nN; size_t bo, ao;
        if (L < 1536) { job = L >> 9; l = L & 511; nN = 8; bo = job == 0 ? O_WRT : (job == 1 ? O_WKT : O_WVT); ao = job == 0 ? 0 : (job == 1 ? 2 : 3); }
        else { const int q = L - 1536; job = 3 + (q >> 6); l = q & 63; nN = 1; bo = job == 3 ? O_W1C : (job == 4 ? O_A1C : O_G1C); ao = job == 3 ? 1 : (job == 4 ? 4 : 5); }
        int pm, pn; remap_tile(l, 64, nN, pm, pn, nN == 8 ? 4 : 8);
        u.a = ws + O_X6 + ao * (64 * MiB) + (size_t)pm * (256 * 2048 * 2); u.b = ws + bo + (size_t)pn * (256 * 2048 * 2); u.pm = pm; u.pn = pn; u.job = job; return true;
    }
};
struct SchedLora2 {
    const char* ws; int G, c;
    __device__ __forceinline__ bool next(int i, Unit& u) const {
        const int L = i * G + c; if (L >= 2560) return false;
        const int job = L >> 9, l = L & 511;
        const size_t ao = job < 2 ? O_LW : (job < 4 ? O_LA : O_LG);
        const size_t bo = job == 0 ? O_W2T0 : (job == 1 ? O_W2T1 : (job == 2 ? O_A2T0 : (job == 3 ? O_A2T1 : O_G2T)));
        int pm, pn; remap_tile(l, 64, 8, pm, pn, 4);
        u.a = ws + ao + (size_t)pm * (256 * 256 * 2); u.b = ws + bo + (size_t)pn * (256 * 256 * 2); u.pm = pm; u.pn = pn; u.job = job; return true;
    }
};

struct EpiSwiGLU {
    static constexpr bool PERM = true;
    bf16_t* U;
    __device__ __forceinline__ void operator()(const f32x4 (&acc)[2][2][4][2], const Unit& u, int wr, int wc, int fr, int fq) const {
        const int row0 = u.pm * BM + wr * 64 + fr, col0 = u.pn * 128 + wc * 32 + 8 * fq;
#pragma unroll
        for (int ai = 0; ai < 2; ++ai)
#pragma unroll
            for (int m = 0; m < 4; ++m) {
                bf16_t* rowp = U + (size_t)(row0 + ai * HALF + m * 16) * F_ + col0;
                float o[8];
#pragma unroll
                for (int n = 0; n < 2; ++n)
#pragma unroll
                    for (int j = 0; j < 4; ++j) { const float g = acc[ai][0][m][n][j], up = acc[ai][1][m][n][j]; o[4 * n + j] = g * sigmoidf_(g) * up; }
                u32x4 w; w.x = cvt_pk_bf16(o[0], o[1]); w.y = cvt_pk_bf16(o[2], o[3]); w.z = cvt_pk_bf16(o[4], o[5]); w.w = cvt_pk_bf16(o[6], o[7]);
                *(u32x4*)rowp = w;
            }
    }
};
struct EpiResid {
    static constexpr bool PERM = false;
    const float* src; float* dst; const float* colscale; float scale;
    __device__ __forceinline__ void operator()(const f32x4 (&acc)[2][2][4][2], const Unit& u, int wr, int wc, int fr, int fq) const {
        const int row0 = u.pm * BM + wr * 64 + fr, col0 = u.pn * BM + wc * 32 + 4 * fq;
        f32x4 sv[2][2];
#pragma unroll
        for (int bj = 0; bj < 2; ++bj)
#pragma unroll
            for (int n = 0; n < 2; ++n) sv[bj][n] = colscale ? *(const f32x4*)(colscale + col0 + bj * HALF + n * 16) * scale : (f32x4){scale, scale, scale, scale};
#pragma unroll
        for (int ai = 0; ai < 2; ++ai) {
            f32x4 base[4][2][2];
#pragma unroll
            for (int m = 0; m < 4; ++m)
#pragma unroll
                for (int bj = 0; bj < 2; ++bj)
#pragma unroll
                    for (int n = 0; n < 2; ++n) base[m][bj][n] = *(const f32x4*)(src + (size_t)(row0 + ai * HALF + m * 16) * D_ + col0 + bj * HALF + n * 16);
            __builtin_amdgcn_sched_barrier(0);
#pragma unroll
            for (int m = 0; m < 4; ++m)
#pragma unroll
                for (int bj = 0; bj < 2; ++bj)
#pragma unroll
                    for (int n = 0; n < 2; ++n) *(f32x4*)(dst + (size_t)(row0 + ai * HALF + m * 16) * D_ + col0 + bj * HALF + n * 16) = base[m][bj][n] + acc[ai][bj][m][n] * sv[bj][n];
            __builtin_amdgcn_sched_barrier(0);
        }
    }
};
struct EpiProj {
    static constexpr bool PERM = true;
    unsigned char* ws;
    __device__ __forceinline__ void operator()(const f32x4 (&acc)[2][2][4][2], const Unit& u, int wr, int wc, int fr, int fq) const {
        const int job = u.job;
        const int row0 = u.pm * BM + wr * 64 + fr, col0 = u.pn * BM + wc * 32 + 8 * fq;
        const size_t obase = job == 0 ? O_R : (job == 1 ? O_K : (job == 2 ? O_V : (job == 3 ? O_LW : (job == 4 ? O_LA : O_LG))));
        const int ldc = job < 3 ? D_ : 256;
        unsigned short* outp = (unsigned short*)(ws + obase) + (size_t)row0 * ldc + col0;
        const float c0 = job == 3 ? 1.f : 0.f, c1 = job == 3 ? -2.f : 1.f, c2 = job == 3 ? 2.f : -1.f;
        const bool act = (job == 3) || (job == 5), f16 = job < 3;
#pragma unroll
        for (int ai = 0; ai < 2; ++ai)
#pragma unroll
            for (int m = 0; m < 4; ++m) {
                unsigned short* rowp = outp + (size_t)(ai * HALF + m * 16) * ldc;
#pragma unroll
                for (int bj = 0; bj < 2; ++bj) {
                    f32x4 v0 = acc[ai][bj][m][0], v1 = acc[ai][bj][m][1];
                    if (act) {
#pragma unroll
                        for (int j = 0; j < 4; ++j) { v0[j] = c0 + c1 * __builtin_amdgcn_rcpf(1.f + __expf(c2 * v0[j])); v1[j] = c0 + c1 * __builtin_amdgcn_rcpf(1.f + __expf(c2 * v1[j])); }
                    }
                    u32x4 w;
                    if (f16) { w.x = pk_h2(v0[0], v0[1]); w.y = pk_h2(v0[2], v0[3]); w.z = pk_h2(v1[0], v1[1]); w.w = pk_h2(v1[2], v1[3]); }
                    else { w.x = cvt_pk_bf16(v0[0], v0[1]); w.y = cvt_pk_bf16(v0[2], v0[3]); w.z = cvt_pk_bf16(v1[0], v1[1]); w.w = cvt_pk_bf16(v1[2], v1[3]); }
                    *(u32x4*)(rowp + bj * HALF) = w;
                }
            }
    }
};
struct EpiLora2 {
    static constexpr bool PERM = true;
    unsigned char* ws; const float* w0; const float* a0;
    __device__ __forceinline__ void operator()(const f32x4 (&acc)[2][2][4][2], const Unit& u, int wr, int wc, int fr, int fq) const {
        const int job = u.job;
        const int row0 = u.pm * BM + wr * 64 + fr, col0 = u.pn * BM + wc * 32 + 8 * fq;
        const size_t obase = job == 0 ? O_E0 : (job == 1 ? O_E1 : (job == 2 ? O_A0 : (job == 3 ? O_A1 : O_G)));
        unsigned short* outp = (unsigned short*)(ws + obase) + (size_t)row0 * D_ + col0;
        const float* bias = (job < 2 ? (w0 + (size_t)job * D_) : (a0 + (size_t)(job & 1) * D_)) + col0;
        const float osc = job < 2 ? 0.60653065971f : 1.f;
        const bool act = job < 4;
#pragma unroll
        for (int bj = 0; bj < 2; ++bj) {
            f32x4 b0 = (f32x4){0.f, 0.f, 0.f, 0.f}, b1 = b0;
            if (act) { b0 = *(const f32x4*)(bias + bj * HALF); b1 = *(const f32x4*)(bias + bj * HALF + 4); }
#pragma unroll
            for (int ai = 0; ai < 2; ++ai)
#pragma unroll
                for (int m = 0; m < 4; ++m) {
                    unsigned short* rowp = outp + (size_t)(ai * HALF + m * 16) * D_;
                    f32x4 v0 = acc[ai][bj][m][0] + b0, v1 = acc[ai][bj][m][1] + b1;
                    if (act) {
#pragma unroll
                        for (int j = 0; j < 4; ++j) { v0[j] = osc * sigmoidf_(v0[j]); v1[j] = osc * sigmoidf_(v1[j]); }
                    }
                    u32x4 w; w.x = pk_h2(v0[0], v0[1]); w.y = pk_h2(v0[2], v0[3]); w.z = pk_h2(v1[0], v1[1]); w.w = pk_h2(v1[2], v1[3]);
                    *(u32x4*)(rowp + bj * HALF) = w;
                    __builtin_amdgcn_sched_barrier(0);
                }
        }
    }
};

constexpr int SC_T = 32;
constexpr int SC_AV = 0, SC_WR = SC_T * 32 * 4, SC_W = 2 * SC_T * 32 * 4, SC_BK = SC_W + SC_T * 64 * 4, SC_V = SC_BK + SC_T * 64 * 4, SC_SC = SC_V + SC_T * 64 * 4, SC_Y = SC_SC + SC_T * 2 * 4, SC_A = SC_Y + SC_T * 64 * 4, SC_BUF = SC_A + SC_T * 64 * 4;
constexpr int SC_ZERO = 2 * SC_BUF;
typedef _Float16 half2_t __attribute__((ext_vector_type(2)));
__device__ __forceinline__ float dot2h(unsigned a, unsigned b, float c) { return __builtin_amdgcn_fdot2(__builtin_bit_cast(half2_t, a), __builtin_bit_cast(half2_t, b), c, false); }
__device__ __forceinline__ void red8x4(float& a, float& b, float& c, float& d) {
    asm volatile("s_nop 1\n\t"
                 "v_add_f32_dpp %0, %0, %0 quad_perm:[1,0,3,2] row_mask:0xf bank_mask:0xf\n\t"
                 "v_add_f32_dpp %1, %1, %1 quad_perm:[1,0,3,2] row_mask:0xf bank_mask:0xf\n\t"
                 "v_add_f32_dpp %2, %2, %2 quad_perm:[1,0,3,2] row_mask:0xf bank_mask:0xf\n\t"
                 "v_add_f32_dpp %3, %3, %3 quad_perm:[1,0,3,2] row_mask:0xf bank_mask:0xf\n\t"
                 "v_add_f32_dpp %0, %0, %0 quad_perm:[2,3,0,1] row_mask:0xf bank_mask:0xf\n\t"
                 "v_add_f32_dpp %1, %1, %1 quad_perm:[2,3,0,1] row_mask:0xf bank_mask:0xf\n\t"
                 "v_add_f32_dpp %2, %2, %2 quad_perm:[2,3,0,1] row_mask:0xf bank_mask:0xf\n\t"
                 "v_add_f32_dpp %3, %3, %3 quad_perm:[2,3,0,1] row_mask:0xf bank_mask:0xf\n\t"
                 "v_add_f32_dpp %0, %0, %0 row_half_mirror row_mask:0xf bank_mask:0xf\n\t"
                 "v_add_f32_dpp %1, %1, %1 row_half_mirror row_mask:0xf bank_mask:0xf\n\t"
                 "v_add_f32_dpp %2, %2, %2 row_half_mirror row_mask:0xf bank_mask:0xf\n\t"
                 "v_add_f32_dpp %3, %3, %3 row_half_mirror row_mask:0xf bank_mask:0xf"
                 : "+v"(a), "+v"(b), "+v"(c), "+v"(d));
}
__device__ __forceinline__ void scan_phase(const Params& p, unsigned char* ws, LAS unsigned char* lds, int tid, int lane, int wave, int bid, int nb) {
    const float* k_k = pin(p, 25); const float* k_a = pin(p, 26); const float* r_k = pin(p, 27);
    for (int chain = bid; chain < 256; chain += nb) {
        const int d = chain & 1, hh = (chain >> 1) & 31, b = chain >> 6;
        const unsigned short* Rg = (const unsigned short*)(ws + O_R);
        const unsigned short* Kg = (const unsigned short*)(ws + O_K);
        const unsigned short* Vg = (const unsigned short*)(ws + O_V);
        unsigned short* Eg = (unsigned short*)(ws + (d ? O_E1 : O_E0));
        const unsigned short* Ag = (const unsigned short*)(ws + (d ? O_A1 : O_A0));
        float* BSg = (float*)(ws + O_BS) + (size_t)d * M_ * NH_;
        __syncthreads();
        if (wave >= 4) {
            const int lid = tid - 256, s = lid >> 3, j0 = 8 * (lid & 7), ch = hh * 64 + j0;
            float kkc[8], kac[8], rkc[8];
#pragma unroll
            for (int i = 0; i < 8; ++i) { kkc[i] = k_k[ch + i]; kac[i] = k_a[ch + i]; rkc[i] = r_k[ch + i]; }
            if (lid < 32) ((LAS unsigned*)(lds + SC_ZERO))[lid] = 0u;
            h8 r8, k8, v8, e8, a8;
            { const int t = d ? (S_ - 1 - s) : s; const size_t off = ((size_t)b * S_ + t) * D_ + ch;
              r8 = *(const h8*)(Rg + off); k8 = *(const h8*)(Kg + off); v8 = *(const h8*)(Vg + off); e8 = *(const h8*)(Eg + off); a8 = *(const h8*)(Ag + off); }
            for (int ci = -1; ci < S_ / SC_T; ++ci) {
                if (ci >= 1) {
                    const int cj = ci - 1; const int st = cj * SC_T + s; const int t = d ? (S_ - 1 - st) : st;
                    const LAS unsigned char* fb = lds + (cj & 1) * SC_BUF;
                    const LAS float* yb = (const LAS float*)(fb + SC_Y) + s * 64 + j0; const LAS float* ab = (const LAS float*)(fb + SC_A) + s * 64 + j0; const LAS float* vv = (const LAS float*)(fb + SC_V) + s * 64 + j0;
                    const f32x2 bk2 = *(const LAS f32x2*)((const LAS float*)(fb + SC_SC) + s * 2);
                    const f32x4 y0 = *(const LAS f32x4*)yb + *(const LAS f32x4*)ab * bk2.x + *(const LAS f32x4*)vv * bk2.y, y1 = *(const LAS f32x4*)(yb + 4) + *(const LAS f32x4*)(ab + 4) * bk2.x + *(const LAS f32x4*)(vv + 4) * bk2.y;
                    u32x4 w; w.x = cvt_pk_bf16(y0.x, y0.y); w.y = cvt_pk_bf16(y0.z, y0.w); w.z = cvt_pk_bf16(y1.x, y1.y); w.w = cvt_pk_bf16(y1.z, y1.w);
                    *(u32x4*)(Eg + ((size_t)b * S_ + t) * D_ + ch) = w;
                }
                if (ci + 1 < S_ / SC_T) {
                    const int cj = ci + 1; const int st = cj * SC_T + s; const int t = d ? (S_ - 1 - st) : st;
                    const size_t m = (size_t)b * S_ + t;
                    h8 r8n = r8, k8n = k8, v8n = v8, e8n = e8, a8n = a8;
                    if (cj + 1 < S_ / SC_T) {
                        const int st2 = (cj + 1) * SC_T + s; const int t2 = d ? (S_ - 1 - st2) : st2; const size_t off2 = ((size_t)b * S_ + t2) * D_ + ch;
                        r8n = *(const h8*)(Rg + off2); k8n = *(const h8*)(Kg + off2); v8n = *(const h8*)(Vg + off2); e8n = *(const h8*)(Eg + off2); a8n = *(const h8*)(Ag + off2);
                    }
                    float kk[8], ss = 0.f;
#pragma unroll
                    for (int i = 0; i < 8; ++i) { kk[i] = (float)k8[i] * kkc[i]; ss += kk[i] * kk[i]; }
                    ss = red8(ss);
                    const float inv = fminf(__builtin_amdgcn_rsqf(ss), 1e12f);
                    float ps[8];
                    const int wl = lid & 63;
#pragma unroll
                    for (int i = 0; i < 8; ++i) ps[i] = (float)e8[i];
#pragma unroll
                    for (int dd = 8; dd < 64; dd <<= 1) {
#pragma unroll
                        for (int i = 0; i < 8; ++i) { const float tup = __shfl_up(ps[i], dd); ps[i] += (wl >= dd) ? tup : 0.f; }
                    }
                    float av[8], wv[8], bb[8], kd[8], wrr[8], br = 0.f, kr = 0.f, bsum = 0.f;
#pragma unroll
                    for (int i = 0; i < 8; ++i) {
                        const float rr = (float)r8[i], kf = (float)k8[i], af = (float)a8[i], ei = (float)e8[i];
                        const float Pt = __expf(-ps[i]), Pm = __expf(ei - ps[i]), iP = __expf(ps[i]);
                        kk[i] *= inv; const float bt = kk[i] * af, kt = kf * (1.f + (af - 1.f) * kac[i]);
                        br += bt * rr; kr += kt * rr; bsum += rr * kt * rkc[i];
                        av[i] = -kk[i] * Pm; wrr[i] = Pt * rr; bb[i] = bt * iP; kd[i] = kt * iP; wv[i] = Pt;
                    }
                    br = red8(br); kr = red8(kr); bsum = red8(bsum);
                    LAS unsigned char* buf = lds + (cj & 1) * SC_BUF;
                    *(LAS u32x4*)((LAS unsigned*)(buf + SC_AV) + s * 32 + (j0 >> 1)) = (u32x4){pk_h2(av[0], av[1]), pk_h2(av[2], av[3]), pk_h2(av[4], av[5]), pk_h2(av[6], av[7])};
                    *(LAS u32x4*)((LAS unsigned*)(buf + SC_WR) + s * 32 + (j0 >> 1)) = (u32x4){pk_h2(wrr[0], wrr[1]), pk_h2(wrr[2], wrr[3]), pk_h2(wrr[4], wrr[5]), pk_h2(wrr[6], wrr[7])};
                    if ((s & 7) == 7) { LAS float* wp = (LAS float*)(buf + SC_W) + (s >> 3) * 64 + j0;
                      *(LAS f32x4*)wp = (f32x4){wv[0], wv[1], wv[2], wv[3]}; *(LAS f32x4*)(wp + 4) = (f32x4){wv[4], wv[5], wv[6], wv[7]}; }
                    LAS unsigned* bkp = (LAS unsigned*)(buf + SC_BK) + s * 64 + j0;
                    *(LAS u32x4*)bkp = (u32x4){pk_h2(bb[0], kd[0]), pk_h2(bb[1], kd[1]), pk_h2(bb[2], kd[2]), pk_h2(bb[3], kd[3])};
                    *(LAS u32x4*)(bkp + 4) = (u32x4){pk_h2(bb[4], kd[4]), pk_h2(bb[5], kd[5]), pk_h2(bb[6], kd[6]), pk_h2(bb[7], kd[7])};
                    LAS float* vb = (LAS float*)(buf + SC_V) + s * 64 + j0;
                    *(LAS f32x4*)vb = (f32x4){(float)v8[0], (float)v8[1], (float)v8[2], (float)v8[3]}; *(LAS f32x4*)(vb + 4) = (f32x4){(float)v8[4], (float)v8[5], (float)v8[6], (float)v8[7]};
                    if ((lid & 7) == 0) { *(LAS f32x2*)((LAS float*)(buf + SC_SC) + s * 2) = (f32x2){br, kr}; BSg[m * NH_ + hh] = bsum; }
                    r8 = r8n; k8 = k8n; v8 = v8n; e8 = e8n; a8 = a8n;
                }
                __syncthreads();
            }
            {
                const int cj = S_ / SC_T - 1; const int st = cj * SC_T + s; const int t = d ? (S_ - 1 - st) : st;
                const LAS unsigned char* fb = lds + (cj & 1) * SC_BUF;
                const LAS float* yb = (const LAS float*)(fb + SC_Y) + s * 64 + j0; const LAS float* ab = (const LAS float*)(fb + SC_A) + s * 64 + j0; const LAS float* vv = (const LAS float*)(fb + SC_V) + s * 64 + j0;
                const f32x2 bk2 = *(const LAS f32x2*)((const LAS float*)(fb + SC_SC) + s * 2);
                const f32x4 y0 = *(const LAS f32x4*)yb + *(const LAS f32x4*)ab * bk2.x + *(const LAS f32x4*)vv * bk2.y, y1 = *(const LAS f32x4*)(yb + 4) + *(const LAS f32x4*)(ab + 4) * bk2.x + *(const LAS f32x4*)(vv + 4) * bk2.y;
                u32x4 w; w.x = cvt_pk_bf16(y0.x, y0.y); w.y = cvt_pk_bf16(y0.z, y0.w); w.z = cvt_pk_bf16(y1.x, y1.y); w.w = cvt_pk_bf16(y1.z, y1.w);
                *(u32x4*)(Eg + ((size_t)b * S_ + t) * D_ + ch) = w;
            }
        } else {
            const int rl = lane & 15, g = lane >> 4, row = 16 * wave + rl, m4 = rl & 3;
            f32x2 S[8];
#pragma unroll
            for (int q = 0; q < 8; ++q) S[q] = (f32x2){0.f, 0.f};
            __syncthreads();
            for (int ci = 0; ci < S_ / SC_T; ++ci) {
                const LAS unsigned char* buf = lds + (ci & 1) * SC_BUF;
                const LAS unsigned char* xb = (m4 == 0 ? buf + SC_AV : (m4 == 1 ? buf + SC_WR : lds + SC_ZERO)) + 16 * g;
                const int xs = m4 < 2 ? 128 : 0;
                const LAS float* wb = (const LAS float*)(buf + SC_W) + 8 * g;
                const LAS unsigned* bkb = (const LAS unsigned*)(buf + SC_BK) + 8 * g;
                const LAS float* vb = (const LAS float*)(buf + SC_V) + row;
                LAS float* yb = (LAS float*)(lds + (ci & 1) * SC_BUF + SC_Y) + row;
#define SC_LOAD(P, s) do { \
                    P##x1 = *(const LAS h8*)(xb + (s) * xs); P##x2 = *(const LAS h8*)(xb + (s) * xs + 64); \
                                        P##k0 = *(const LAS u32x4*)(bkb + (s) * 64); P##k1 = *(const LAS u32x4*)(bkb + (s) * 64 + 4); P##k2 = *(const LAS u32x4*)(bkb + (s) * 64 + 32); P##k3 = *(const LAS u32x4*)(bkb + (s) * 64 + 36); \
                    P##v = *(vb + (s) * 64); } while (0)
#define SC_STEP(P, s) do { \
                    const u32x4 b1u = (u32x4){pk_h2(S[0].x, S[0].y), pk_h2(S[1].x, S[1].y), pk_h2(S[2].x, S[2].y), pk_h2(S[3].x, S[3].y)}; \
                    const u32x4 b2u = (u32x4){pk_h2(S[4].x, S[4].y), pk_h2(S[5].x, S[5].y), pk_h2(S[6].x, S[6].y), pk_h2(S[7].x, S[7].y)}; \
                    f32x4 acc = __builtin_amdgcn_mfma_f32_16x16x32_f16(P##x1, __builtin_bit_cast(h8, b1u), (f32x4){0.f, 0.f, 0.f, 0.f}, 0, 0, 0); \
                    acc = __builtin_amdgcn_mfma_f32_16x16x32_f16(P##x2, __builtin_bit_cast(h8, b2u), acc, 0, 0, 0); \
                    f32x2 t; \
                    const unsigned hh0 = pk_h2(acc[0], P##v); \
                    S[0].x = dot2h(hh0, P##k0.x, S[0].x); S[0].y = dot2h(hh0, P##k0.y, S[0].y); S[1].x = dot2h(hh0, P##k0.z, S[1].x); S[1].y = dot2h(hh0, P##k0.w, S[1].y); \
                    S[2].x = dot2h(hh0, P##k1.x, S[2].x); S[2].y = dot2h(hh0, P##k1.y, S[2].y); S[3].x = dot2h(hh0, P##k1.z, S[3].x); S[3].y = dot2h(hh0, P##k1.w, S[3].y); \
                    S[4].x = dot2h(hh0, P##k2.x, S[4].x); S[4].y = dot2h(hh0, P##k2.y, S[4].y); S[5].x = dot2h(hh0, P##k2.z, S[5].x); S[5].y = dot2h(hh0, P##k2.w, S[5].y); \
                    S[6].x = dot2h(hh0, P##k3.x, S[6].x); S[6].y = dot2h(hh0, P##k3.y, S[6].y); S[7].x = dot2h(hh0, P##k3.z, S[7].x); S[7].y = dot2h(hh0, P##k3.w, S[7].y); \
                    (void)t; if (g == 0) { *(yb + (s) * 64) = acc[1]; *(yb + (s) * 64 + SC_T * 64) = acc[0]; } } while (0)
                h8 Ax1, Ax2, Bx1, Bx2; u32x4 Ak0, Ak1, Ak2, Ak3, Bk0, Bk1, Bk2, Bk3; float Av, Bv;
                SC_LOAD(A, 0);
                for (int s = 0; s < SC_T; s += 8) {
                    const LAS float* pg = wb + (s >> 3) * 64;
                    const f32x4 p0 = *(const LAS f32x4*)pg, p1 = *(const LAS f32x4*)(pg + 4), p2 = *(const LAS f32x4*)(pg + 32), p3 = *(const LAS f32x4*)(pg + 36);
#define SC_PAIR(o) SC_LOAD(B, s + (o) + 1); __builtin_amdgcn_sched_barrier(0); SC_STEP(A, s + (o)); __builtin_amdgcn_sched_barrier(0); \
                    SC_LOAD(A, s + (o) + 2); __builtin_amdgcn_sched_barrier(0); SC_STEP(B, s + (o) + 1); __builtin_amdgcn_sched_barrier(0)
                    SC_PAIR(0); SC_PAIR(2); SC_PAIR(4); SC_PAIR(6);
#undef SC_PAIR
                    S[0] *= p0.xy; S[1] *= p0.zw; S[2] *= p1.xy; S[3] *= p1.zw; S[4] *= p2.xy; S[5] *= p2.zw; S[6] *= p3.xy; S[7] *= p3.zw;
                }
#undef SC_LOAD
#undef SC_STEP
                __syncthreads();
            }
        }
    }
}

__device__ __forceinline__ void post_phase(const Params& p, unsigned char* ws, int lane, int gw, int NGW) {
    const float* lnw = pin(p, 28); const float* lnb = pin(p, 29);
    const unsigned short* Y0 = (const unsigned short*)(ws + O_E0); const unsigned short* Y1 = (const unsigned short*)(ws + O_E1);
    const unsigned short* Vg = (const unsigned short*)(ws + O_V); const unsigned short* Gg = (const unsigned short*)(ws + O_G);
    const float* BS = (const float*)(ws + O_BS);
    unsigned short* P = (unsigned short*)(ws + O_POST);
    for (int m = gw; m < M_; m += NGW) {
#pragma unroll
        for (int j = 0; j < 4; ++j) {
            const int ch0 = 8 * (lane + 64 * j), head = ch0 >> 6;
            const size_t off = (size_t)m * D_ + ch0;
            const u32x4 a = *(const u32x4*)(Y0 + off), bq = *(const u32x4*)(Y1 + off);
            float ys[8];
            ys[0] = bf_lo(a.x) + bf_lo(bq.x); ys[1] = bf_hi(a.x) + bf_hi(bq.x); ys[2] = bf_lo(a.y) + bf_lo(bq.y); ys[3] = bf_hi(a.y) + bf_hi(bq.y);
            ys[4] = bf_lo(a.z) + bf_lo(bq.z); ys[5] = bf_hi(a.z) + bf_hi(bq.z); ys[6] = bf_lo(a.w) + bf_lo(bq.w); ys[7] = bf_hi(a.w) + bf_hi(bq.w);
            float s = 0.f;
#pragma unroll
            for (int i = 0; i < 8; ++i) s += ys[i];
            const float mean = red8(s) * (1.f / 64.f);
            float s2 = 0.f;
#pragma unroll
            for (int i = 0; i < 8; ++i) { ys[i] -= mean; s2 += ys[i] * ys[i]; }
            const float rs = rsqrtf(red8(s2) * (1.f / 64.f) + 64e-5f);
            const h8 v8 = *(const h8*)(Vg + off), g8 = *(const h8*)(Gg + off);
            const f32x4 w0 = *(const f32x4*)(lnw + ch0), w1 = *(const f32x4*)(lnw + ch0 + 4), b0 = *(const f32x4*)(lnb + ch0), b1 = *(const f32x4*)(lnb + ch0 + 4);
            const float bsum = BS[(size_t)m * NH_ + head] + BS[(size_t)M_ * NH_ + (size_t)m * NH_ + head];
            float o[8];
#pragma unroll
            for (int i = 0; i < 8; ++i) {
                const float lw = i < 4 ? w0[i] : w1[i - 4], lb = i < 4 ? b0[i] : b1[i - 4];
                o[i] = (ys[i] * rs * lw + lb + bsum * (float)v8[i]) * (float)g8[i];
            }
            u32x4 w; w.x = cvt_pk_bf16(o[0], o[1]); w.y = cvt_pk_bf16(o[2], o[3]); w.z = cvt_pk_bf16(o[4], o[5]); w.w = cvt_pk_bf16(o[6], o[7]);
            *(u32x4*)(P + off) = w;
        }
    }
}

__device__ __forceinline__ void ffn_g1(unsigned char* ws, LAS unsigned char* lds, int tid, int bid, int nb, size_t o_gu) {
    SchedSimple S; S.A = (const char*)(ws + O_XN); S.Bt = (const char*)(ws + o_gu); S.nM = 64; S.nN = 44; S.G = nb; S.c = bid; S.poolmode = 0; S.wgm = 8;
    S.tstepA = (size_t)256 * D_ * 2; S.tstepB = (size_t)256 * D_ * 2;
    EpiSwiGLU E; E.U = (bf16_t*)(ws + O_U);
    gemm_phase(lds, tid, D_, D_, D_, S, E);
}
__device__ __forceinline__ void gemm_resid(unsigned char* ws, float* hout, LAS unsigned char* lds, int tid, int bid, int nb, size_t o_a, int lda, size_t o_bt, int K, int poolmode, const float* src, const float* colscale, float scale) {
    SchedSimple S; S.A = (const char*)(ws + o_a); S.Bt = (const char*)(ws + o_bt); S.nM = 64; S.nN = 8; S.G = nb; S.c = bid; S.poolmode = poolmode; S.wgm = 4;
    S.tstepA = (size_t)256 * lda * 2; S.tstepB = (size_t)256 * K * 2;
    EpiResid E; E.src = src; E.dst = hout; E.colscale = colscale; E.scale = scale;
    gemm_phase(lds, tid, K, lda, K, S, E);
}

__global__ void __launch_bounds__(512) mega(Params p) {
    extern __shared__ __attribute__((aligned(16))) unsigned char smem[];
    LAS unsigned char* lds = (LAS unsigned char*)smem;
    cg::grid_group grid = cg::this_grid();
    XcdBarrier xb;
    {
        volatile LAS unsigned* st = (volatile LAS unsigned*)(lds + 131072);
        if (threadIdx.x == 0) { st[0] = 0u; st[1] = 0u; }
        __syncthreads();
        xb.bar = (unsigned*)(p.ws + O_BAR); xb.x = xb_xcc_id(); xb.st = st;
        if (threadIdx.x == 0) (void)xb_add(&xb.bar[XB_XCNT(xb.x)], 1u);
    }
    constexpr int nb = 256;
    const int wid_s = __builtin_amdgcn_readfirstlane((int)(threadIdx.x >> 6));
#define PROLOG int m1_ = -1; asm volatile("" : "+s"(m1_)); int tid = wid_s * 64 + (int)__builtin_amdgcn_mbcnt_hi(m1_, __builtin_amdgcn_mbcnt_lo(m1_, 0)); int bid = blockIdx.x; asm volatile("" : "+s"(bid)); \
        const int lane = tid & 63, wave = tid >> 6; const int gw = bid * 8 + wave, NGW = nb * 8; LAS float* scr = (LAS float*)(lds + wave * 8704); \
        unsigned char* ws = p.ws; asm volatile("" : "+s"(ws)); float* h = p.out; asm volatile("" : "+s"(h)); (void)lane; (void)gw; (void)NGW; (void)scr; (void)h; (void)ws;
    for (int ph = p.ph_lo; ph < p.ph_hi; ++ph) {
#if REP_MASK
      const int nrep = ((REP_MASK >> ph) & 1) + 1;
      for (int rep = 0; rep < nrep; ++rep) {
        const float rsc = (rep == nrep - 1) ? 1.f : 0.f;
        if (rep) grid.sync();
#else
      { constexpr float rsc = 1.f;
#endif
        switch (ph) {
        case 0: { PROLOG
            norm_phase<false>(pin(p, 0), pin(p, 1), (bf16_t*)(ws + O_XN), nullptr, lane, gw, NGW);
            conv_ffn(pin(p, 2), pin(p, 3), pin(p, 4), (bf16_t*)(ws + O_AGU), (bf16_t*)(ws + O_AD), scr, lane, gw, NGW);
            conv_ffn(pin(p, 7), pin(p, 8), pin(p, 9), (bf16_t*)(ws + O_BGU), (bf16_t*)(ws + O_BD), scr, lane, gw, NGW);
            conv_rwkv(p, ws, scr, lane, gw, NGW);
        } break;
        case 1: { PROLOG
            ffn_g1(ws, lds, tid, bid, nb, O_AGU);
        } break;
        case 2: { PROLOG
            gemm_resid(ws, h, lds, tid, bid, nb, O_U, F_, O_AD, F_, 0, pin(p, 0), nullptr, 0.5f * rsc);
        } break;
        case 3: { PROLOG
            pool_prep_phase(h, pin(p, 5), (bf16_t*)(ws + O_XN), lds, tid, lane, wave, bid, nb);
            __syncthreads();
            conv_ffn(pin(p, 2) + (size_t)D_ * F_, pin(p, 3) + (size_t)D_ * F_, pin(p, 4) + (size_t)D_ * F_, (bf16_t*)(ws + O_AGU), (bf16_t*)(ws + O_AD), scr, lane, gw, NGW);
        } break;
        case 4: { PROLOG
            gemm_resid(ws, h, lds, tid, bid, nb, O_XN, D_, O_POOLT, 512, 1, h, pin(p, 11), 1.f * rsc);
        } break;
        case 5: { PROLOG
            norm_phase<false>(h, pin(p, 6), (bf16_t*)(ws + O_XN), nullptr, lane, gw, NGW);
        } break;
        case 6: { PROLOG
            ffn_g1(ws, lds, tid, bid, nb, O_BGU);
        } break;
        case 7: { PROLOG
            gemm_resid(ws, h, lds, tid, bid, nb, O_U, F_, O_BD, F_, 0, h, nullptr, 0.5f * rsc);
        } break;
        case 8: { PROLOG
            norm_phase<false>(h, pin(p, 1) + D_, (bf16_t*)(ws + O_XN), nullptr, lane, gw, NGW);
        } break;
        case 9: { PROLOG
            ffn_g1(ws, lds, tid, bid, nb, O_AGU);
        } break;
        case 10: { PROLOG
            gemm_resid(ws, h, lds, tid, bid, nb, O_U, F_, O_AD, F_, 0, h, nullptr, 0.5f * rsc);
        } break;
        case 11: { PROLOG
            rwkv_prep_phase(h, pin(p, 5) + D_, pin(p, 12), (bf16_t*)(ws + O_X6), lane, gw, NGW);
        } break;
        case 12: { PROLOG
            {
            SchedProj S; S.ws = (const char*)ws; S.G = nb; S.c = bid;
            EpiProj E; E.ws = ws;
            gemm_phase(lds, tid, D_, D_, D_, S, E);
        }
        } break;
        case 13: { PROLOG
            {
            SchedLora2 S; S.ws = (const char*)ws; S.G = nb; S.c = bid;
            EpiLora2 E; E.ws = ws; E.w0 = pin(p, 17); E.a0 = pin(p, 20);
            gemm_phase(lds, tid, 256, 256, 256, S, E);
        }
        } break;
        case 14: { PROLOG
            scan_phase(p, ws, lds, tid, lane, wave, bid, nb);
        } break;
        case 15: { PROLOG
            post_phase(p, ws, lane, gw, NGW);
        } break;
        case 16: { PROLOG
            gemm_resid(ws, h, lds, tid, bid, nb, O_POST, D_, O_WOT, D_, 0, h, nullptr, 1.f * rsc);
        } break;
        case 17: { PROLOG
            norm_phase<false>(h, pin(p, 6) + D_, (bf16_t*)(ws + O_XN), nullptr, lane, gw, NGW);
            conv_ffn(pin(p, 7) + (size_t)D_ * F_, pin(p, 8) + (size_t)D_ * F_, pin(p, 9) + (size_t)D_ * F_, (bf16_t*)(ws + O_BGU), (bf16_t*)(ws + O_BD), scr, lane, gw, NGW);
        } break;
        case 18: { PROLOG
            ffn_g1(ws, lds, tid, bid, nb, O_BGU);
        } break;
        case 19: { PROLOG
            gemm_resid(ws, h, lds, tid, bid, nb, O_U, F_, O_BD, F_, 0, h, nullptr, 0.5f * rsc);
        } break;
        case 20: { PROLOG
            norm_phase<true>(h, pin(p, 30), nullptr, h, lane, gw, NGW);
        } break;
        default: break;
        }
      }
        if (ph + 1 < p.ph_hi) {
            if (p.ph_lo < 0) grid.sync();
            xcd_barrier(xb, threadIdx.x == 0);
        }
    }
}

extern "C" void kernel_launch(void* const* d_in, const int* in_sizes, int n_in, void* d_out, int out_size, void* d_ws, size_t ws_size, hipStream_t stream) {
    static int grid_blocks = 0;
    if (grid_blocks == 0) {
        if (n_in != 31 || out_size != M_ * D_ || ws_size < WS_NEED) { fprintf(stderr, "kernel_launch: unexpected shapes (n_in %d out %d ws %zu)\n", n_in, out_size, ws_size); grid_blocks = -1; return; }
        int dev = 0, cus = 0, per_cu = 0;
        hipGetDevice(&dev);
        hipDeviceGetAttribute(&cus, hipDeviceAttributeMultiprocessorCount, dev);
        if (hipFuncSetAttribute((const void*)mega, hipFuncAttributeMaxDynamicSharedMemorySize, LDS_BYTES) != hipSuccess) { fprintf(stderr, "kernel_launch: hipFuncSetAttribute failed\n"); grid_blocks = -1; return; }
        hipOccupancyMaxActiveBlocksPerMultiprocessor(&per_cu, (const void*)mega, 512, LDS_BYTES);
        if (per_cu < 1) per_cu = 1;
        if (cus * per_cu < 256) { fprintf(stderr, "kernel_launch: device holds only %d co-resident workgroups, 256 needed\n", cus * per_cu); grid_blocks = -1; (void)hipGetLastError(); return; }
        grid_blocks = 256;
        (void)hipGetLastError();
    }
    if (grid_blocks < 0) return;
    Params p{};
    for (int i = 0; i < 31; ++i) p.in[i] = (const float*)d_in[i];
    p.out = (float*)d_out; p.ws = (unsigned char*)d_ws;
#if MK_SINGLE
    (void)hipMemsetAsync((unsigned char*)d_ws + O_BAR, 0, XCD_BAR_WORDS * 4, stream);
    p.ph_lo = 0; p.ph_hi = NPHASE;
    void* args[] = {&p};
    hipError_t e = hipLaunchCooperativeKernel((const void*)mega, dim3(grid_blocks), dim3(512), args, LDS_BYTES, stream);
    if (e != hipSuccess) fprintf(stderr, "cooperative launch failed: %s (grid %d)\n", hipGetErrorString(e), grid_blocks);
#else
    for (int ph = 0; ph < NPHASE; ++ph) {
        p.ph_lo = ph; p.ph_hi = ph + 1;
        hipLaunchKernelGGL(mega, dim3(grid_blocks), dim3(512), LDS_BYTES, stream, p);
    }
#endif
}
```

```cpp
#include <hip/hip_runtime.h>
#include <hip/hip_cooperative_groups.h>
#include <cstdio>
namespace cg = cooperative_groups;

#ifndef REP_MASK
#define REP_MASK 0
#endif
#ifndef MK_SINGLE
#define MK_SINGLE 1
#endif

#define LAS __attribute__((address_space(3)))
typedef unsigned short bf16_t;
typedef short bf16x8 __attribute__((ext_vector_type(8)));
typedef float f32x4 __attribute__((ext_vector_type(4)));
typedef float f32x2 __attribute__((ext_vector_type(2)));
typedef unsigned u32x4 __attribute__((ext_vector_type(4)));
typedef unsigned u32x2 __attribute__((ext_vector_type(2)));
typedef _Float16 h8 __attribute__((ext_vector_type(8)));

constexpr int M_ = 16384, D_ = 2048, F_ = 5632, S_ = 4096, NH_ = 32;
constexpr int NPHASE = 21;
constexpr int LDS_BYTES = 131072 + 16;
constexpr size_t MiB = 1ull << 20;
constexpr size_t O_WRT = 0 * MiB, O_WKT = 8 * MiB, O_WVT = 16 * MiB, O_WOT = 24 * MiB, O_W1C = 32 * MiB, O_A1C = 33 * MiB, O_G1C = 34 * MiB;
constexpr size_t O_W2T0 = 35 * MiB, O_W2T1 = 36 * MiB, O_A2T0 = 37 * MiB, O_A2T1 = 38 * MiB, O_G2T = 39 * MiB, O_POOLT = 40 * MiB;
constexpr size_t O_BAR = 42 * MiB;
constexpr size_t O_XN = 70 * MiB;
constexpr size_t O_AGU = 134 * MiB, O_AD = 178 * MiB, O_BGU = 200 * MiB, O_BD = 244 * MiB;
constexpr size_t O_U = 266 * MiB;
constexpr size_t O_X6 = 70 * MiB;
constexpr size_t O_R = 454 * MiB, O_K = 518 * MiB, O_V = 582 * MiB, O_LW = 646 * MiB, O_LA = 654 * MiB, O_LG = 662 * MiB, O_BS = 670 * MiB;
constexpr size_t O_E0 = 70 * MiB, O_E1 = 134 * MiB, O_A0 = 198 * MiB, O_A1 = 262 * MiB, O_G = 326 * MiB, O_POST = 390 * MiB;
constexpr size_t WS_NEED = 674 * MiB;

struct Params {
    const float* in[31];
    float* out;
    unsigned char* ws;
    int ph_lo, ph_hi;
};

__device__ __forceinline__ const float* pin(const Params& p, int i) { asm volatile("" : "+s"(i)); return p.in[i]; }
__device__ __forceinline__ unsigned cvt_pk_bf16(float lo, float hi) { unsigned r; asm volatile("v_cvt_pk_bf16_f32 %0, %1, %2" : "=v"(r) : "v"(lo), "v"(hi)); return r; }
__device__ __forceinline__ unsigned pk_h2(float a, float b) { auto h = __builtin_amdgcn_cvt_pkrtz(a, b); return __builtin_bit_cast(unsigned, h); }
__device__ __forceinline__ float bf_lo(unsigned w) { return __builtin_bit_cast(float, w << 16); }
__device__ __forceinline__ float bf_hi(unsigned w) { return __builtin_bit_cast(float, w & 0xffff0000u); }
template <int CTRL> __device__ __forceinline__ float dpp_f(float v) {
    return __builtin_bit_cast(float, __builtin_amdgcn_update_dpp(0, __builtin_bit_cast(int, v), CTRL, 0xF, 0xF, true));
}
__device__ __forceinline__ float red8(float v) { v += dpp_f<0xB1>(v); v += dpp_f<0x4E>(v); v += dpp_f<0x141>(v); return v; }
__device__ __forceinline__ float wave_sum(float v) {
    v += dpp_f<0xB1>(v); v += dpp_f<0x4E>(v); v += dpp_f<0x141>(v); v += dpp_f<0x140>(v);
    const int iv = __builtin_bit_cast(int, v);
    const float r0 = __builtin_bit_cast(float, __builtin_amdgcn_readlane(iv, 0)), r1 = __builtin_bit_cast(float, __builtin_amdgcn_readlane(iv, 16));
    const float r2 = __builtin_bit_cast(float, __builtin_amdgcn_readlane(iv, 32)), r3 = __builtin_bit_cast(float, __builtin_amdgcn_readlane(iv, 48));
    return (r0 + r1) + (r2 + r3);
}
__device__ __forceinline__ float sigmoidf_(float x) { return __builtin_amdgcn_rcpf(1.f + __expf(-x)); }
#define LDS_WAIT() asm volatile("s_waitcnt lgkmcnt(0)" ::: "memory")


#define XB_TMO      128
#define XB_XCNT(j)  (256  + 64 * (j))
#define XB_XSUB(j)  (1280 + 64 * (j))
#define XB_XGEN(j)  (2304 + 64 * (j))
#define XB_TOP      3328
#define XB_TOPGEN   3392
#define XCD_BAR_WORDS 3456
#define XB_SPIN_CAP (1u << 18)
__device__ __forceinline__ unsigned xb_ld(unsigned* p)              { return __hip_atomic_load(p, __ATOMIC_RELAXED, __HIP_MEMORY_SCOPE_AGENT); }
__device__ __forceinline__ unsigned xb_add(unsigned* p, unsigned v) { return __hip_atomic_fetch_add(p, v, __ATOMIC_RELAXED, __HIP_MEMORY_SCOPE_AGENT); }
__device__ __forceinline__ unsigned xb_xcc_id() { return (unsigned)__builtin_amdgcn_s_getreg((3 << 11) | 20) & 0xFu; }
#define XB_SPIN(cond, bar) do { unsigned _sp = 0; while (cond) { __builtin_amdgcn_s_sleep(1); \
    if ((++_sp & 255u) == 0u) { if (xb_ld(&(bar)[XB_TMO])) break; if (_sp > XB_SPIN_CAP) { atomicAdd(&(bar)[XB_TMO], 1u); break; } } } } while (0)
struct XcdBarrier { unsigned* bar; unsigned x; volatile LAS unsigned* st; };
__device__ __forceinline__ void xcd_barrier_complete(unsigned* bar, unsigned x, unsigned& nloc, unsigned& nx) {
    const unsigned G = gridDim.x;
    unsigned sum, cnt, mine, sp = 0u;
    for (;;) {
        sum = 0u; cnt = 0u; mine = 0u;
#pragma unroll
        for (unsigned j = 0; j < 16; ++j) { const unsigned c = xb_ld(&bar[XB_XCNT(j)]); sum += c; cnt += (c > 0u) ? 1u : 0u; mine = (j == x) ? c : mine; }
        if (sum == G) break;
        __builtin_amdgcn_s_sleep(1);
        if ((++sp & 255u) == 0u) { if (xb_ld(&bar[XB_TMO])) break; if (sp > XB_SPIN_CAP) { atomicAdd(&bar[XB_TMO], 1u); break; } }
    }
    nloc = mine > 0u ? mine : 1u; nx = cnt > 0u ? cnt : 1u;
}
__device__ __forceinline__ void xcd_barrier(const XcdBarrier& b, bool leader_thread) {
    asm volatile("s_waitcnt vmcnt(0)" ::: "memory");
    __syncthreads();
    if (leader_thread) {
        unsigned* bar = b.bar;
        __builtin_amdgcn_s_waitcnt(0);
        unsigned nloc = b.st[0], nx = b.st[1];
        if (nloc == 0u) { xcd_barrier_complete(bar, b.x, nloc, nx); b.st[0] = nloc; b.st[1] = nx; }
        const unsigned old = xb_add(&bar[XB_XSUB(b.x)], 1u);
        const unsigned gen = old / nloc;
        if (old + 1u == (gen + 1u) * nloc) {
            __builtin_amdgcn_fence(__ATOMIC_RELEASE, "agent");
            asm volatile("s_waitcnt vmcnt(0)" ::: "memory");
            const unsigned og = xb_add(&bar[XB_TOP], 1u);
            const unsigned tg = og / nx;
            if (og + 1u == (tg + 1u) * nx) xb_add(&bar[XB_TOPGEN], 1u);
            else XB_SPIN(xb_ld(&bar[XB_TOPGEN]) == tg, bar);
            __builtin_amdgcn_fence(__ATOMIC_ACQUIRE, "agent");
            xb_add(&bar[XB_XGEN(b.x)], 1u);
            asm volatile("s_waitcnt vmcnt(0)" ::: "memory");
        } else {
            XB_SPIN(xb_ld(&bar[XB_XGEN(b.x)]) == gen, bar);
            __builtin_amdgcn_fence(__ATOMIC_ACQUIRE, "agent");
            asm volatile("s_waitcnt vmcnt(0)" ::: "memory");
        }
    }
    __syncthreads();
}

__device__ __forceinline__ void tr_load(const float* src, int N, int k0, int n0, float (&v)[32], int lane) {
#pragma unroll
    for (int i = 0; i < 32; ++i) v[i] = src[(size_t)(k0 + 2 * i + (lane >> 5)) * N + n0 + (lane & 31)];
}
__device__ __forceinline__ void tr_store(const float (&v)[32], int k0, int n0, bf16_t* dst, int ldd, int mode, int row0, int col0, const float* scale, LAS float* scr, int lane) {
#pragma unroll
    for (int i = 0; i < 32; ++i) {
        const int kk = 2 * i + (lane >> 5);
        float x = v[i];
        if (scale) x *= scale[k0 + kk];
        scr[kk * 33 + (lane & 31)] = x;
    }
    LDS_WAIT();
    const int c = lane & 7;
#pragma unroll
    for (int j = 0; j < 4; ++j) {
        const int n = (lane >> 3) + 8 * j; const LAS float* s = scr + (8 * c) * 33 + n;
        u32x4 o; o.x = cvt_pk_bf16(s[0 * 33], s[1 * 33]); o.y = cvt_pk_bf16(s[2 * 33], s[3 * 33]); o.z = cvt_pk_bf16(s[4 * 33], s[5 * 33]); o.w = cvt_pk_bf16(s[6 * 33], s[7 * 33]);
        const int ng = n0 + n;
        const int row = mode ? (256 * (ng >> 7) + row0 + (ng & 127)) : (row0 + ng);
        *(u32x4*)(dst + (size_t)row * ldd + col0 + k0 + 8 * c) = o;
    }
    LDS_WAIT();
}
__device__ __forceinline__ void tr_mat(const float* src, int K, int N, bf16_t* dst, int ldd, int mode, int row0, int col0, const float* scale, LAS float* scr, int lane, int gw, int NGW, int rot) {
    const int nblk = N / 32, items = (K / 64) * nblk;
    int it = gw - rot; while (it < 0) it += NGW;
    float va[32], vb[32];
    if (it < items) tr_load(src, N, 64 * (it / nblk), 32 * (it % nblk), va, lane);
    while (it < items) {
        const int nx = it + NGW;
        if (nx < items) tr_load(src, N, 64 * (nx / nblk), 32 * (nx % nblk), vb, lane);
        tr_store(va, 64 * (it / nblk), 32 * (it % nblk), dst, ldd, mode, row0, col0, scale, scr, lane);
#pragma unroll
        for (int i = 0; i < 32; ++i) va[i] = vb[i];
        it = nx;
    }
}
__device__ __forceinline__ void conv_ffn(const float* gate, const float* up, const float* down, bf16_t* gu, bf16_t* dn, LAS float* scr, int lane, int gw, int NGW) {
    tr_mat(gate, D_, F_, gu, D_, 1, 0, 0, nullptr, scr, lane, gw, NGW, 0);
    tr_mat(up, D_, F_, gu, D_, 1, 128, 0, nullptr, scr, lane, gw, NGW, 5632);
    tr_mat(down, F_, D_, dn, F_, 0, 0, 0, nullptr, scr, lane, gw, NGW, 11264);
}
__device__ __forceinline__ void conv_rwkv(const Params& p, unsigned char* ws, LAS float* scr, int lane, int gw, int NGW) {
    tr_mat(pin(p, 13), D_, D_, (bf16_t*)(ws + O_WRT), D_, 0, 0, 0, nullptr, scr, lane, gw, NGW, 0);
    tr_mat(pin(p, 14), D_, D_, (bf16_t*)(ws + O_WKT), D_, 0, 0, 0, nullptr, scr, lane, gw, NGW, 0);
    tr_mat(pin(p, 15), D_, D_, (bf16_t*)(ws + O_WVT), D_, 0, 0, 0, nullptr, scr, lane, gw, NGW, 0);
    tr_mat(pin(p, 16), D_, D_, (bf16_t*)(ws + O_WOT), D_, 0, 0, 0, nullptr, scr, lane, gw, NGW, 0);
    for (int d = 0; d < 2; ++d) {
        tr_mat(pin(p, 18) + (size_t)d * D_ * 96, D_, 96, (bf16_t*)(ws + O_W1C), D_, 0, d * 96, 0, nullptr, scr, lane, gw, NGW, d * 96);
        tr_mat(pin(p, 21) + (size_t)d * D_ * 96, D_, 96, (bf16_t*)(ws + O_A1C), D_, 0, d * 96, 0, nullptr, scr, lane, gw, NGW, 192 + d * 96);
    }
    tr_mat(pin(p, 23), D_, 256, (bf16_t*)(ws + O_G1C), D_, 0, 0, 0, nullptr, scr, lane, gw, NGW, 384);
    tr_mat(pin(p, 24), 256, D_, (bf16_t*)(ws + O_G2T), 256, 0, 0, 0, nullptr, scr, lane, gw, NGW, 1280);
    for (int g = 0; g < 4; ++g)
        tr_mat(pin(p, 10) + (size_t)g * 512 * 512, 512, 512, (bf16_t*)(ws + O_POOLT) + (size_t)g * 512 * 512, 512, 0, 0, 0, nullptr, scr, lane, gw, NGW, 1536 + g * 128);
    const int gt = gw * 64 + lane, NT = NGW * 64;
    for (int idx = gt; idx < 2 * 64 * 2048; idx += NT) {
        const int which = idx / (64 * 2048), r = idx % (64 * 2048);
        bf16_t* dst = (bf16_t*)(ws + (which ? O_A1C : O_W1C)) + (size_t)192 * 2048;
        dst[r] = 0;
    }
    for (int idx = gt; idx < 4 * 256 * 2048; idx += NT) {
        const int mat = idx / (256 * 2048), r = idx % (256 * 2048), kk = r / 2048, n = r % 2048;
        const int d = mat & 1; const bool isa = mat >= 2;
        const float* src = (isa ? pin(p, 22) : pin(p, 19)) + (size_t)d * 96 * D_;
        bf16_t* dst = (bf16_t*)(ws + (isa ? (d ? O_A2T1 : O_A2T0) : (d ? O_W2T1 : O_W2T0)));
        const int j = kk - d * 96;
        const float v = (j >= 0 && j < 96) ? src[(size_t)j * D_ + n] : 0.f;
        dst[(size_t)n * 256 + kk] = (bf16_t)(cvt_pk_bf16(v, 0.f) & 0xffffu);
    }
}

template <bool FINAL>
__device__ __forceinline__ void norm_phase(const float* src, const float* gain, bf16_t* dst, float* fdst, int lane, int gw, int NGW) {
    f32x4 gv[8];
#pragma unroll
    for (int j = 0; j < 8; ++j) gv[j] = ((const f32x4*)gain)[lane + 64 * j];
    for (int row = gw; row < M_; row += NGW) {
        const f32x4* xr = (const f32x4*)(src + (size_t)row * D_) + lane;
        f32x4 v[8]; float s = 0.f;
#pragma unroll
        for (int j = 0; j < 8; ++j) { v[j] = xr[64 * j]; s += (v[j].x * v[j].x + v[j].y * v[j].y) + (v[j].z * v[j].z + v[j].w * v[j].w); }
        const float rstd = rsqrtf(wave_sum(s) * (1.f / D_) + 1e-6f);
        if (FINAL) {
            f32x4* o = (f32x4*)(fdst + (size_t)row * D_) + lane;
#pragma unroll
            for (int j = 0; j < 8; ++j) o[64 * j] = v[j] * rstd * gv[j];
        } else {
            u32x2* o = (u32x2*)(dst + (size_t)row * D_) + lane;
#pragma unroll
            for (int j = 0; j < 8; ++j) { f32x4 t = v[j] * rstd * gv[j]; u32x2 w; w.x = cvt_pk_bf16(t.x, t.y); w.y = cvt_pk_bf16(t.z, t.w); o[64 * j] = w; }
        }
    }
}

__device__ __forceinline__ void load_norm_row(const float* src, int row, const f32x4 (&gv)[8], f32x4 (&o)[8], int lane) {
    const f32x4* xr = (const f32x4*)(src + (size_t)row * D_) + lane;
    float s = 0.f;
#pragma unroll
    for (int j = 0; j < 8; ++j) { o[j] = xr[64 * j]; s += (o[j].x * o[j].x + o[j].y * o[j].y) + (o[j].z * o[j].z + o[j].w * o[j].w); }
    const float rstd = rsqrtf(wave_sum(s) * (1.f / D_) + 1e-6f);
#pragma unroll
    for (int j = 0; j < 8; ++j) o[j] = o[j] * rstd * gv[j];
}
__device__ __forceinline__ void rwkv_prep_phase(const float* h, const float* gain, const float* mu, bf16_t* x6, int lane, int gw, int NGW) {
    f32x4 gv[8];
#pragma unroll
    for (int j = 0; j < 8; ++j) gv[j] = ((const f32x4*)gain)[lane + 64 * j];
    for (int run = gw; run < M_ / 8; run += NGW) {
        const int row0 = run * 8, t0 = row0 & (S_ - 1);
        f32x4 prev[8], cur[8], nxt[8];
        if (t0 > 0) load_norm_row(h, row0 - 1, gv, prev, lane);
        else {
#pragma unroll
            for (int j = 0; j < 8; ++j) prev[j] = (f32x4){0.f, 0.f, 0.f, 0.f};
        }
        load_norm_row(h, row0, gv, cur, lane);
        for (int i = 0; i < 8; ++i) {
            const int row = row0 + i, t = t0 + i;
            if (t + 1 < S_) load_norm_row(h, row + 1, gv, nxt, lane);
            else {
#pragma unroll
                for (int j = 0; j < 8; ++j) nxt[j] = (f32x4){0.f, 0.f, 0.f, 0.f};
            }
#pragma unroll
            for (int j = 0; j < 8; ++j) {
                const f32x4 xx = (prev[j] + nxt[j]) * 0.5f - cur[j];
#pragma unroll
                for (int q = 0; q < 6; ++q) {
                    const f32x4 m4 = ((const f32x4*)(mu + (size_t)q * D_))[lane + 64 * j];
                    const f32x4 xm = cur[j] + xx * m4;
                    u32x2 w; w.x = cvt_pk_bf16(xm.x, xm.y); w.y = cvt_pk_bf16(xm.z, xm.w);
                    ((u32x2*)(x6 + (size_t)q * M_ * D_ + (size_t)row * D_))[lane + 64 * j] = w;
                }
                prev[j] = cur[j]; cur[j] = nxt[j];
            }
        }
    }
}

__device__ __forceinline__ void pool_prep_phase(const float* h, const float* gain, bf16_t* outp, LAS unsigned char* lds, int tid, int lane, int wave, int bid, int nb) {
    LAS float* rs = (LAS float*)lds;
    for (int chunk = bid; chunk < M_ / 64; chunk += nb) {
        const int m0 = chunk * 64, b = m0 / S_, t0 = m0 % S_;
        __syncthreads();
        for (int rr = wave; rr < 80; rr += 8) {
            const int t = t0 - 8 + rr;
            if (t >= 0 && t < S_) {
                const f32x4* xr = (const f32x4*)(h + ((size_t)b * S_ + t) * D_) + lane;
                float s = 0.f;
#pragma unroll
                for (int j = 0; j < 8; ++j) { const f32x4 v = xr[64 * j]; s += (v.x * v.x + v.y * v.y) + (v.z * v.z + v.w * v.w); }
                s = wave_sum(s);
                if (lane == 0) rs[rr] = rsqrtf(s * (1.f / D_) + 1e-6f);
            }
        }
        __syncthreads();
        const int c = 4 * tid, g = tid >> 7, w = 2 << g, half = w >> 1;
        const f32x4 gn = *(const f32x4*)(gain + c);
        const float* hb = h + (size_t)b * S_ * D_ + c;
#define HN(t) ((*(const f32x4*)(hb + (size_t)(t) * D_)) * rs[(t) - t0 + 8] * gn)
        int lo = t0 - half; if (lo < 0) lo = 0;
        int hi = t0 + half; if (hi > S_) hi = S_;
        f32x4 sum = (f32x4){0.f, 0.f, 0.f, 0.f};
        for (int u = lo; u < hi; ++u) sum += HN(u);
#pragma unroll 8
        for (int i = 0; i < 64; ++i) {
            const int t = t0 + i;
            const f32x4 x = HN(t);
            const float inv = 1.f / (float)(hi - lo);
            const f32x4 o = sum * inv - x;
            u32x2 wv; wv.x = cvt_pk_bf16(o.x, o.y); wv.y = cvt_pk_bf16(o.z, o.w);
            *(u32x2*)(outp + ((size_t)b * S_ + t) * D_ + c) = wv;
            if (i < 63) {
                if (t + 1 - half > 0) { sum -= HN(lo); ++lo; }
                if (t + half < S_) { sum += HN(t + half); ++hi; }
            }
        }
#undef HN
    }
}

constexpr int BM = 256, BK = 64, HALF = 128, HTB = HALF * BK * 2;
__device__ __forceinline__ int lds_byte(int r, int c) { const int st = (r >> 4) * 2 + (c >> 5), rr = r & 15, cc = c & 31, ob = rr * 64 + cc * 2; return st * 1024 + (ob ^ (((ob >> 9) & 1) << 5)); }
__device__ __forceinline__ void stage_rc(int b, int& R, int& C) { const int st = b / 1024, sb = b % 1024, swz = sb ^ (((sb >> 9) & 1) << 5); R = (st >> 1) * 16 + swz / 64; C = (st & 1) * 32 + (swz % 64) / 2; }
__device__ __forceinline__ int perm32(int rho) { const int n = rho >> 4, i = rho & 15; return 8 * (i >> 2) + 4 * n + (i & 3); }

struct Unit { const char* a; const char* b; int pm, pn, job; };

__device__ __forceinline__ void remap_tile(int l, int nM, int nN, int& pm, int& pn, int wgm = 8) {
    const int nwg = nM * nN; int wgid = l;
    { const int q = nwg / 8, r = nwg % 8, xcd = wgid % 8, off = wgid / 8; wgid = (xcd < r ? xcd * (q + 1) : r * (q + 1) + (xcd - r) * q) + off; }
    const int nig = wgm * nN, gid = wgid / nig, fm = gid * wgm, gsz = (nM - fm) < wgm ? (nM - fm) : wgm;
    pm = fm + ((wgid % nig) % gsz); pn = (wgid % nig) / gsz;
}

template <class Epi, class Sched>
__device__ __forceinline__ void gemm_phase(LAS unsigned char* lds, const int tid, const int K, const int lda, const int ldb, const Sched& S, const Epi& E) {
    const int wid = __builtin_amdgcn_readfirstlane(tid >> 6), lane = tid & 63, wr = wid >> 2, wc = wid & 3, fr = lane & 15, fq = lane >> 4;
    const int nt = K / BK;
    unsigned voffA, voffB;
    { int R, C; stage_rc(tid * 16, R, C); const int Rb = Epi::PERM ? ((R & ~31) + perm32(R & 31)) : R;
        voffA = (unsigned)(R * lda + C) * 2u; voffB = (unsigned)(Rb * ldb + C) * 2u; }
    const size_t q64A = (size_t)64 * lda * 2, q64B = (size_t)64 * ldb * 2;
    const size_t kstep = (size_t)(BK * 2);
    const size_t hstepA = (size_t)HALF * lda * 2, hstepB = (size_t)HALF * ldb * 2;
    const unsigned ldsw = (unsigned)wid * 1024u;
    const int aoff = lds_byte(wr * 64 + fr, fq * 8), boff = lds_byte(wc * 32 + fr, fq * 8);
#define PG8_SA(b, h) (((b) * 2 + (h)) * HTB)
#define PG8_SB(b, h) ((4 + (b) * 2 + (h)) * HTB)
#define PG8_STAGE(bufoff, gbase, voff) do { \
        __builtin_amdgcn_global_load_lds((const unsigned*)((const char*)(gbase) + (voff)), (LAS unsigned*)(lds + (bufoff) + ldsw), 16, 0, 0); \
        __builtin_amdgcn_global_load_lds((const unsigned*)((const char*)(gbase) + q64_##voff + (voff)), (LAS unsigned*)(lds + (bufoff) + ldsw + 8192), 16, 0, 0); } while (0)
#define q64_voffA q64A
#define q64_voffB q64B
#define PG8_LDA(dst, b, h) do { _Pragma("unroll") for (int m = 0; m < 4; ++m) _Pragma("unroll") for (int k = 0; k < 2; ++k) dst[m][k] = *(const LAS bf16x8*)(lds + PG8_SA(b, h) + aoff + m * 2048 + k * 1024); } while (0)
#define PG8_LDB(dst, b, h) do { _Pragma("unroll") for (int n = 0; n < 2; ++n) _Pragma("unroll") for (int k = 0; k < 2; ++k) dst[n][k] = *(const LAS bf16x8*)(lds + PG8_SB(b, h) + boff + n * 2048 + k * 1024); } while (0)
#define PG8_MMA(ai, bj, At, Bt) do { __builtin_amdgcn_s_setprio(1); _Pragma("unroll") for (int m = 0; m < 4; ++m) _Pragma("unroll") for (int n = 0; n < 2; ++n) _Pragma("unroll") for (int k = 0; k < 2; ++k) \
        acc[ai][bj][m][n] = __builtin_amdgcn_mfma_f32_16x16x32_bf16(Bt[n][k], At[m][k], acc[ai][bj][m][n], 0, 0, 0); __builtin_amdgcn_s_setprio(0); } while (0)
#define PG8_WAIT_V(n) asm volatile("s_waitcnt vmcnt(" #n ")" ::: "memory")
#define PG8_WAIT_L(n) asm volatile("s_waitcnt lgkmcnt(" #n ")" ::: "memory")
#define PG8_BAR __builtin_amdgcn_s_barrier()
#define PG8_SCHED __builtin_amdgcn_sched_barrier(0)
    Unit cur, nxt; int ui = 0;
    if (!S.next(0, cur)) return;
    f32x4 acc[2][2][4][2];
#pragma unroll
    for (int a = 0; a < 2; ++a)
#pragma unroll
        for (int b = 0; b < 2; ++b)
#pragma unroll
            for (int m = 0; m < 4; ++m)
#pragma unroll
                for (int n = 0; n < 2; ++n) acc[a][b][m][n] = (f32x4){0.f, 0.f, 0.f, 0.f};
    bf16x8 At[4][2], B0[2][2], B1[2][2];
    const char* cA = cur.a; const char* cB = cur.b;
    PG8_STAGE(PG8_SB(0, 0), cB, voffB); PG8_STAGE(PG8_SA(0, 0), cA, voffA); PG8_STAGE(PG8_SB(0, 1), cB + hstepB, voffB); PG8_STAGE(PG8_SA(0, 1), cA + hstepA, voffA);
    if (wr == 1) PG8_BAR;
    PG8_WAIT_V(4); PG8_BAR;
    PG8_STAGE(PG8_SB(1, 0), cB + kstep, voffB); PG8_STAGE(PG8_SA(1, 0), cA + kstep, voffA); PG8_STAGE(PG8_SB(1, 1), cB + hstepB + kstep, voffB);
    PG8_WAIT_V(6); PG8_BAR;
    for (;;) {
        const bool has_next = S.next(ui + 1, nxt);
        const char* nA = has_next ? nxt.a : cA; const char* nB = has_next ? nxt.b : cB;
        for (int t = 0; t < nt; t += 2) {
            const bool last = (t == nt - 2);
            const char* a1 = cA + (size_t)(t + 1) * kstep;
            const char* a2 = last ? nA : cA + (size_t)(t + 2) * kstep; const char* b2 = last ? nB : cB + (size_t)(t + 2) * kstep;
            const char* a3 = a2 + kstep; const char* b3 = b2 + kstep;
            PG8_LDB(B0, 0, 0); PG8_SCHED; PG8_LDA(At, 0, 0); PG8_STAGE(PG8_SA(1, 1), a1 + hstepA, voffA);
            PG8_WAIT_L(8); PG8_BAR; PG8_WAIT_L(0); PG8_MMA(0, 0, At, B0); PG8_BAR; PG8_SCHED;
            PG8_LDB(B1, 0, 1); PG8_STAGE(PG8_SB(0, 0), b2, voffB);
            PG8_BAR; PG8_WAIT_L(0); PG8_MMA(0, 1, At, B1); PG8_BAR;
            PG8_LDA(At, 0, 1); PG8_STAGE(PG8_SA(0, 0), a2, voffA);
            PG8_BAR; PG8_WAIT_L(0); PG8_MMA(1, 0, At, B0); PG8_BAR; PG8_SCHED;
            PG8_STAGE(PG8_SB(0, 1), b2 + hstepB, voffB);
            PG8_WAIT_V(6); PG8_BAR; PG8_MMA(1, 1, At, B1); PG8_BAR;
            PG8_LDB(B0, 1, 0); PG8_SCHED; PG8_LDA(At, 1, 0); PG8_STAGE(PG8_SA(0, 1), a2 + hstepA, voffA);
            PG8_WAIT_L(8); PG8_BAR; PG8_WAIT_L(0); PG8_MMA(0, 0, At, B0); PG8_BAR; PG8_SCHED;
            PG8_LDB(B1, 1, 1); PG8_STAGE(PG8_SB(1, 0), b3, voffB);
            PG8_BAR; PG8_WAIT_L(0); PG8_MMA(0, 1, At, B1); PG8_BAR;
            PG8_LDA(At, 1, 1); PG8_STAGE(PG8_SA(1, 0), a3, voffA);
            PG8_BAR; PG8_WAIT_L(0); PG8_MMA(1, 0, At, B0); PG8_BAR; PG8_SCHED;
            PG8_STAGE(PG8_SB(1, 1), b3 + hstepB, voffB);
            PG8_WAIT_V(6); PG8_BAR; PG8_MMA(1, 1, At, B1); PG8_BAR;
        }
        { int ln = lane; asm volatile("" : "+v"(ln)); E(acc, cur, wr, wc, ln & 15, ln >> 4); }
        if (!has_next) break;
#pragma unroll
        for (int a = 0; a < 2; ++a)
#pragma unroll
            for (int b = 0; b < 2; ++b)
#pragma unroll
                for (int m = 0; m < 4; ++m)
#pragma unroll
                    for (int n = 0; n < 2; ++n) acc[a][b][m][n] = (f32x4){0.f, 0.f, 0.f, 0.f};
        cur = nxt; cA = nA; cB = nB; ++ui;
    }
    PG8_WAIT_V(0);
    if (wr == 0) PG8_BAR;
    PG8_BAR;
#undef PG8_SA
#undef PG8_SB
#undef PG8_STAGE
#undef q64_voffA
#undef q64_voffB
#undef PG8_LDA
#undef PG8_LDB
#undef PG8_MMA
#undef PG8_WAIT_V
#undef PG8_WAIT_L
#undef PG8_BAR
#undef PG8_SCHED
}

struct SchedSimple {
    const char* A; const char* Bt; int nM, nN, G, c, poolmode, wgm; size_t tstepA, tstepB;
    __device__ __forceinline__ bool next(int i, Unit& u) const {
        const int L = i * G + c; if (L >= nM * nN) return false;
        int pm, pn; remap_tile(L, nM, nN, pm, pn, wgm);
        u.a = A + (size_t)pm * tstepA + (poolmode ? (size_t)(pn >> 1) * 1024 : 0); u.b = Bt + (size_t)pn * tstepB; u.pm = pm; u.pn = pn; u.job = 0; return true;
    }
};
struct SchedProj {
    const char* ws; int G, c;
    __device__ __forceinline__ bool next(int i, Unit& u) const {
        const int L = i * G + c; if (L >= 1728) return false;
        int job, l, nN; size_t bo, ao;
        if (L < 1536) { job = L >> 9; l = L & 511; nN = 8; bo = job == 0 ? O_WRT : (job == 1 ? O_WKT : O_WVT); ao = job == 0 ? 0 : (job == 1 ? 2 : 3); }
        else { const int q = L - 1536; job = 3 + (q >> 6); l = q & 63; nN = 1; bo = job == 3 ? O_W1C : (job == 4 ? O_A1C : O_G1C); ao = job == 3 ? 1 : (job == 4 ? 4 : 5); }
        int pm, pn; remap_tile(l, 64, nN, pm, pn, nN == 8 ? 4 : 8);
        u.a = ws + O_X6 + ao * (64 * MiB) + (size_t)pm * (256 * 2048 * 2); u.b = ws + bo + (size_t)pn * (256 * 2048 * 2); u.pm = pm; u.pn = pn; u.job = job; return true;
    }
};
struct SchedLora2 {
    const char* ws; int G, c;
    __device__ __forceinline__ bool next(int i, Unit& u) const {
        const int L = i * G + c; if (L >= 2560) return false;
        const int job = L >> 9, l = L & 511;
        const size_t ao = job < 2 ? O_LW : (job < 4 ? O_LA : O_LG);
        const size_t bo = job == 0 ? O_W2T0 : (job == 1 ? O_W2T1 : (job == 2 ? O_A2T0 : (job == 3 ? O_A2T1 : O_G2T)));
        int pm, pn; remap_tile(l, 64, 8, pm, pn, 4);
        u.a = ws + ao + (size_t)pm * (256 * 256 * 2); u.b = ws + bo + (size_t)pn * (256 * 256 * 2); u.pm = pm; u.pn = pn; u.job = job; return true;
    }
};

struct EpiSwiGLU {
    static constexpr bool PERM = true;
    bf16_t* U;
    __device__ __forceinline__ void operator()(const f32x4 (&acc)[2][2][4][2], const Unit& u, int wr, int wc, int fr, int fq) const {
        const int row0 = u.pm * BM + wr * 64 + fr, col0 = u.pn * 128 + wc * 32 + 8 * fq;
#pragma unroll
        for (int ai = 0; ai < 2; ++ai)
#pragma unroll
            for (int m = 0; m < 4; ++m) {
                bf16_t* rowp = U + (size_t)(row0 + ai * HALF + m * 16) * F_ + col0;
                float o[8];
#pragma unroll
                for (int n = 0; n < 2; ++n)
#pragma unroll
                    for (int j = 0; j < 4; ++j) { const float g = acc[ai][0][m][n][j], up = acc[ai][1][m][n][j]; o[4 * n + j] = g * sigmoidf_(g) * up; }
                u32x4 w; w.x = cvt_pk_bf16(o[0], o[1]); w.y = cvt_pk_bf16(o[2], o[3]); w.z = cvt_pk_bf16(o[4], o[5]); w.w = cvt_pk_bf16(o[6], o[7]);
                *(u32x4*)rowp = w;
            }
    }
};
struct EpiResid {
    static constexpr bool PERM = false;
    const float* src; float* dst; const float* colscale; float scale;
    __device__ __forceinline__ void operator()(const f32x4 (&acc)[2][2][4][2], const Unit& u, int wr, int wc, int fr, int fq) const {
        const int row0 = u.pm * BM + wr * 64 + fr, col0 = u.pn * BM + wc * 32 + 4 * fq;
        f32x4 sv[2][2];
#pragma unroll
        for (int bj = 0; bj < 2; ++bj)
#pragma unroll
            for (int n = 0; n < 2; ++n) sv[bj][n] = colscale ? *(const f32x4*)(colscale + col0 + bj * HALF + n * 16) * scale : (f32x4){scale, scale, scale, scale};
#pragma unroll
        for (int ai = 0; ai < 2; ++ai) {
            f32x4 base[4][2][2];
#pragma unroll
            for (int m = 0; m < 4; ++m)
#pragma unroll
                for (int bj = 0; bj < 2; ++bj)
#pragma unroll
                    for (int n = 0; n < 2; ++n) base[m][bj][n] = *(const f32x4*)(src + (size_t)(row0 + ai * HALF + m * 16) * D_ + col0 + bj * HALF + n * 16);
            __builtin_amdgcn_sched_barrier(0);
#pragma unroll
            for (int m = 0; m < 4; ++m)
#pragma unroll
                for (int bj = 0; bj < 2; ++bj)
#pragma unroll
                    for (int n = 0; n < 2; ++n) *(f32x4*)(dst + (size_t)(row0 + ai * HALF + m * 16) * D_ + col0 + bj * HALF + n * 16) = base[m][bj][n] + acc[ai][bj][m][n] * sv[bj][n];
            __builtin_amdgcn_sched_barrier(0);
        }
    }
};
struct EpiProj {
    static constexpr bool PERM = true;
    unsigned char* ws;
    __device__ __forceinline__ void operator()(const f32x4 (&acc)[2][2][4][2], const Unit& u, int wr, int wc, int fr, int fq) const {
        const int job = u.job;
        const int row0 = u.pm * BM + wr * 64 + fr, col0 = u.pn * BM + wc * 32 + 8 * fq;
        const size_t obase = job == 0 ? O_R : (job == 1 ? O_K : (job == 2 ? O_V : (job == 3 ? O_LW : (job == 4 ? O_LA : O_LG))));
        const int ldc = job < 3 ? D_ : 256;
        unsigned short* outp = (unsigned short*)(ws + obase) + (size_t)row0 * ldc + col0;
        const float c0 = job == 3 ? 1.f : 0.f, c1 = job == 3 ? -2.f : 1.f, c2 = job == 3 ? 2.f : -1.f;
        const bool act = (job == 3) || (job == 5), f16 = job < 3;
#pragma unroll
        for (int ai = 0; ai < 2; ++ai)
#pragma unroll
            for (int m = 0; m < 4; ++m) {
                unsigned short* rowp = outp + (size_t)(ai * HALF + m * 16) * ldc;
#pragma unroll
                for (int bj = 0; bj < 2; ++bj) {
                    f32x4 v0 = acc[ai][bj][m][0], v1 = acc[ai][bj][m][1];
                    if (act) {
#pragma unroll
                        for (int j = 0; j < 4; ++j) { v0[j] = c0 + c1 * __builtin_amdgcn_rcpf(1.f + __expf(c2 * v0[j])); v1[j] = c0 + c1 * __builtin_amdgcn_rcpf(1.f + __expf(c2 * v1[j])); }
                    }
                    u32x4 w;
                    if (f16) { w.x = pk_h2(v0[0], v0[1]); w.y = pk_h2(v0[2], v0[3]); w.z = pk_h2(v1[0], v1[1]); w.w = pk_h2(v1[2], v1[3]); }
                    else { w.x = cvt_pk_bf16(v0[0], v0[1]); w.y = cvt_pk_bf16(v0[2], v0[3]); w.z = cvt_pk_bf16(v1[0], v1[1]); w.w = cvt_pk_bf16(v1[2], v1[3]); }
                    *(u32x4*)(rowp + bj * HALF) = w;
                }
            }
    }
};
struct EpiLora2 {
    static constexpr bool PERM = true;
    unsigned char* ws; const float* w0; const float* a0;
    __device__ __forceinline__ void operator()(const f32x4 (&acc)[2][2][4][2], const Unit& u, int wr, int wc, int fr, int fq) const {
        const int job = u.job;
        const int row0 = u.pm * BM + wr * 64 + fr, col0 = u.pn * BM + wc * 32 + 8 * fq;
        const size_t obase = job == 0 ? O_E0 : (job == 1 ? O_E1 : (job == 2 ? O_A0 : (job == 3 ? O_A1 : O_G)));
        unsigned short* outp = (unsigned short*)(ws + obase) + (size_t)row0 * D_ + col0;
        const float* bias = (job < 2 ? (w0 + (size_t)job * D_) : (a0 + (size_t)(job & 1) * D_)) + col0;
        const float osc = job < 2 ? 0.60653065971f : 1.f;
        const bool act = job < 4;
#pragma unroll
        for (int bj = 0; bj < 2; ++bj) {
            f32x4 b0 = (f32x4){0.f, 0.f, 0.f, 0.f}, b1 = b0;
            if (act) { b0 = *(const f32x4*)(bias + bj * HALF); b1 = *(const f32x4*)(bias + bj * HALF + 4); }
#pragma unroll
            for (int ai = 0; ai < 2; ++ai)
#pragma unroll
                for (int m = 0; m < 4; ++m) {
                    unsigned short* rowp = outp + (size_t)(ai * HALF + m * 16) * D_;
                    f32x4 v0 = acc[ai][bj][m][0] + b0, v1 = acc[ai][bj][m][1] + b1;
                    if (act) {
#pragma unroll
                        for (int j = 0; j < 4; ++j) { v0[j] = osc * sigmoidf_(v0[j]); v1[j] = osc * sigmoidf_(v1[j]); }
                    }
                    u32x4 w; w.x = pk_h2(v0[0], v0[1]); w.y = pk_h2(v0[2], v0[3]); w.z = pk_h2(v1[0], v1[1]); w.w = pk_h2(v1[2], v1[3]);
                    *(u32x4*)(rowp + bj * HALF) = w;
                    __builtin_amdgcn_sched_barrier(0);
                }
        }
    }
};

constexpr int SC_T = 32;
constexpr int SC_AV = 0, SC_WR = SC_T * 32 * 4, SC_W = 2 * SC_T * 32 * 4, SC_BK = SC_W + SC_T * 64 * 4, SC_V = SC_BK + SC_T * 64 * 4, SC_SC = SC_V + SC_T * 64 * 4, SC_Y = SC_SC + SC_T * 2 * 4, SC_A = SC_Y + SC_T * 64 * 4, SC_BUF = SC_A + SC_T * 64 * 4;
constexpr int SC_ZERO = 2 * SC_BUF;
typedef _Float16 half2_t __attribute__((ext_vector_type(2)));
__device__ __forceinline__ float dot2h(unsigned a, unsigned b, float c) { return __builtin_amdgcn_fdot2(__builtin_bit_cast(half2_t, a), __builtin_bit_cast(half2_t, b), c, false); }
__device__ __forceinline__ void red8x4(float& a, float& b, float& c, float& d) {
    asm volatile("s_nop 1\n\t"
                 "v_add_f32_dpp %0, %0, %0 quad_perm:[1,0,3,2] row_mask:0xf bank_mask:0xf\n\t"
                 "v_add_f32_dpp %1, %1, %1 quad_perm:[1,0,3,2] row_mask:0xf bank_mask:0xf\n\t"
                 "v_add_f32_dpp %2, %2, %2 quad_perm:[1,0,3,2] row_mask:0xf bank_mask:0xf\n\t"
                 "v_add_f32_dpp %3, %3, %3 quad_perm:[1,0,3,2] row_mask:0xf bank_mask:0xf\n\t"
                 "v_add_f32_dpp %0, %0, %0 quad_perm:[2,3,0,1] row_mask:0xf bank_mask:0xf\n\t"
                 "v_add_f32_dpp %1, %1, %1 quad_perm:[2,3,0,1] row_mask:0xf bank_mask:0xf\n\t"
                 "v_add_f32_dpp %2, %2, %2 quad_perm:[2,3,0,1] row_mask:0xf bank_mask:0xf\n\t"
                 "v_add_f32_dpp %3, %3, %3 quad_perm:[2,3,0,1] row_mask:0xf bank_mask:0xf\n\t"
                 "v_add_f32_dpp %0, %0, %0 row_half_mirror row_mask:0xf bank_mask:0xf\n\t"
                 "v_add_f32_dpp %1, %1, %1 row_half_mirror row_mask:0xf bank_mask:0xf\n\t"
                 "v_add_f32_dpp %2, %2, %2 row_half_mirror row_mask:0xf bank_mask:0xf\n\t"
                 "v_add_f32_dpp %3, %3, %3 row_half_mirror row_mask:0xf bank_mask:0xf"
                 : "+v"(a), "+v"(b), "+v"(c), "+v"(d));
}
__device__ __forceinline__ void scan_phase(const Params& p, unsigned char* ws, LAS unsigned char* lds, int tid, int lane, int wave, int bid, int nb) {
    const float* k_k = pin(p, 25); const float* k_a = pin(p, 26); const float* r_k = pin(p, 27);
    for (int chain = bid; chain < 256; chain += nb) {
        const int d = chain & 1, hh = (chain >> 1) & 31, b = chain >> 6;
        const unsigned short* Rg = (const unsigned short*)(ws + O_R);
        const unsigned short* Kg = (const unsigned short*)(ws + O_K);
        const unsigned short* Vg = (const unsigned short*)(ws + O_V);
        unsigned short* Eg = (unsigned short*)(ws + (d ? O_E1 : O_E0));
        const unsigned short* Ag = (const unsigned short*)(ws + (d ? O_A1 : O_A0));
        float* BSg = (float*)(ws + O_BS) + (size_t)d * M_ * NH_;
        __syncthreads();
        if (wave >= 4) {
            const int lid = tid - 256, s = lid >> 3, j0 = 8 * (lid & 7), ch = hh * 64 + j0;
            float kkc[8], kac[8], rkc[8];
#pragma unroll
            for (int i = 0; i < 8; ++i) { kkc[i] = k_k[ch + i]; kac[i] = k_a[ch + i]; rkc[i] = r_k[ch + i]; }
            if (lid < 32) ((LAS unsigned*)(lds + SC_ZERO))[lid] = 0u;
            h8 r8, k8, v8, e8, a8;
            { const int t = d ? (S_ - 1 - s) : s; const size_t off = ((size_t)b * S_ + t) * D_ + ch;
              r8 = *(const h8*)(Rg + off); k8 = *(const h8*)(Kg + off); v8 = *(const h8*)(Vg + off); e8 = *(const h8*)(Eg + off); a8 = *(const h8*)(Ag + off); }
            for (int ci = -1; ci < S_ / SC_T; ++ci) {
                if (ci >= 1) {
                    const int cj = ci - 1; const int st = cj * SC_T + s; const int t = d ? (S_ - 1 - st) : st;
                    const LAS unsigned char* fb = lds + (cj & 1) * SC_BUF;
                    const LAS float* yb = (const LAS float*)(fb + SC_Y) + s * 64 + j0; const LAS float* ab = (const LAS float*)(fb + SC_A) + s * 64 + j0; const LAS float* vv = (const LAS float*)(fb + SC_V) + s * 64 + j0;
                    const f32x2 bk2 = *(const LAS f32x2*)((const LAS float*)(fb + SC_SC) + s * 2);
                    const f32x4 y0 = *(const LAS f32x4*)yb + *(const LAS f32x4*)ab * bk2.x + *(const LAS f32x4*)vv * bk2.y, y1 = *(const LAS f32x4*)(yb + 4) + *(const LAS f32x4*)(ab + 4) * bk2.x + *(const LAS f32x4*)(vv + 4) * bk2.y;
                    u32x4 w; w.x = cvt_pk_bf16(y0.x, y0.y); w.y = cvt_pk_bf16(y0.z, y0.w); w.z = cvt_pk_bf16(y1.x, y1.y); w.w = cvt_pk_bf16(y1.z, y1.w);
                    *(u32x4*)(Eg + ((size_t)b * S_ + t) * D_ + ch) = w;
                }
                if (ci + 1 < S_ / SC_T) {
                    const int cj = ci + 1; const int st = cj * SC_T + s; const int t = d ? (S_ - 1 - st) : st;
                    const size_t m = (size_t)b * S_ + t;
                    h8 r8n = r8, k8n = k8, v8n = v8, e8n = e8, a8n = a8;
                    if (cj + 1 < S_ / SC_T) {
                        const int st2 = (cj + 1) * SC_T + s; const int t2 = d ? (S_ - 1 - st2) : st2; const size_t off2 = ((size_t)b * S_ + t2) * D_ + ch;
                        r8n = *(const h8*)(Rg + off2); k8n = *(const h8*)(Kg + off2); v8n = *(const h8*)(Vg + off2); e8n = *(const h8*)(Eg + off2); a8n = *(const h8*)(Ag + off2);
                    }
                    float kk[8], ss = 0.f;
#pragma unroll
                    for (int i = 0; i < 8; ++i) { kk[i] = (float)k8[i] * kkc[i]; ss += kk[i] * kk[i]; }
                    ss = red8(ss);
                    const float inv = fminf(__builtin_amdgcn_rsqf(ss), 1e12f);
                    float ps[8];
                    const int wl = lid & 63;
#pragma unroll
                    for (int i = 0; i < 8; ++i) ps[i] = (float)e8[i];
#pragma unroll
                    for (int dd = 8; dd < 64; dd <<= 1) {
#pragma unroll
                        for (int i = 0; i < 8; ++i) { const float tup = __shfl_up(ps[i], dd); ps[i] += (wl >= dd) ? tup : 0.f; }
                    }
                    float av[8], wv[8], bb[8], kd[8], wrr[8], br = 0.f, kr = 0.f, bsum = 0.f;
#pragma unroll
                    for (int i = 0; i < 8; ++i) {
                        const float rr = (float)r8[i], kf = (float)k8[i], af = (float)a8[i], ei = (float)e8[i];
                        const float Pt = __expf(-ps[i]), Pm = __expf(ei - ps[i]), iP = __expf(ps[i]);
                        kk[i] *= inv; const float bt = kk[i] * af, kt = kf * (1.f + (af - 1.f) * kac[i]);
                        br += bt * rr; kr += kt * rr; bsum += rr * kt * rkc[i];
                        av[i] = -kk[i] * Pm; wrr[i] = Pt * rr; bb[i] = bt * iP; kd[i] = kt * iP; wv[i] = Pt;
                    }
                    br = red8(br); kr = red8(kr); bsum = red8(bsum);
                    LAS unsigned char* buf = lds + (cj & 1) * SC_BUF;
                    *(LAS u32x4*)((LAS unsigned*)(buf + SC_AV) + s * 32 + (j0 >> 1)) = (u32x4){pk_h2(av[0], av[1]), pk_h2(av[2], av[3]), pk_h2(av[4], av[5]), pk_h2(av[6], av[7])};
                    *(LAS u32x4*)((LAS unsigned*)(buf + SC_WR) + s * 32 + (j0 >> 1)) = (u32x4){pk_h2(wrr[0], wrr[1]), pk_h2(wrr[2], wrr[3]), pk_h2(wrr[4], wrr[5]), pk_h2(wrr[6], wrr[7])};
                    if ((s & 7) == 7) { LAS float* wp = (LAS float*)(buf + SC_W) + (s >> 3) * 64 + j0;
                      *(LAS f32x4*)wp = (f32x4){wv[0], wv[1], wv[2], wv[3]}; *(LAS f32x4*)(wp + 4) = (f32x4){wv[4], wv[5], wv[6], wv[7]}; }
                    LAS unsigned* bkp = (LAS unsigned*)(buf + SC_BK) + s * 64 + j0;
                    *(LAS u32x4*)bkp = (u32x4){pk_h2(bb[0], kd[0]), pk_h2(bb[1], kd[1]), pk_h2(bb[2], kd[2]), pk_h2(bb[3], kd[3])};
                    *(LAS u32x4*)(bkp + 4) = (u32x4){pk_h2(bb[4], kd[4]), pk_h2(bb[5], kd[5]), pk_h2(bb[6], kd[6]), pk_h2(bb[7], kd[7])};
                    LAS float* vb = (LAS float*)(buf + SC_V) + s * 64 + j0;
                    *(LAS f32x4*)vb = (f32x4){(float)v8[0], (float)v8[1], (float)v8[2], (float)v8[3]}; *(LAS f32x4*)(vb + 4) = (f32x4){(float)v8[4], (float)v8[5], (float)v8[6], (float)v8[7]};
                    if ((lid & 7) == 0) { *(LAS f32x2*)((LAS float*)(buf + SC_SC) + s * 2) = (f32x2){br, kr}; BSg[m * NH_ + hh] = bsum; }
                    r8 = r8n; k8 = k8n; v8 = v8n; e8 = e8n; a8 = a8n;
                }
                __syncthreads();
            }
            {
                const int cj = S_ / SC_T - 1; const int st = cj * SC_T + s; const int t = d ? (S_ - 1 - st) : st;
                const LAS unsigned char* fb = lds + (cj & 1) * SC_BUF;
                const LAS float* yb = (const LAS float*)(fb + SC_Y) + s * 64 + j0; const LAS float* ab = (const LAS float*)(fb + SC_A) + s * 64 + j0; const LAS float* vv = (const LAS float*)(fb + SC_V) + s * 64 + j0;
                const f32x2 bk2 = *(const LAS f32x2*)((const LAS float*)(fb + SC_SC) + s * 2);
                const f32x4 y0 = *(const LAS f32x4*)yb + *(const LAS f32x4*)ab * bk2.x + *(const LAS f32x4*)vv * bk2.y, y1 = *(const LAS f32x4*)(yb + 4) + *(const LAS f32x4*)(ab + 4) * bk2.x + *(const LAS f32x4*)(vv + 4) * bk2.y;
                u32x4 w; w.x = cvt_pk_bf16(y0.x, y0.y); w.y = cvt_pk_bf16(y0.z, y0.w); w.z = cvt_pk_bf16(y1.x, y1.y); w.w = cvt_pk_bf16(y1.z, y1.w);
                *(u32x4*)(Eg + ((size_t)b * S_ + t) * D_ + ch) = w;
            }
        } else {
            const int rl = lane & 15, g = lane >> 4, row = 16 * wave + rl, m4 = rl & 3;
            f32x2 S[8];
#pragma unroll
            for (int q = 0; q < 8; ++q) S[q] = (f32x2){0.f, 0.f};
            __syncthreads();
            for (int ci = 0; ci < S_ / SC_T; ++ci) {
                const LAS unsigned char* buf = lds + (ci & 1) * SC_BUF;
                const LAS unsigned char* xb = (m4 == 0 ? buf + SC_AV : (m4 == 1 ? buf + SC_WR : lds + SC_ZERO)) + 16 * g;
                const int xs = m4 < 2 ? 128 : 0;
                const LAS float* wb = (const LAS float*)(buf + SC_W) + 8 * g;
                const LAS unsigned* bkb = (const LAS unsigned*)(buf + SC_BK) + 8 * g;
                const LAS float* vb = (const LAS float*)(buf + SC_V) + row;
                LAS float* yb = (LAS float*)(lds + (ci & 1) * SC_BUF + SC_Y) + row;
#define SC_LOAD(P, s) do { \
                    P##x1 = *(const LAS h8*)(xb + (s) * xs); P##x2 = *(const LAS h8*)(xb + (s) * xs + 64); \
                                        P##k0 = *(const LAS u32x4*)(bkb + (s) * 64); P##k1 = *(const LAS u32x4*)(bkb + (s) * 64 + 4); P##k2 = *(const LAS u32x4*)(bkb + (s) * 64 + 32); P##k3 = *(const LAS u32x4*)(bkb + (s) * 64 + 36); \
                    P##v = *(vb + (s) * 64); } while (0)
#define SC_STEP(P, s) do { \
                    const u32x4 b1u = (u32x4){pk_h2(S[0].x, S[0].y), pk_h2(S[1].x, S[1].y), pk_h2(S[2].x, S[2].y), pk_h2(S[3].x, S[3].y)}; \
                    const u32x4 b2u = (u32x4){pk_h2(S[4].x, S[4].y), pk_h2(S[5].x, S[5].y), pk_h2(S[6].x, S[6].y), pk_h2(S[7].x, S[7].y)}; \
                    f32x4 acc = __builtin_amdgcn_mfma_f32_16x16x32_f16(P##x1, __builtin_bit_cast(h8, b1u), (f32x4){0.f, 0.f, 0.f, 0.f}, 0, 0, 0); \
                    acc = __builtin_amdgcn_mfma_f32_16x16x32_f16(P##x2, __builtin_bit_cast(h8, b2u), acc, 0, 0, 0); \
                    f32x2 t; \
                    const unsigned hh0 = pk_h2(acc[0], P##v); \
                    S[0].x = dot2h(hh0, P##k0.x, S[0].x); S[0].y = dot2h(hh0, P##k0.y, S[0].y); S[1].x = dot2h(hh0, P##k0.z, S[1].x); S[1].y = dot2h(hh0, P##k0.w, S[1].y); \
                    S[2].x = dot2h(hh0, P##k1.x, S[2].x); S[2].y = dot2h(hh0, P##k1.y, S[2].y); S[3].x = dot2h(hh0, P##k1.z, S[3].x); S[3].y = dot2h(hh0, P##k1.w, S[3].y); \
                    S[4].x = dot2h(hh0, P##k2.x, S[4].x); S[4].y = dot2h(hh0, P##k2.y, S[4].y); S[5].x = dot2h(hh0, P##k2.z, S[5].x); S[5].y = dot2h(hh0, P##k2.w, S[5].y); \
                    S[6].x = dot2h(hh0, P##k3.x, S[6].x); S[6].y = dot2h(hh0, P##k3.y, S[6].y); S[7].x = dot2h(hh0, P##k3.z, S[7].x); S[7].y = dot2h(hh0, P##k3.w, S[7].y); \
                    (void)t; if (g == 0) { *(yb + (s) * 64) = acc[1]; *(yb + (s) * 64 + SC_T * 64) = acc[0]; } } while (0)
                h8 Ax1, Ax2, Bx1, Bx2; u32x4 Ak0, Ak1, Ak2, Ak3, Bk0, Bk1, Bk2, Bk3; float Av, Bv;
                SC_LOAD(A, 0);
                for (int s = 0; s < SC_T; s += 8) {
                    const LAS float* pg = wb + (s >> 3) * 64;
                    const f32x4 p0 = *(const LAS f32x4*)pg, p1 = *(const LAS f32x4*)(pg + 4), p2 = *(const LAS f32x4*)(pg + 32), p3 = *(const LAS f32x4*)(pg + 36);
#define SC_PAIR(o) SC_LOAD(B, s + (o) + 1); SC_STEP(A, s + (o)); __builtin_amdgcn_sched_barrier(0); \
                    SC_LOAD(A, s + (o) + 2); SC_STEP(B, s + (o) + 1); __builtin_amdgcn_sched_barrier(0)
                    SC_PAIR(0); SC_PAIR(2); SC_PAIR(4); SC_PAIR(6);
#undef SC_PAIR
                    S[0] *= p0.xy; S[1] *= p0.zw; S[2] *= p1.xy; S[3] *= p1.zw; S[4] *= p2.xy; S[5] *= p2.zw; S[6] *= p3.xy; S[7] *= p3.zw;
                }
#undef SC_LOAD
#undef SC_STEP
                __syncthreads();
            }
        }
    }
}

__device__ __forceinline__ void post_phase(const Params& p, unsigned char* ws, int lane, int gw, int NGW) {
    const float* lnw = pin(p, 28); const float* lnb = pin(p, 29);
    const unsigned short* Y0 = (const unsigned short*)(ws + O_E0); const unsigned short* Y1 = (const unsigned short*)(ws + O_E1);
    const unsigned short* Vg = (const unsigned short*)(ws + O_V); const unsigned short* Gg = (const unsigned short*)(ws + O_G);
    const float* BS = (const float*)(ws + O_BS);
    unsigned short* P = (unsigned short*)(ws + O_POST);
    for (int m = gw; m < M_; m += NGW) {
#pragma unroll
        for (int j = 0; j < 4; ++j) {
            const int ch0 = 8 * (lane + 64 * j), head = ch0 >> 6;
            const size_t off = (size_t)m * D_ + ch0;
            const u32x4 a = *(const u32x4*)(Y0 + off), bq = *(const u32x4*)(Y1 + off);
            float ys[8];
            ys[0] = bf_lo(a.x) + bf_lo(bq.x); ys[1] = bf_hi(a.x) + bf_hi(bq.x); ys[2] = bf_lo(a.y) + bf_lo(bq.y); ys[3] = bf_hi(a.y) + bf_hi(bq.y);
            ys[4] = bf_lo(a.z) + bf_lo(bq.z); ys[5] = bf_hi(a.z) + bf_hi(bq.z); ys[6] = bf_lo(a.w) + bf_lo(bq.w); ys[7] = bf_hi(a.w) + bf_hi(bq.w);
            float s = 0.f;
#pragma unroll
            for (int i = 0; i < 8; ++i) s += ys[i];
            const float mean = red8(s) * (1.f / 64.f);
            float s2 = 0.f;
#pragma unroll
            for (int i = 0; i < 8; ++i) { ys[i] -= mean; s2 += ys[i] * ys[i]; }
            const float rs = rsqrtf(red8(s2) * (1.f / 64.f) + 64e-5f);
            const h8 v8 = *(const h8*)(Vg + off), g8 = *(const h8*)(Gg + off);
            const f32x4 w0 = *(const f32x4*)(lnw + ch0), w1 = *(const f32x4*)(lnw + ch0 + 4), b0 = *(const f32x4*)(lnb + ch0), b1 = *(const f32x4*)(lnb + ch0 + 4);
            const float bsum = BS[(size_t)m * NH_ + head] + BS[(size_t)M_ * NH_ + (size_t)m * NH_ + head];
            float o[8];
#pragma unroll
            for (int i = 0; i < 8; ++i) {
                const float lw = i < 4 ? w0[i] : w1[i - 4], lb = i < 4 ? b0[i] : b1[i - 4];
                o[i] = (ys[i] * rs * lw + lb + bsum * (float)v8[i]) * (float)g8[i];
            }
            u32x4 w; w.x = cvt_pk_bf16(o[0], o[1]); w.y = cvt_pk_bf16(o[2], o[3]); w.z = cvt_pk_bf16(o[4], o[5]); w.w = cvt_pk_bf16(o[6], o[7]);
            *(u32x4*)(P + off) = w;
        }
    }
}

__device__ __forceinline__ void ffn_g1(unsigned char* ws, LAS unsigned char* lds, int tid, int bid, int nb, size_t o_gu) {
    SchedSimple S; S.A = (const char*)(ws + O_XN); S.Bt = (const char*)(ws + o_gu); S.nM = 64; S.nN = 44; S.G = nb; S.c = bid; S.poolmode = 0; S.wgm = 8;
    S.tstepA = (size_t)256 * D_ * 2; S.tstepB = (size_t)256 * D_ * 2;
    EpiSwiGLU E; E.U = (bf16_t*)(ws + O_U);
    gemm_phase(lds, tid, D_, D_, D_, S, E);
}
__device__ __forceinline__ void gemm_resid(unsigned char* ws, float* hout, LAS unsigned char* lds, int tid, int bid, int nb, size_t o_a, int lda, size_t o_bt, int K, int poolmode, const float* src, const float* colscale, float scale) {
    SchedSimple S; S.A = (const char*)(ws + o_a); S.Bt = (const char*)(ws + o_bt); S.nM = 64; S.nN = 8; S.G = nb; S.c = bid; S.poolmode = poolmode; S.wgm = 4;
    S.tstepA = (size_t)256 * lda * 2; S.tstepB = (size_t)256 * K * 2;
    EpiResid E; E.src = src; E.dst = hout; E.colscale = colscale; E.scale = scale;
    gemm_phase(lds, tid, K, lda, K, S, E);
}

__global__ void __launch_bounds__(512) mega(Params p) {
    extern __shared__ __attribute__((aligned(16))) unsigned char smem[];
    LAS unsigned char* lds = (LAS unsigned char*)smem;
    cg::grid_group grid = cg::this_grid();
    XcdBarrier xb;
    {
        volatile LAS unsigned* st = (volatile LAS unsigned*)(lds + 131072);
        if (threadIdx.x == 0) { st[0] = 0u; st[1] = 0u; }
        __syncthreads();
        xb.bar = (unsigned*)(p.ws + O_BAR); xb.x = xb_xcc_id(); xb.st = st;
        if (threadIdx.x == 0) (void)xb_add(&xb.bar[XB_XCNT(xb.x)], 1u);
    }
    constexpr int nb = 256;
    const int wid_s = __builtin_amdgcn_readfirstlane((int)(threadIdx.x >> 6));
#define PROLOG int m1_ = -1; asm volatile("" : "+s"(m1_)); int tid = wid_s * 64 + (int)__builtin_amdgcn_mbcnt_hi(m1_, __builtin_amdgcn_mbcnt_lo(m1_, 0)); int bid = blockIdx.x; asm volatile("" : "+s"(bid)); \
        const int lane = tid & 63, wave = tid >> 6; const int gw = bid * 8 + wave, NGW = nb * 8; LAS float* scr = (LAS float*)(lds + wave * 8704); \
        unsigned char* ws = p.ws; asm volatile("" : "+s"(ws)); float* h = p.out; asm volatile("" : "+s"(h)); (void)lane; (void)gw; (void)NGW; (void)scr; (void)h; (void)ws;
    for (int ph = p.ph_lo; ph < p.ph_hi; ++ph) {
#if REP_MASK
      const int nrep = ((REP_MASK >> ph) & 1) + 1;
      for (int rep = 0; rep < nrep; ++rep) {
        const float rsc = (rep == nrep - 1) ? 1.f : 0.f;
        if (rep) grid.sync();
#else
      { constexpr float rsc = 1.f;
#endif
        switch (ph) {
        case 0: { PROLOG
            norm_phase<false>(pin(p, 0), pin(p, 1), (bf16_t*)(ws + O_XN), nullptr, lane, gw, NGW);
            conv_ffn(pin(p, 2), pin(p, 3), pin(p, 4), (bf16_t*)(ws + O_AGU), (bf16_t*)(ws + O_AD), scr, lane, gw, NGW);
            conv_ffn(pin(p, 7), pin(p, 8), pin(p, 9), (bf16_t*)(ws + O_BGU), (bf16_t*)(ws + O_BD), scr, lane, gw, NGW);
            conv_rwkv(p, ws, scr, lane, gw, NGW);
        } break;
        case 1: { PROLOG
            ffn_g1(ws, lds, tid, bid, nb, O_AGU);
        } break;
        case 2: { PROLOG
            gemm_resid(ws, h, lds, tid, bid, nb, O_U, F_, O_AD, F_, 0, pin(p, 0), nullptr, 0.5f * rsc);
        } break;
        case 3: { PROLOG
            pool_prep_phase(h, pin(p, 5), (bf16_t*)(ws + O_XN), lds, tid, lane, wave, bid, nb);
            __syncthreads();
            conv_ffn(pin(p, 2) + (size_t)D_ * F_, pin(p, 3) + (size_t)D_ * F_, pin(p, 4) + (size_t)D_ * F_, (bf16_t*)(ws + O_AGU), (bf16_t*)(ws + O_AD), scr, lane, gw, NGW);
        } break;
        case 4: { PROLOG
            gemm_resid(ws, h, lds, tid, bid, nb, O_XN, D_, O_POOLT, 512, 1, h, pin(p, 11), 1.f * rsc);
        } break;
        case 5: { PROLOG
            norm_phase<false>(h, pin(p, 6), (bf16_t*)(ws + O_XN), nullptr, lane, gw, NGW);
        } break;
        case 6: { PROLOG
            ffn_g1(ws, lds, tid, bid, nb, O_BGU);
        } break;
        case 7: { PROLOG
            gemm_resid(ws, h, lds, tid, bid, nb, O_U, F_, O_BD, F_, 0, h, nullptr, 0.5f * rsc);
        } break;
        case 8: { PROLOG
            norm_phase<false>(h, pin(p, 1) + D_, (bf16_t*)(ws + O_XN), nullptr, lane, gw, NGW);
        } break;
        case 9: { PROLOG
            ffn_g1(ws, lds, tid, bid, nb, O_AGU);
        } break;
        case 10: { PROLOG
            gemm_resid(ws, h, lds, tid, bid, nb, O_U, F_, O_AD, F_, 0, h, nullptr, 0.5f * rsc);
        } break;
        case 11: { PROLOG
            rwkv_prep_phase(h, pin(p, 5) + D_, pin(p, 12), (bf16_t*)(ws + O_X6), lane, gw, NGW);
        } break;
        case 12: { PROLOG
            {
            SchedProj S; S.ws = (const char*)ws; S.G = nb; S.c = bid;
            EpiProj E; E.ws = ws;
            gemm_phase(lds, tid, D_, D_, D_, S, E);
        }
        } break;
        case 13: { PROLOG
            {
            SchedLora2 S; S.ws = (const char*)ws; S.G = nb; S.c = bid;
            EpiLora2 E; E.ws = ws; E.w0 = pin(p, 17); E.a0 = pin(p, 20);
            gemm_phase(lds, tid, 256, 256, 256, S, E);
        }
        } break;
        case 14: { PROLOG
            scan_phase(p, ws, lds, tid, lane, wave, bid, nb);
        } break;
        case 15: { PROLOG
            post_phase(p, ws, lane, gw, NGW);
        } break;
        case 16: { PROLOG
            gemm_resid(ws, h, lds, tid, bid, nb, O_POST, D_, O_WOT, D_, 0, h, nullptr, 1.f * rsc);
        } break;
        case 17: { PROLOG
            norm_phase<false>(h, pin(p, 6) + D_, (bf16_t*)(ws + O_XN), nullptr, lane, gw, NGW);
            conv_ffn(pin(p, 7) + (size_t)D_ * F_, pin(p, 8) + (size_t)D_ * F_, pin(p, 9) + (size_t)D_ * F_, (bf16_t*)(ws + O_BGU), (bf16_t*)(ws + O_BD), scr, lane, gw, NGW);
        } break;
        case 18: { PROLOG
            ffn_g1(ws, lds, tid, bid, nb, O_BGU);
        } break;
        case 19: { PROLOG
            gemm_resid(ws, h, lds, tid, bid, nb, O_U, F_, O_BD, F_, 0, h, nullptr, 0.5f * rsc);
        } break;
        case 20: { PROLOG
            norm_phase<true>(h, pin(p, 30), nullptr, h, lane, gw, NGW);
        } break;
        default: break;
        }
      }
        if (ph + 1 < p.ph_hi) {
            if (p.ph_lo < 0) grid.sync();
            xcd_barrier(xb, threadIdx.x == 0);
        }
    }
}

extern "C" void kernel_launch(void* const* d_in, const int* in_sizes, int n_in, void* d_out, int out_size, void* d_ws, size_t ws_size, hipStream_t stream) {
    static int grid_blocks = 0;
    if (grid_blocks == 0) {
        if (n_in != 31 || out_size != M_ * D_ || ws_size < WS_NEED) { fprintf(stderr, "kernel_launch: unexpected shapes (n_in %d out %d ws %zu)\n", n_in, out_size, ws_size); grid_blocks = -1; return; }
        int dev = 0, cus = 0, per_cu = 0;
        hipGetDevice(&dev);
        hipDeviceGetAttribute(&cus, hipDeviceAttributeMultiprocessorCount, dev);
        if (hipFuncSetAttribute((const void*)mega, hipFuncAttributeMaxDynamicSharedMemorySize, LDS_BYTES) != hipSuccess) { fprintf(stderr, "kernel_launch: hipFuncSetAttribute failed\n"); grid_blocks = -1; return; }
        hipOccupancyMaxActiveBlocksPerMultiprocessor(&per_cu, (const void*)mega, 512, LDS_BYTES);
        if (per_cu < 1) per_cu = 1;
        if (cus * per_cu < 256) { fprintf(stderr, "kernel_launch: device holds only %d co-resident workgroups, 256 needed\n", cus * per_cu); grid_blocks = -1; (void)hipGetLastError(); return; }
        grid_blocks = 256;
        (void)hipGetLastError();
    }
    if (grid_blocks < 0) return;
    Params p{};
    for (int i = 0; i < 31; ++i) p.in[i] = (const float*)d_in[i];
    p.out = (float*)d_out; p.ws = (unsigned char*)d_ws;
#if MK_SINGLE
    (void)hipMemsetAsync((unsigned char*)d_ws + O_BAR, 0, XCD_BAR_WORDS * 4, stream);
    p.ph_lo = 0; p.ph_hi = NPHASE;
    void* args[] = {&p};
    hipError_t e = hipLaunchCooperativeKernel((const void*)mega, dim3(grid_blocks), dim3(512), args, LDS_BYTES, stream);
    if (e != hipSuccess) fprintf(stderr, "cooperative launch failed: %s (grid %d)\n", hipGetErrorString(e), grid_blocks);
#else
    for (int ph = 0; ph < NPHASE; ++ph) {
        p.ph_lo = ph; p.ph_hi = ph + 1;
        hipLaunchKernelGGL(mega, dim3(grid_blocks), dim3(512), LDS_BYTES, stream, p);
    }
#endif
}
```

```cpp
#include <hip/hip_runtime.h>
#include <hip/hip_cooperative_groups.h>
#include <cstdio>
namespace cg = cooperative_groups;

#ifndef REP_MASK
#define REP_MASK 0
#endif
#ifndef MK_SINGLE
#define MK_SINGLE 1
#endif

#define LAS __attribute__((address_space(3)))
typedef unsigned short bf16_t;
typedef short bf16x8 __attribute__((ext_vector_type(8)));
typedef float f32x4 __attribute__((ext_vector_type(4)));
typedef float f32x2 __attribute__((ext_vector_type(2)));
typedef unsigned u32x4 __attribute__((ext_vector_type(4)));
typedef unsigned u32x2 __attribute__((ext_vector_type(2)));
typedef _Float16 h8 __attribute__((ext_vector_type(8)));

constexpr int M_ = 16384, D_ = 2048, F_ = 5632, S_ = 4096, NH_ = 32;
constexpr int NPHASE = 21;
constexpr int LDS_BYTES = 131072 + 16;
constexpr size_t MiB = 1ull << 20;
constexpr size_t O_WRT = 0 * MiB, O_WKT = 8 * MiB, O_WVT = 16 * MiB, O_WOT = 24 * MiB, O_W1C = 32 * MiB, O_A1C = 33 * MiB, O_G1C = 34 * MiB;
constexpr size_t O_W2T0 = 35 * MiB, O_W2T1 = 36 * MiB, O_A2T0 = 37 * MiB, O_A2T1 = 38 * MiB, O_G2T = 39 * MiB, O_POOLT = 40 * MiB;
constexpr size_t O_BAR = 42 * MiB;
constexpr size_t O_XN = 70 * MiB;
constexpr size_t O_AGU = 134 * MiB, O_AD = 178 * MiB, O_BGU = 200 * MiB, O_BD = 244 * MiB;
constexpr size_t O_U = 266 * MiB;
constexpr size_t O_X6 = 70 * MiB;
constexpr size_t O_R = 454 * MiB, O_K = 518 * MiB, O_V = 582 * MiB, O_LW = 646 * MiB, O_LA = 654 * MiB, O_LG = 662 * MiB, O_BS = 670 * MiB;
constexpr size_t O_E0 = 70 * MiB, O_E1 = 134 * MiB, O_A0 = 198 * MiB, O_A1 = 262 * MiB, O_G = 326 * MiB, O_POST = 390 * MiB;
constexpr size_t WS_NEED = 674 * MiB;

struct Params {
    const float* in[31];
    float* out;
    unsigned char* ws;
    int ph_lo, ph_hi;
};

__device__ __forceinline__ const float* pin(const Params& p, int i) { asm volatile("" : "+s"(i)); return p.in[i]; }
__device__ __forceinline__ unsigned cvt_pk_bf16(float lo, float hi) { unsigned r; asm volatile("v_cvt_pk_bf16_f32 %0, %1, %2" : "=v"(r) : "v"(lo), "v"(hi)); return r; }
__device__ __forceinline__ unsigned pk_h2(float a, float b) { auto h = __builtin_amdgcn_cvt_pkrtz(a, b); return __builtin_bit_cast(unsigned, h); }
__device__ __forceinline__ float bf_lo(unsigned w) { return __builtin_bit_cast(float, w << 16); }
__device__ __forceinline__ float bf_hi(unsigned w) { return __builtin_bit_cast(float, w & 0xffff0000u); }
template <int CTRL> __device__ __forceinline__ float dpp_f(float v) {
    return __builtin_bit_cast(float, __builtin_amdgcn_update_dpp(0, __builtin_bit_cast(int, v), CTRL, 0xF, 0xF, true));
}
__device__ __forceinline__ float red8(float v) { v += dpp_f<0xB1>(v); v += dpp_f<0x4E>(v); v += dpp_f<0x141>(v); return v; }
__device__ __forceinline__ float wave_sum(float v) {
    v += dpp_f<0xB1>(v); v += dpp_f<0x4E>(v); v += dpp_f<0x141>(v); v += dpp_f<0x140>(v);
    const int iv = __builtin_bit_cast(int, v);
    const float r0 = __builtin_bit_cast(float, __builtin_amdgcn_readlane(iv, 0)), r1 = __builtin_bit_cast(float, __builtin_amdgcn_readlane(iv, 16));
    const float r2 = __builtin_bit_cast(float, __builtin_amdgcn_readlane(iv, 32)), r3 = __builtin_bit_cast(float, __builtin_amdgcn_readlane(iv, 48));
    return (r0 + r1) + (r2 + r3);
}
__device__ __forceinline__ float sigmoidf_(float x) { return __builtin_amdgcn_rcpf(1.f + __expf(-x)); }
#define LDS_WAIT() asm volatile("s_waitcnt lgkmcnt(0)" ::: "memory")


#define XB_TMO      128
#define XB_XCNT(j)  (256  + 64 * (j))
#define XB_XSUB(j)  (1280 + 64 * (j))
#define XB_XGEN(j)  (2304 + 64 * (j))
#define XB_TOP      3328
#define XB_TOPGEN   3392
#define XCD_BAR_WORDS 3456
#define XB_SPIN_CAP (1u << 18)
__device__ __forceinline__ unsigned xb_ld(unsigned* p)              { return __hip_atomic_load(p, __ATOMIC_RELAXED, __HIP_MEMORY_SCOPE_AGENT); }
__device__ __forceinline__ unsigned xb_add(unsigned* p, unsigned v) { return __hip_atomic_fetch_add(p, v, __ATOMIC_RELAXED, __HIP_MEMORY_SCOPE_AGENT); }
__device__ __forceinline__ unsigned xb_xcc_id() { return (unsigned)__builtin_amdgcn_s_getreg((3 << 11) | 20) & 0xFu; }
#define XB_SPIN(cond, bar) do { unsigned _sp = 0; while (cond) { __builtin_amdgcn_s_sleep(1); \
    if ((++_sp & 255u) == 0u) { if (xb_ld(&(bar)[XB_TMO])) break; if (_sp > XB_SPIN_CAP) { atomicAdd(&(bar)[XB_TMO], 1u); break; } } } } while (0)
struct XcdBarrier { unsigned* bar; unsigned x; volatile LAS unsigned* st; };
__device__ __forceinline__ void xcd_barrier_complete(unsigned* bar, unsigned x, unsigned& nloc, unsigned& nx) {
    const unsigned G = gridDim.x;
    unsigned sum, cnt, mine, sp = 0u;
    for (;;) {
        sum = 0u; cnt = 0u; mine = 0u;
#pragma unroll
        for (unsigned j = 0; j < 16; ++j) { const unsigned c = xb_ld(&bar[XB_XCNT(j)]); sum += c; cnt += (c > 0u) ? 1u : 0u; mine = (j == x) ? c : mine; }
        if (sum == G) break;
        __builtin_amdgcn_s_sleep(1);
        if ((++sp & 255u) == 0u) { if (xb_ld(&bar[XB_TMO])) break; if (sp > XB_SPIN_CAP) { atomicAdd(&bar[XB_TMO], 1u); break; } }
    }
    nloc = mine > 0u ? mine : 1u; nx = cnt > 0u ? cnt : 1u;
}
__device__ __forceinline__ void xcd_barrier(const XcdBarrier& b, bool leader_thread) {
    asm volatile("s_waitcnt vmcnt(0)" ::: "memory");
    __syncthreads();
    if (leader_thread) {
        unsigned* bar = b.bar;
        __builtin_amdgcn_s_waitcnt(0);
        unsigned nloc = b.st[0], nx = b.st[1];
        if (nloc == 0u) { xcd_barrier_complete(bar, b.x, nloc, nx); b.st[0] = nloc; b.st[1] = nx; }
        const unsigned old = xb_add(&bar[XB_XSUB(b.x)], 1u);
        const unsigned gen = old / nloc;
        if (old + 1u == (gen + 1u) * nloc) {
            __builtin_amdgcn_fence(__ATOMIC_RELEASE, "agent");
            asm volatile("s_waitcnt vmcnt(0)" ::: "memory");
            const unsigned og = xb_add(&bar[XB_TOP], 1u);
            const unsigned tg = og / nx;
            if (og + 1u == (tg + 1u) * nx) xb_add(&bar[XB_TOPGEN], 1u);
            else XB_SPIN(xb_ld(&bar[XB_TOPGEN]) == tg, bar);
            __builtin_amdgcn_fence(__ATOMIC_ACQUIRE, "agent");
            xb_add(&bar[XB_XGEN(b.x)], 1u);
            asm volatile("s_waitcnt vmcnt(0)" ::: "memory");
        } else {
            XB_SPIN(xb_ld(&bar[XB_XGEN(b.x)]) == gen, bar);
            __builtin_amdgcn_fence(__ATOMIC_ACQUIRE, "agent");
            asm volatile("s_waitcnt vmcnt(0)" ::: "memory");
        }
    }
    __syncthreads();
}

__device__ __forceinline__ void tr_load(const float* src, int N, int k0, int n0, float (&v)[32], int lane) {
#pragma unroll
    for (int i = 0; i < 32; ++i) v[i] = src[(size_t)(k0 + 2 * i + (lane >> 5)) * N + n0 + (lane & 31)];
}
__device__ __forceinline__ void tr_store(const float (&v)[32], int k0, int n0, bf16_t* dst, int ldd, int mode, int row0, int col0, const float* scale, LAS float* scr, int lane) {
#pragma unroll
    for (int i = 0; i < 32; ++i) {
        const int kk = 2 * i + (lane >> 5);
        float x = v[i];
        if (scale) x *= scale[k0 + kk];
        scr[kk * 33 + (lane & 31)] = x;
    }
    LDS_WAIT();
    const int c = lane & 7;
#pragma unroll
    for (int j = 0; j < 4; ++j) {
        const int n = (lane >> 3) + 8 * j; const LAS float* s = scr + (8 * c) * 33 + n;
        u32x4 o; o.x = cvt_pk_bf16(s[0 * 33], s[1 * 33]); o.y = cvt_pk_bf16(s[2 * 33], s[3 * 33]); o.z = cvt_pk_bf16(s[4 * 33], s[5 * 33]); o.w = cvt_pk_bf16(s[6 * 33], s[7 * 33]);
        const int ng = n0 + n;
        const int row = mode ? (256 * (ng >> 7) + row0 + (ng & 127)) : (row0 + ng);
        *(u32x4*)(dst + (size_t)row * ldd + col0 + k0 + 8 * c) = o;
    }
    LDS_WAIT();
}
__device__ __forceinline__ void tr_mat(const float* src, int K, int N, bf16_t* dst, int ldd, int mode, int row0, int col0, const float* scale, LAS float* scr, int lane, int gw, int NGW, int rot) {
    const int nblk = N / 32, items = (K / 64) * nblk;
    int it = gw - rot; while (it < 0) it += NGW;
    float va[32], vb[32];
    if (it < items) tr_load(src, N, 64 * (it / nblk), 32 * (it % nblk), va, lane);
    while (it < items) {
        const int nx = it + NGW;
        if (nx < items) tr_load(src, N, 64 * (nx / nblk), 32 * (nx % nblk), vb, lane);
        tr_store(va, 64 * (it / nblk), 32 * (it % nblk), dst, ldd, mode, row0, col0, scale, scr, lane);
#pragma unroll
        for (int i = 0; i < 32; ++i) va[i] = vb[i];
        it = nx;
    }
}
__device__ __forceinline__ void conv_ffn(const float* gate, const float* up, const float* down, bf16_t* gu, bf16_t* dn, LAS float* scr, int lane, int gw, int NGW) {
    tr_mat(gate, D_, F_, gu, D_, 1, 0, 0, nullptr, scr, lane, gw, NGW, 0);
    tr_mat(up, D_, F_, gu, D_, 1, 128, 0, nullptr, scr, lane, gw, NGW, 5632);
    tr_mat(down, F_, D_, dn, F_, 0, 0, 0, nullptr, scr, lane, gw, NGW, 11264);
}
__device__ __forceinline__ void conv_rwkv(const Params& p, unsigned char* ws, LAS float* scr, int lane, int gw, int NGW) {
    tr_mat(pin(p, 13), D_, D_, (bf16_t*)(ws + O_WRT), D_, 0, 0, 0, nullptr, scr, lane, gw, NGW, 0);
    tr_mat(pin(p, 14), D_, D_, (bf16_t*)(ws + O_WKT), D_, 0, 0, 0, nullptr, scr, lane, gw, NGW, 0);
    tr_mat(pin(p, 15), D_, D_, (bf16_t*)(ws + O_WVT), D_, 0, 0, 0, nullptr, scr, lane, gw, NGW, 0);
    tr_mat(pin(p, 16), D_, D_, (bf16_t*)(ws + O_WOT), D_, 0, 0, 0, nullptr, scr, lane, gw, NGW, 0);
    for (int d = 0; d < 2; ++d) {
        tr_mat(pin(p, 18) + (size_t)d * D_ * 96, D_, 96, (bf16_t*)(ws + O_W1C), D_, 0, d * 96, 0, nullptr, scr, lane, gw, NGW, d * 96);
        tr_mat(pin(p, 21) + (size_t)d * D_ * 96, D_, 96, (bf16_t*)(ws + O_A1C), D_, 0, d * 96, 0, nullptr, scr, lane, gw, NGW, 192 + d * 96);
    }
    tr_mat(pin(p, 23), D_, 256, (bf16_t*)(ws + O_G1C), D_, 0, 0, 0, nullptr, scr, lane, gw, NGW, 384);
    tr_mat(pin(p, 24), 256, D_, (bf16_t*)(ws + O_G2T), 256, 0, 0, 0, nullptr, scr, lane, gw, NGW, 1280);
    for (int g = 0; g < 4; ++g)
        tr_mat(pin(p, 10) + (size_t)g * 512 * 512, 512, 512, (bf16_t*)(ws + O_POOLT) + (size_t)g * 512 * 512, 512, 0, 0, 0, nullptr, scr, lane, gw, NGW, 1536 + g * 128);
    const int gt = gw * 64 + lane, NT = NGW * 64;
    for (int idx = gt; idx < 2 * 64 * 2048; idx += NT) {
        const int which = idx / (64 * 2048), r = idx % (64 * 2048);
        bf16_t* dst = (bf16_t*)(ws + (which ? O_A1C : O_W1C)) + (size_t)192 * 2048;
        dst[r] = 0;
    }
    for (int idx = gt; idx < 4 * 256 * 2048; idx += NT) {
        const int mat = idx / (256 * 2048), r = idx % (256 * 2048), kk = r / 2048, n = r % 2048;
        const int d = mat & 1; const bool isa = mat >= 2;
        const float* src = (isa ? pin(p, 22) : pin(p, 19)) + (size_t)d * 96 * D_;
        bf16_t* dst = (bf16_t*)(ws + (isa ? (d ? O_A2T1 : O_A2T0) : (d ? O_W2T1 : O_W2T0)));
        const int j = kk - d * 96;
        const float v = (j >= 0 && j < 96) ? src[(size_t)j * D_ + n] : 0.f;
        dst[(size_t)n * 256 + kk] = (bf16_t)(cvt_pk_bf16(v, 0.f) & 0xffffu);
    }
}

template <bool FINAL>
__device__ __forceinline__ void norm_phase(const float* src, const float* gain, bf16_t* dst, float* fdst, int lane, int gw, int NGW) {
    f32x4 gv[8];
#pragma unroll
    for (int j = 0; j < 8; ++j) gv[j] = ((const f32x4*)gain)[lane + 64 * j];
    for (int row = gw; row < M_; row += NGW) {
        const f32x4* xr = (const f32x4*)(src + (size_t)row * D_) + lane;
        f32x4 v[8]; float s = 0.f;
#pragma unroll
        for (int j = 0; j < 8; ++j) { v[j] = xr[64 * j]; s += (v[j].x * v[j].x + v[j].y * v[j].y) + (v[j].z * v[j].z + v[j].w * v[j].w); }
        const float rstd = rsqrtf(wave_sum(s) * (1.f / D_) + 1e-6f);
        if (FINAL) {
            f32x4* o = (f32x4*)(fdst + (size_t)row * D_) + lane;
#pragma unroll
            for (int j = 0; j < 8; ++j) o[64 * j] = v[j] * rstd * gv[j];
        } else {
            u32x2* o = (u32x2*)(dst + (size_t)row * D_) + lane;
#pragma unroll
            for (int j = 0; j < 8; ++j) { f32x4 t = v[j] * rstd * gv[j]; u32x2 w; w.x = cvt_pk_bf16(t.x, t.y); w.y = cvt_pk_bf16(t.z, t.w); o[64 * j] = w; }
        }
    }
}

__device__ __forceinline__ void load_norm_row(const float* src, int row, const f32x4 (&gv)[8], f32x4 (&o)[8], int lane) {
    const f32x4* xr = (const f32x4*)(src + (size_t)row * D_) + lane;
    float s = 0.f;
#pragma unroll
    for (int j = 0; j < 8; ++j) { o[j] = xr[64 * j]; s += (o[j].x * o[j].x + o[j].y * o[j].y) + (o[j].z * o[j].z + o[j].w * o[j].w); }
    const float rstd = rsqrtf(wave_sum(s) * (1.f / D_) + 1e-6f);
#pragma unroll
    for (int j = 0; j < 8; ++j) o[j] = o[j] * rstd * gv[j];
}
__device__ __forceinline__ void rwkv_prep_phase(const float* h, const float* gain, const float* mu, bf16_t* x6, int lane, int gw, int NGW) {
    f32x4 gv[8];
#pragma unroll
    for (int j = 0; j < 8; ++j) gv[j] = ((const f32x4*)gain)[lane + 64 * j];
    for (int run = gw; run < M_ / 8; run += NGW) {
        const int row0 = run * 8, t0 = row0 & (S_ - 1);
        f32x4 prev[8], cur[8], nxt[8];
        if (t0 > 0) load_norm_row(h, row0 - 1, gv, prev, lane);
        else {
#pragma unroll
            for (int j = 0; j < 8; ++j) prev[j] = (f32x4){0.f, 0.f, 0.f, 0.f};
        }
        load_norm_row(h, row0, gv, cur, lane);
        for (int i = 0; i < 8; ++i) {
            const int row = row0 + i, t = t0 + i;
            if (t + 1 < S_) load_norm_row(h, row + 1, gv, nxt, lane);
            else {
#pragma unroll
                for (int j = 0; j < 8; ++j) nxt[j] = (f32x4){0.f, 0.f, 0.f, 0.f};
            }
#pragma unroll
            for (int j = 0; j < 8; ++j) {
                const f32x4 xx = (prev[j] + nxt[j]) * 0.5f - cur[j];
#pragma unroll
                for (int q = 0; q < 6; ++q) {
                    const f32x4 m4 = ((const f32x4*)(mu + (size_t)q * D_))[lane + 64 * j];
                    const f32x4 xm = cur[j] + xx * m4;
                    u32x2 w; w.x = cvt_pk_bf16(xm.x, xm.y); w.y = cvt_pk_bf16(xm.z, xm.w);
                    ((u32x2*)(x6 + (size_t)q * M_ * D_ + (size_t)row * D_))[lane + 64 * j] = w;
                }
                prev[j] = cur[j]; cur[j] = nxt[j];
            }
        }
    }
}

__device__ __forceinline__ void pool_prep_phase(const float* h, const float* gain, bf16_t* outp, LAS unsigned char* lds, int tid, int lane, int wave, int bid, int nb) {
    LAS float* rs = (LAS float*)lds;
    for (int chunk = bid; chunk < M_ / 64; chunk += nb) {
        const int m0 = chunk * 64, b = m0 / S_, t0 = m0 % S_;
        __syncthreads();
        for (int rr = wave; rr < 80; rr += 8) {
            const int t = t0 - 8 + rr;
            if (t >= 0 && t < S_) {
                const f32x4* xr = (const f32x4*)(h + ((size_t)b * S_ + t) * D_) + lane;
                float s = 0.f;
#pragma unroll
                for (int j = 0; j < 8; ++j) { const f32x4 v = xr[64 * j]; s += (v.x * v.x + v.y * v.y) + (v.z * v.z + v.w * v.w); }
                s = wave_sum(s);
                if (lane == 0) rs[rr] = rsqrtf(s * (1.f / D_) + 1e-6f);
            }
        }
        __syncthreads();
        const int c = 4 * tid, g = tid >> 7, w = 2 << g, half = w >> 1;
        const f32x4 gn = *(const f32x4*)(gain + c);
        const float* hb = h + (size_t)b * S_ * D_ + c;
#define HN(t) ((*(const f32x4*)(hb + (size_t)(t) * D_)) * rs[(t) - t0 + 8] * gn)
        int lo = t0 - half; if (lo < 0) lo = 0;
        int hi = t0 + half; if (hi > S_) hi = S_;
        f32x4 sum = (f32x4){0.f, 0.f, 0.f, 0.f};
        for (int u = lo; u < hi; ++u) sum += HN(u);
#pragma unroll 8
        for (int i = 0; i < 64; ++i) {
            const int t = t0 + i;
            const f32x4 x = HN(t);
            const float inv = 1.f / (float)(hi - lo);
            const f32x4 o = sum * inv - x;
            u32x2 wv; wv.x = cvt_pk_bf16(o.x, o.y); wv.y = cvt_pk_bf16(o.z, o.w);
            *(u32x2*)(outp + ((size_t)b * S_ + t) * D_ + c) = wv;
            if (i < 63) {
                if (t + 1 - half > 0) { sum -= HN(lo); ++lo; }
                if (t + half < S_) { sum += HN(t + half); ++hi; }
            }
        }
#undef HN
    }
}

constexpr int BM = 256, BK = 64, HALF = 128, HTB = HALF * BK * 2;
__device__ __forceinline__ int lds_byte(int r, int c) { const int st = (r >> 4) * 2 + (c >> 5), rr = r & 15, cc = c & 31, ob = rr * 64 + cc * 2; return st * 1024 + (ob ^ (((ob >> 9) & 1) << 5)); }
__device__ __forceinline__ void stage_rc(int b, int& R, int& C) { const int st = b / 1024, sb = b % 1024, swz = sb ^ (((sb >> 9) & 1) << 5); R = (st >> 1) * 16 + swz / 64; C = (st & 1) * 32 + (swz % 64) / 2; }
__device__ __forceinline__ int perm32(int rho) { const int n = rho >> 4, i = rho & 15; return 8 * (i >> 2) + 4 * n + (i & 3); }

struct Unit { const char* a; const char* b; int pm, pn, job; };

__device__ __forceinline__ void remap_tile(int l, int nM, int nN, int& pm, int& pn, int wgm = 8) {
    const int nwg = nM * nN; int wgid = l;
    { const int q = nwg / 8, r = nwg % 8, xcd = wgid % 8, off = wgid / 8; wgid = (xcd < r ? xcd * (q + 1) : r * (q + 1) + (xcd - r) * q) + off; }
    const int nig = wgm * nN, gid = wgid / nig, fm = gid * wgm, gsz = (nM - fm) < wgm ? (nM - fm) : wgm;
    pm = fm + ((wgid % nig) % gsz); pn = (wgid % nig) / gsz;
}

template <class Epi, class Sched>
__device__ __forceinline__ void gemm_phase(LAS unsigned char* lds, const int tid, const int K, const int lda, const int ldb, const Sched& S, const Epi& E) {
    const int wid = __builtin_amdgcn_readfirstlane(tid >> 6), lane = tid & 63, wr = wid >> 2, wc = wid & 3, fr = lane & 15, fq = lane >> 4;
    const int nt = K / BK;
    unsigned voffA, voffB;
    { int R, C; stage_rc(tid * 16, R, C); const int Rb = Epi::PERM ? ((R & ~31) + perm32(R & 31)) : R;
        voffA = (unsigned)(R * lda + C) * 2u; voffB = (unsigned)(Rb * ldb + C) * 2u; }
    const size_t q64A = (size_t)64 * lda * 2, q64B = (size_t)64 * ldb * 2;
    const size_t kstep = (size_t)(BK * 2);
    const size_t hstepA = (size_t)HALF * lda * 2, hstepB = (size_t)HALF * ldb * 2;
    const unsigned ldsw = (unsigned)wid * 1024u;
    const int aoff = lds_byte(wr * 64 + fr, fq * 8), boff = lds_byte(wc * 32 + fr, fq * 8);
#define PG8_SA(b, h) (((b) * 2 + (h)) * HTB)
#define PG8_SB(b, h) ((4 + (b) * 2 + (h)) * HTB)
#define PG8_STAGE(bufoff, gbase, voff) do { \
        __builtin_amdgcn_global_load_lds((const unsigned*)((const char*)(gbase) + (voff)), (LAS unsigned*)(lds + (bufoff) + ldsw), 16, 0, 0); \
        __builtin_amdgcn_global_load_lds((const unsigned*)((const char*)(gbase) + q64_##voff + (voff)), (LAS unsigned*)(lds + (bufoff) + ldsw + 8192), 16, 0, 0); } while (0)
#define q64_voffA q64A
#define q64_voffB q64B
#define PG8_LDA(dst, b, h) do { _Pragma("unroll") for (int m = 0; m < 4; ++m) _Pragma("unroll") for (int k = 0; k < 2; ++k) dst[m][k] = *(const LAS bf16x8*)(lds + PG8_SA(b, h) + aoff + m * 2048 + k * 1024); } while (0)
#define PG8_LDB(dst, b, h) do { _Pragma("unroll") for (int n = 0; n < 2; ++n) _Pragma("unroll") for (int k = 0; k < 2; ++k) dst[n][k] = *(const LAS bf16x8*)(lds + PG8_SB(b, h) + boff + n * 2048 + k * 1024); } while (0)
#define PG8_MMA(ai, bj, At, Bt) do { __builtin_amdgcn_s_setprio(1); _Pragma("unroll") for (int m = 0; m < 4; ++m) _Pragma("unroll") for (int n = 0; n < 2; ++n) _Pragma("unroll") for (int k = 0; k < 2; ++k) \
        acc[ai][bj][m][n] = __builtin_amdgcn_mfma_f32_16x16x32_bf16(Bt[n][k], At[m][k], acc[ai][bj][m][n], 0, 0, 0); __builtin_amdgcn_s_setprio(0); } while (0)
#define PG8_WAIT_V(n) asm volatile("s_waitcnt vmcnt(" #n ")" ::: "memory")
#define PG8_WAIT_L(n) asm volatile("s_waitcnt lgkmcnt(" #n ")" ::: "memory")
#define PG8_BAR __builtin_amdgcn_s_barrier()
#define PG8_SCHED __builtin_amdgcn_sched_barrier(0)
    Unit cur, nxt; int ui = 0;
    if (!S.next(0, cur)) return;
    f32x4 acc[2][2][4][2];
#pragma unroll
    for (int a = 0; a < 2; ++a)
#pragma unroll
        for (int b = 0; b < 2; ++b)
#pragma unroll
            for (int m = 0; m < 4; ++m)
#pragma unroll
                for (int n = 0; n < 2; ++n) acc[a][b][m][n] = (f32x4){0.f, 0.f, 0.f, 0.f};
    bf16x8 At[4][2], B0[2][2], B1[2][2];
    const char* cA = cur.a; const char* cB = cur.b;
    PG8_STAGE(PG8_SB(0, 0), cB, voffB); PG8_STAGE(PG8_SA(0, 0), cA, voffA); PG8_STAGE(PG8_SB(0, 1), cB + hstepB, voffB); PG8_STAGE(PG8_SA(0, 1), cA + hstepA, voffA);
    if (wr == 1) PG8_BAR;
    PG8_WAIT_V(4); PG8_BAR;
    PG8_STAGE(PG8_SB(1, 0), cB + kstep, voffB); PG8_STAGE(PG8_SA(1, 0), cA + kstep, voffA); PG8_STAGE(PG8_SB(1, 1), cB + hstepB + kstep, voffB);
    PG8_WAIT_V(6); PG8_BAR;
    for (;;) {
        const bool has_next = S.next(ui + 1, nxt);
        const char* nA = has_next ? nxt.a : cA; const char* nB = has_next ? nxt.b : cB;
        for (int t = 0; t < nt; t += 2) {
            const bool last = (t == nt - 2);
            const char* a1 = cA + (size_t)(t + 1) * kstep;
            const char* a2 = last ? nA : cA + (size_t)(t + 2) * kstep; const char* b2 = last ? nB : cB + (size_t)(t + 2) * kstep;
            const char* a3 = a2 + kstep; const char* b3 = b2 + kstep;
            PG8_LDB(B0, 0, 0); PG8_SCHED; PG8_LDA(At, 0, 0); PG8_STAGE(PG8_SA(1, 1), a1 + hstepA, voffA);
            PG8_WAIT_L(8); PG8_BAR; PG8_WAIT_L(0); PG8_MMA(0, 0, At, B0); PG8_BAR; PG8_SCHED;
            PG8_LDB(B1, 0, 1); PG8_STAGE(PG8_SB(0, 0), b2, voffB);
            PG8_BAR; PG8_WAIT_L(0); PG8_MMA(0, 1, At, B1); PG8_BAR;
            PG8_LDA(At, 0, 1); PG8_STAGE(PG8_SA(0, 0), a2, voffA);
            PG8_BAR; PG8_WAIT_L(0); PG8_MMA(1, 0, At, B0); PG8_BAR; PG8_SCHED;
            PG8_STAGE(PG8_SB(0, 1), b2 + hstepB, voffB);
            PG8_WAIT_V(6); PG8_BAR; PG8_MMA(1, 1, At, B1); PG8_BAR;
            PG8_LDB(B0, 1, 0); PG8_SCHED; PG8_LDA(At, 1, 0); PG8_STAGE(PG8_SA(0, 1), a2 + hstepA, voffA);
            PG8_WAIT_L(8); PG8_BAR; PG8_WAIT_L(0); PG8_MMA(0, 0, At, B0); PG8_BAR; PG8_SCHED;
            PG8_LDB(B1, 1, 1); PG8_STAGE(PG8_SB(1, 0), b3, voffB);
            PG8_BAR; PG8_WAIT_L(0); PG8_MMA(0, 1, At, B1); PG8_BAR;
            PG8_LDA(At, 1, 1); PG8_STAGE(PG8_SA(1, 0), a3, voffA);
            PG8_BAR; PG8_WAIT_L(0); PG8_MMA(1, 0, At, B0); PG8_BAR; PG8_SCHED;
            PG8_STAGE(PG8_SB(1, 1), b3 + hstepB, voffB);
            PG8_WAIT_V(6); PG8_BAR; PG8_MMA(1, 1, At, B1); PG8_BAR;
        }
        { int ln = lane; asm volatile("" : "+v"(ln)); E(acc, cur, wr, wc, ln & 15, ln >> 4); }
        if (!has_next) break;
#pragma unroll
        for (int a = 0; a < 2; ++a)
#pragma unroll
            for (int b = 0; b < 2; ++b)
#pragma unroll
                for (int m = 0; m < 4; ++m)
#pragma unroll
                    for (int n = 0; n < 2; ++n) acc[a][b][m][n] = (f32x4){0.f, 0.f, 0.f, 0.f};
        cur = nxt; cA = nA; cB = nB; ++ui;
    }
    PG8_WAIT_V(0);
    if (wr == 0) PG8_BAR;
    PG8_BAR;
#undef PG8_SA
#undef PG8_SB
#undef PG8_STAGE
#undef q64_voffA
#undef q64_voffB
#undef PG8_LDA
#undef PG8_LDB
#undef PG8_MMA
#undef PG8_WAIT_V
#undef PG8_WAIT_L
#undef PG8_BAR
#undef PG8_SCHED
}

struct SchedSimple {
    const char* A; const char* Bt; int nM, nN, G, c, poolmode, wgm; size_t tstepA, tstepB;
    __device__ __forceinline__ bool next(int i, Unit& u) const {
        const int L = i * G + c; if (L >= nM * nN) return false;
        int pm, pn; remap_tile(L, nM, nN, pm, pn, wgm);
        u.a = A + (size_t)pm * tstepA + (poolmode ? (size_t)(pn >> 1) * 1024 : 0); u.b = Bt + (size_t)pn * tstepB; u.pm = pm; u.pn = pn; u.job = 0; return true;
    }
};
struct SchedProj {
    const char* ws; int G, c;
    __device__ __forceinline__ bool next(int i, Unit& u) const {
        const int L = i * G + c; if (L >= 1728) return false;
        int job, l, nN; size_t bo, ao;
        if (L < 1536) { job = L >> 9; l = L & 511; nN = 8; bo = job == 0 ? O_WRT : (job == 1 ? O_WKT : O_WVT); ao = job == 0 ? 0 : (job == 1 ? 2 : 3); }
        else { const int q = L - 1536; job = 3 + (q >> 6); l = q & 63; nN = 1; bo = job == 3 ? O_W1C : (job == 4 ? O_A1C : O_G1C); ao = job == 3 ? 1 : (job == 4 ? 4 : 5); }
        int pm, pn; remap_tile(l, 64, nN, pm, pn, nN == 8 ? 4 : 8);
        u.a = ws + O_X6 + ao * (64 * MiB) + (size_t)pm * (256 * 2048 * 2); u.b = ws + bo + (size_t)pn * (256 * 2048 * 2); u.pm = pm; u.pn = pn; u.job = job; return true;
    }
};
struct SchedLora2 {
    const char* ws; int G, c;
    __device__ __forceinline__ bool next(int i, Unit& u) const {
        const int L = i * G + c; if (L >= 2560) return false;
        const int job = L >> 9, l = L & 511;
        const size_t ao = job < 2 ? O_LW : (job < 4 ? O_LA : O_LG);
        const size_t bo = job == 0 ? O_W2T0 : (job == 1 ? O_W2T1 : (job == 2 ? O_A2T0 : (job == 3 ? O_A2T1 : O_G2T)));
        int pm, pn; remap_tile(l, 64, 8, pm, pn, 4);
        u.a = ws + ao + (size_t)pm * (256 * 256 * 2); u.b = ws + bo + (size_t)pn * (256 * 256 * 2); u.pm = pm; u.pn = pn; u.job = job; return true;
    }
};

struct EpiSwiGLU {
    static constexpr bool PERM = true;
    bf16_t* U;
    __device__ __forceinline__ void operator()(const f32x4 (&acc)[2][2][4][2], const Unit& u, int wr, int wc, int fr, int fq) const {
        const int row0 = u.pm * BM + wr * 64 + fr, col0 = u.pn * 128 + wc * 32 + 8 * fq;
#pragma unroll
        for (int ai = 0; ai < 2; ++ai)
#pragma unroll
            for (int m = 0; m < 4; ++m) {
                bf16_t* rowp = U + (size_t)(row0 + ai * HALF + m * 16) * F_ + col0;
                float o[8];
#pragma unroll
                for (int n = 0; n < 2; ++n)
#pragma unroll
                    for (int j = 0; j < 4; ++j) { const float g = acc[ai][0][m][n][j], up = acc[ai][1][m][n][j]; o[4 * n + j] = g * sigmoidf_(g) * up; }
                u32x4 w; w.x = cvt_pk_bf16(o[0], o[1]); w.y = cvt_pk_bf16(o[2], o[3]); w.z = cvt_pk_bf16(o[4], o[5]); w.w = cvt_pk_bf16(o[6], o[7]);
                *(u32x4*)rowp = w;
            }
    }
};
struct EpiResid {
    static constexpr bool PERM = false;
    const float* src; float* dst; const float* colscale; float scale;
    __device__ __forceinline__ void operator()(const f32x4 (&acc)[2][2][4][2], const Unit& u, int wr, int wc, int fr, int fq) const {
        const int row0 = u.pm * BM + wr * 64 + fr, col0 = u.pn * BM + wc * 32 + 4 * fq;
        f32x4 sv[2][2];
#pragma unroll
        for (int bj = 0; bj < 2; ++bj)
#pragma unroll
            for (int n = 0; n < 2; ++n) sv[bj][n] = colscale ? *(const f32x4*)(colscale + col0 + bj * HALF + n * 16) * scale : (f32x4){scale, scale, scale, scale};
#pragma unroll
        for (int ai = 0; ai < 2; ++ai) {
            f32x4 base[4][2][2];
#pragma unroll
            for (int m = 0; m < 4; ++m)
#pragma unroll
                for (int bj = 0; bj < 2; ++bj)
#pragma unroll
                    for (int n = 0; n < 2; ++n) base[m][bj][n] = *(const f32x4*)(src + (size_t)(row0 + ai * HALF + m * 16) * D_ + col0 + bj * HALF + n * 16);
            __builtin_amdgcn_sched_barrier(0);
#pragma unroll
            for (int m = 0; m < 4; ++m)
#pragma unroll
                for (int bj = 0; bj < 2; ++bj)
#pragma unroll
                    for (int n = 0; n < 2; ++n) *(f32x4*)(dst + (size_t)(row0 + ai * HALF + m * 16) * D_ + col0 + bj * HALF + n * 16) = base[m][bj][n] + acc[ai][bj][m][n] * sv[bj][n];
            __builtin_amdgcn_sched_barrier(0);
        }
    }
};
struct EpiProj {
    static constexpr bool PERM = true;
    unsigned char* ws;
    __device__ __forceinline__ void operator()(const f32x4 (&acc)[2][2][4][2], const Unit& u, int wr, int wc, int fr, int fq) const {
        const int job = u.job;
        const int row0 = u.pm * BM + wr * 64 + fr, col0 = u.pn * BM + wc * 32 + 8 * fq;
        const size_t obase = job == 0 ? O_R : (job == 1 ? O_K : (job == 2 ? O_V : (job == 3 ? O_LW : (job == 4 ? O_LA : O_LG))));
        const int ldc = job < 3 ? D_ : 256;
        unsigned short* outp = (unsigned short*)(ws + obase) + (size_t)row0 * ldc + col0;
        const float c0 = job == 3 ? 1.f : 0.f, c1 = job == 3 ? -2.f : 1.f, c2 = job == 3 ? 2.f : -1.f;
        const bool act = (job == 3) || (job == 5), f16 = job < 3;
#pragma unroll
        for (int ai = 0; ai < 2; ++ai)
#pragma unroll
            for (int m = 0; m < 4; ++m) {
                unsigned short* rowp = outp + (size_t)(ai * HALF + m * 16) * ldc;
#pragma unroll
                for (int bj = 0; bj < 2; ++bj) {
                    f32x4 v0 = acc[ai][bj][m][0], v1 = acc[ai][bj][m][1];
                    if (act) {
#pragma unroll
                        for (int j = 0; j < 4; ++j) { v0[j] = c0 + c1 * __builtin_amdgcn_rcpf(1.f + __expf(c2 * v0[j])); v1[j] = c0 + c1 * __builtin_amdgcn_rcpf(1.f + __expf(c2 * v1[j])); }
                    }
                    u32x4 w;
                    if (f16) { w.x = pk_h2(v0[0], v0[1]); w.y = pk_h2(v0[2], v0[3]); w.z = pk_h2(v1[0], v1[1]); w.w = pk_h2(v1[2], v1[3]); }
                    else { w.x = cvt_pk_bf16(v0[0], v0[1]); w.y = cvt_pk_bf16(v0[2], v0[3]); w.z = cvt_pk_bf16(v1[0], v1[1]); w.w = cvt_pk_bf16(v1[2], v1[3]); }
                    *(u32x4*)(rowp + bj * HALF) = w;
                }
            }
    }
};
struct EpiLora2 {
    static constexpr bool PERM = true;
    unsigned char* ws; const float* w0; const float* a0;
    __device__ __forceinline__ void operator()(const f32x4 (&acc)[2][2][4][2], const Unit& u, int wr, int wc, int fr, int fq) const {
        const int job = u.job;
        const int row0 = u.pm * BM + wr * 64 + fr, col0 = u.pn * BM + wc * 32 + 8 * fq;
        const size_t obase = job == 0 ? O_E0 : (job == 1 ? O_E1 : (job == 2 ? O_A0 : (job == 3 ? O_A1 : O_G)));
        unsigned short* outp = (unsigned short*)(ws + obase) + (size_t)row0 * D_ + col0;
        const float* bias = (job < 2 ? (w0 + (size_t)job * D_) : (a0 + (size_t)(job & 1) * D_)) + col0;
        const float osc = job < 2 ? 0.60653065971f : 1.f;
        const bool act = job < 4;
#pragma unroll
        for (int bj = 0; bj < 2; ++bj) {
            f32x4 b0 = (f32x4){0.f, 0.f, 0.f, 0.f}, b1 = b0;
            if (act) { b0 = *(const f32x4*)(bias + bj * HALF); b1 = *(const f32x4*)(bias + bj * HALF + 4); }
#pragma unroll
            for (int ai = 0; ai < 2; ++ai)
#pragma unroll
                for (int m = 0; m < 4; ++m) {
                    unsigned short* rowp = outp + (size_t)(ai * HALF + m * 16) * D_;
                    f32x4 v0 = acc[ai][bj][m][0] + b0, v1 = acc[ai][bj][m][1] + b1;
                    if (act) {
#pragma unroll
                        for (int j = 0; j < 4; ++j) { v0[j] = osc * sigmoidf_(v0[j]); v1[j] = osc * sigmoidf_(v1[j]); }
                    }
                    u32x4 w; w.x = pk_h2(v0[0], v0[1]); w.y = pk_h2(v0[2], v0[3]); w.z = pk_h2(v1[0], v1[1]); w.w = pk_h2(v1[2], v1[3]);
                    *(u32x4*)(rowp + bj * HALF) = w;
                    __builtin_amdgcn_sched_barrier(0);
                }
        }
    }
};

constexpr int SC_T = 32;
constexpr int SC_AV = 0, SC_WR = SC_T * 32 * 4, SC_W = 2 * SC_T * 32 * 4, SC_BK = SC_W + SC_T * 64 * 4, SC_V = SC_BK + SC_T * 64 * 4, SC_SC = SC_V + SC_T * 64 * 4, SC_Y = SC_SC + SC_T * 2 * 4, SC_A = SC_Y + SC_T * 64 * 4, SC_BUF = SC_A + SC_T * 64 * 4;
constexpr int SC_ZERO = 2 * SC_BUF;
typedef _Float16 half2_t __attribute__((ext_vector_type(2)));
__device__ __forceinline__ float dot2h(unsigned a, unsigned b, float c) { return __builtin_amdgcn_fdot2(__builtin_bit_cast(half2_t, a), __builtin_bit_cast(half2_t, b), c, false); }
__device__ __forceinline__ void red8x4(float& a, float& b, float& c, float& d) {
    asm volatile("s_nop 1\n\t"
                 "v_add_f32_dpp %0, %0, %0 quad_perm:[1,0,3,2] row_mask:0xf bank_mask:0xf\n\t"
                 "v_add_f32_dpp %1, %1, %1 quad_perm:[1,0,3,2] row_mask:0xf bank_mask:0xf\n\t"
                 "v_add_f32_dpp %2, %2, %2 quad_perm:[1,0,3,2] row_mask:0xf bank_mask:0xf\n\t"
                 "v_add_f32_dpp %3, %3, %3 quad_perm:[1,0,3,2] row_mask:0xf bank_mask:0xf\n\t"
                 "v_add_f32_dpp %0, %0, %0 quad_perm:[2,3,0,1] row_mask:0xf bank_mask:0xf\n\t"
                 "v_add_f32_dpp %1, %1, %1 quad_perm:[2,3,0,1] row_mask:0xf bank_mask:0xf\n\t"
                 "v_add_f32_dpp %2, %2, %2 quad_perm:[2,3,0,1] row_mask:0xf bank_mask:0xf\n\t"
                 "v_add_f32_dpp %3, %3, %3 quad_perm:[2,3,0,1] row_mask:0xf bank_mask:0xf\n\t"
                 "v_add_f32_dpp %0, %0, %0 row_half_mirror row_mask:0xf bank_mask:0xf\n\t"
                 "v_add_f32_dpp %1, %1, %1 row_half_mirror row_mask:0xf bank_mask:0xf\n\t"
                 "v_add_f32_dpp %2, %2, %2 row_half_mirror row_mask:0xf bank_mask:0xf\n\t"
                 "v_add_f32_dpp %3, %3, %3 row_half_mirror row_mask:0xf bank_mask:0xf"
                 : "+v"(a), "+v"(b), "+v"(c), "+v"(d));
}
__device__ __forceinline__ void scan_phase(const Params& p, unsigned char* ws, LAS unsigned char* lds, int tid, int lane, int wave, int bid, int nb) {
    const float* k_k = pin(p, 25); const float* k_a = pin(p, 26); const float* r_k = pin(p, 27);
    for (int chain = bid; chain < 256; chain += nb) {
        const int d = chain & 1, hh = (chain >> 1) & 31, b = chain >> 6;
        const unsigned short* Rg = (const unsigned short*)(ws + O_R);
        const unsigned short* Kg = (const unsigned short*)(ws + O_K);
        const unsigned short* Vg = (const unsigned short*)(ws + O_V);
        unsigned short* Eg = (unsigned short*)(ws + (d ? O_E1 : O_E0));
        const unsigned short* Ag = (const unsigned short*)(ws + (d ? O_A1 : O_A0));
        float* BSg = (float*)(ws + O_BS) + (size_t)d * M_ * NH_;
        __syncthreads();
        if (wave >= 4) {
            const int lid = tid - 256, s = lid >> 3, j0 = 8 * (lid & 7), ch = hh * 64 + j0;
            float kkc[8], kac[8], rkc[8];
#pragma unroll
            for (int i = 0; i < 8; ++i) { kkc[i] = k_k[ch + i]; kac[i] = k_a[ch + i]; rkc[i] = r_k[ch + i]; }
            if (lid < 32) ((LAS unsigned*)(lds + SC_ZERO))[lid] = 0u;
            h8 r8, k8, v8, e8, a8;
            { const int t = d ? (S_ - 1 - s) : s; const size_t off = ((size_t)b * S_ + t) * D_ + ch;
              r8 = *(const h8*)(Rg + off); k8 = *(const h8*)(Kg + off); v8 = *(const h8*)(Vg + off); e8 = *(const h8*)(Eg + off); a8 = *(const h8*)(Ag + off); }
            for (int ci = -1; ci < S_ / SC_T; ++ci) {
                if (ci >= 1) {
                    const int cj = ci - 1; const int st = cj * SC_T + s; const int t = d ? (S_ - 1 - st) : st;
                    const LAS unsigned char* fb = lds + (cj & 1) * SC_BUF;
                    const LAS float* yb = (const LAS float*)(fb + SC_Y) + s * 64 + j0; const LAS float* ab = (const LAS float*)(fb + SC_A) + s * 64 + j0; const LAS float* vv = (const LAS float*)(fb + SC_V) + s * 64 + j0;
                    const f32x2 bk2 = *(const LAS f32x2*)((const LAS float*)(fb + SC_SC) + s * 2);
                    const f32x4 y0 = *(const LAS f32x4*)yb + *(const LAS f32x4*)ab * bk2.x + *(const LAS f32x4*)vv * bk2.y, y1 = *(const LAS f32x4*)(yb + 4) + *(const LAS f32x4*)(ab + 4) * bk2.x + *(const LAS f32x4*)(vv + 4) * bk2.y;
                    u32x4 w; w.x = cvt_pk_bf16(y0.x, y0.y); w.y = cvt_pk_bf16(y0.z, y0.w); w.z = cvt_pk_bf16(y1.x, y1.y); w.w = cvt_pk_bf16(y1.z, y1.w);
                    *(u32x4*)(Eg + ((size_t)b * S_ + t) * D_ + ch) = w;
                }
                if (ci + 1 < S_ / SC_T) {
                    const int cj = ci + 1; const int st = cj * SC_T + s; const int t = d ? (S_ - 1 - st) : st;
                    const size_t m = (size_t)b * S_ + t;
                    h8 r8n = r8, k8n = k8, v8n = v8, e8n = e8, a8n = a8;
                    if (cj + 1 < S_ / SC_T) {
                        const int st2 = (cj + 1) * SC_T + s; const int t2 = d ? (S_ - 1 - st2) : st2; const size_t off2 = ((size_t)b * S_ + t2) * D_ + ch;
                        r8n = *(const h8*)(Rg + off2); k8n = *(const h8*)(Kg + off2); v8n = *(const h8*)(Vg + off2); e8n = *(const h8*)(Eg + off2); a8n = *(const h8*)(Ag + off2);
                    }
                    float kk[8], ss = 0.f;
#pragma unroll
                    for (int i = 0; i < 8; ++i) { kk[i] = (float)k8[i] * kkc[i]; ss += kk[i] * kk[i]; }
                    ss = red8(ss);
                    const float inv = fminf(__builtin_amdgcn_rsqf(ss), 1e12f);
                    float ps[8];
                    const int wl = lid & 63;
#pragma unroll
                    for (int i = 0; i < 8; ++i) ps[i] = (float)e8[i];
#pragma unroll
                    for (int dd = 8; dd < 64; dd <<= 1) {
#pragma unroll
                        for (int i = 0; i < 8; ++i) { const float tup = __shfl_up(ps[i], dd); ps[i] += (wl >= dd) ? tup : 0.f; }
                    }
                    float av[8], wv[8], bb[8], kd[8], wrr[8], br = 0.f, kr = 0.f, bsum = 0.f;
#pragma unroll
                    for (int i = 0; i < 8; ++i) {
                        const float rr = (float)r8[i], kf = (float)k8[i], af = (float)a8[i], ei = (float)e8[i];
                        const float Pt = __expf(-ps[i]), Pm = __expf(ei - ps[i]), iP = __expf(ps[i]);
                        kk[i] *= inv; const float bt = kk[i] * af, kt = kf * (1.f + (af - 1.f) * kac[i]);
                        br += bt * rr; kr += kt * rr; bsum += rr * kt * rkc[i];
                        av[i] = -kk[i] * Pm; wrr[i] = Pt * rr; bb[i] = bt * iP; kd[i] = kt * iP; wv[i] = Pt;
                    }
                    br = red8(br); kr = red8(kr); bsum = red8(bsum);
                    LAS unsigned char* buf = lds + (cj & 1) * SC_BUF;
                    *(LAS u32x4*)((LAS unsigned*)(buf + SC_AV) + s * 32 + (j0 >> 1)) = (u32x4){pk_h2(av[0], av[1]), pk_h2(av[2], av[3]), pk_h2(av[4], av[5]), pk_h2(av[6], av[7])};
                    *(LAS u32x4*)((LAS unsigned*)(buf + SC_WR) + s * 32 + (j0 >> 1)) = (u32x4){pk_h2(wrr[0], wrr[1]), pk_h2(wrr[2], wrr[3]), pk_h2(wrr[4], wrr[5]), pk_h2(wrr[6], wrr[7])};
                    if ((s & 7) == 7) { LAS float* wp = (LAS float*)(buf + SC_W) + (s >> 3) * 64 + j0;
                      *(LAS f32x4*)wp = (f32x4){wv[0], wv[1], wv[2], wv[3]}; *(LAS f32x4*)(wp + 4) = (f32x4){wv[4], wv[5], wv[6], wv[7]}; }
                    LAS unsigned* bkp = (LAS unsigned*)(buf + SC_BK) + s * 64 + j0;
                    *(LAS u32x4*)bkp = (u32x4){pk_h2(bb[0], kd[0]), pk_h2(bb[1], kd[1]), pk_h2(bb[2], kd[2]), pk_h2(bb[3], kd[3])};
                    *(LAS u32x4*)(bkp + 4) = (u32x4){pk_h2(bb[4], kd[4]), pk_h2(bb[5], kd[5]), pk_h2(bb[6], kd[6]), pk_h2(bb[7], kd[7])};
                    LAS float* vb = (LAS float*)(buf + SC_V) + s * 64 + j0;
                    *(LAS f32x4*)vb = (f32x4){(float)v8[0], (float)v8[1], (float)v8[2], (float)v8[3]}; *(LAS f32x4*)(vb + 4) = (f32x4){(float)v8[4], (float)v8[5], (float)v8[6], (float)v8[7]};
                    if ((lid & 7) == 0) { *(LAS f32x2*)((LAS float*)(buf + SC_SC) + s * 2) = (f32x2){br, kr}; BSg[m * NH_ + hh] = bsum; }
                    r8 = r8n; k8 = k8n; v8 = v8n; e8 = e8n; a8 = a8n;
                }
                __syncthreads();
            }
            {
                const int cj = S_ / SC_T - 1; const int st = cj * SC_T + s; const int t = d ? (S_ - 1 - st) : st;
                const LAS unsigned char* fb = lds + (cj & 1) * SC_BUF;
                const LAS float* yb = (const LAS float*)(fb + SC_Y) + s * 64 + j0; const LAS float* ab = (const LAS float*)(fb + SC_A) + s * 64 + j0; const LAS float* vv = (const LAS float*)(fb + SC_V) + s * 64 + j0;
                const f32x2 bk2 = *(const LAS f32x2*)((const LAS float*)(fb + SC_SC) + s * 2);
                const f32x4 y0 = *(const LAS f32x4*)yb + *(const LAS f32x4*)ab * bk2.x + *(const LAS f32x4*)vv * bk2.y, y1 = *(const LAS f32x4*)(yb + 4) + *(const LAS f32x4*)(ab + 4) * bk2.x + *(const LAS f32x4*)(vv + 4) * bk2.y;
                u32x4 w; w.x = cvt_pk_bf16(y0.x, y0.y); w.y = cvt_pk_bf16(y0.z, y0.w); w.z = cvt_pk_bf16(y1.x, y1.y); w.w = cvt_pk_bf16(y1.z, y1.w);
                *(u32x4*)(Eg + ((size_t)b * S_ + t) * D_ + ch) = w;
            }
        } else {
            const int rl = lane & 15, g = lane >> 4, row = 16 * wave + rl, m4 = rl & 3;
            f32x2 S[8];
#pragma unroll
            for (int q = 0; q < 8; ++q) S[q] = (f32x2){0.f, 0.f};
            __syncthreads();
            for (int ci = 0; ci < S_ / SC_T; ++ci) {
                const LAS unsigned char* buf = lds + (ci & 1) * SC_BUF;
                const LAS unsigned char* xb = (m4 == 0 ? buf + SC_AV : (m4 == 1 ? buf + SC_WR : lds + SC_ZERO)) + 16 * g;
                const int xs = m4 < 2 ? 128 : 0;
                const LAS float* wb = (const LAS float*)(buf + SC_W) + 8 * g;
                const LAS unsigned* bkb = (const LAS unsigned*)(buf + SC_BK) + 8 * g;
                const LAS float* vb = (const LAS float*)(buf + SC_V) + row;
                LAS float* yb = (LAS float*)(lds + (ci & 1) * SC_BUF + SC_Y) + row;
#define SC_LOAD(P, s) do { \
                    P##x1 = *(const LAS h8*)(xb + (s) * xs); P##x2 = *(const LAS h8*)(xb + (s) * xs + 64); \
                                        P##k0 = *(const LAS u32x4*)(bkb + (s) * 64); P##k1 = *(const LAS u32x4*)(bkb + (s) * 64 + 4); P##k2 = *(const LAS u32x4*)(bkb + (s) * 64 + 32); P##k3 = *(const LAS u32x4*)(bkb + (s) * 64 + 36); \
                    P##v = *(vb + (s) * 64); } while (0)
#define SC_STEP(P, s) do { \
                    const u32x4 b1u = (u32x4){pk_h2(S[0].x, S[0].y), pk_h2(S[1].x, S[1].y), pk_h2(S[2].x, S[2].y), pk_h2(S[3].x, S[3].y)}; \
                    const u32x4 b2u = (u32x4){pk_h2(S[4].x, S[4].y), pk_h2(S[5].x, S[5].y), pk_h2(S[6].x, S[6].y), pk_h2(S[7].x, S[7].y)}; \
                    f32x4 acc = __builtin_amdgcn_mfma_f32_16x16x32_f16(P##x1, __builtin_bit_cast(h8, b1u), (f32x4){0.f, 0.f, 0.f, 0.f}, 0, 0, 0); \
                    acc = __builtin_amdgcn_mfma_f32_16x16x32_f16(P##x2, __builtin_bit_cast(h8, b2u), acc, 0, 0, 0); \
                    f32x2 t; \
                    const unsigned hh0 = pk_h2(acc[0], P##v); \
                    S[0].x = dot2h(hh0, P##k0.x, S[0].x); S[0].y = dot2h(hh0, P##k0.y, S[0].y); S[1].x = dot2h(hh0, P##k0.z, S[1].x); S[1].y = dot2h(hh0, P##k0.w, S[1].y); \
                    S[2].x = dot2h(hh0, P##k1.x, S[2].x); S[2].y = dot2h(hh0, P##k1.y, S[2].y); S[3].x = dot2h(hh0, P##k1.z, S[3].x); S[3].y = dot2h(hh0, P##k1.w, S[3].y); \
                    S[4].x = dot2h(hh0, P##k2.x, S[4].x); S[4].y = dot2h(hh0, P##k2.y, S[4].y); S[5].x = dot2h(hh0, P##k2.z, S[5].x); S[5].y = dot2h(hh0, P##k2.w, S[5].y); \
                    S[6].x = dot2h(hh0, P##k3.x, S[6].x); S[6].y = dot2h(hh0, P##k3.y, S[6].y); S[7].x = dot2h(hh0, P##k3.z, S[7].x); S[7].y = dot2h(hh0, P##k3.w, S[7].y); \
                    (void)t; if (g == 0) { *(yb + (s) * 64) = acc[1]; *(yb + (s) * 64 + SC_T * 64) = acc[0]; } } while (0)
                h8 Ax1, Ax2, Bx1, Bx2; u32x4 Ak0, Ak1, Ak2, Ak3, Bk0, Bk1, Bk2, Bk3; float Av, Bv;
                SC_LOAD(A, 0);
#pragma unroll
                for (int s = 0; s < SC_T; s += 8) {
                    const LAS float* pg = wb + (s >> 3) * 64;
                    const f32x4 p0 = *(const LAS f32x4*)pg, p1 = *(const LAS f32x4*)(pg + 4), p2 = *(const LAS f32x4*)(pg + 32), p3 = *(const LAS f32x4*)(pg + 36);
#define SC_PAIR(o) SC_LOAD(B, s + (o) + 1); SC_STEP(A, s + (o)); __builtin_amdgcn_sched_barrier(0); \
                    SC_LOAD(A, s + (o) + 2); SC_STEP(B, s + (o) + 1); __builtin_amdgcn_sched_barrier(0)
                    SC_PAIR(0); SC_PAIR(2); SC_PAIR(4); SC_PAIR(6);
#undef SC_PAIR
                    S[0] *= p0.xy; S[1] *= p0.zw; S[2] *= p1.xy; S[3] *= p1.zw; S[4] *= p2.xy; S[5] *= p2.zw; S[6] *= p3.xy; S[7] *= p3.zw;
                }
#undef SC_LOAD
#undef SC_STEP
                __syncthreads();
            }
        }
    }
}

__device__ __forceinline__ void post_phase(const Params& p, unsigned char* ws, int lane, int gw, int NGW) {
    const float* lnw = pin(p, 28); const float* lnb = pin(p, 29);
    const unsigned short* Y0 = (const unsigned short*)(ws + O_E0); const unsigned short* Y1 = (const unsigned short*)(ws + O_E1);
    const unsigned short* Vg = (const unsigned short*)(ws + O_V); const unsigned short* Gg = (const unsigned short*)(ws + O_G);
    const float* BS = (const float*)(ws + O_BS);
    unsigned short* P = (unsigned short*)(ws + O_POST);
    for (int m = gw; m < M_; m += NGW) {
#pragma unroll
        for (int j = 0; j < 4; ++j) {
            const int ch0 = 8 * (lane + 64 * j), head = ch0 >> 6;
            const size_t off = (size_t)m * D_ + ch0;
            const u32x4 a = *(const u32x4*)(Y0 + off), bq = *(const u32x4*)(Y1 + off);
            float ys[8];
            ys[0] = bf_lo(a.x) + bf_lo(bq.x); ys[1] = bf_hi(a.x) + bf_hi(bq.x); ys[2] = bf_lo(a.y) + bf_lo(bq.y); ys[3] = bf_hi(a.y) + bf_hi(bq.y);
            ys[4] = bf_lo(a.z) + bf_lo(bq.z); ys[5] = bf_hi(a.z) + bf_hi(bq.z); ys[6] = bf_lo(a.w) + bf_lo(bq.w); ys[7] = bf_hi(a.w) + bf_hi(bq.w);
            float s = 0.f;
#pragma unroll
            for (int i = 0; i < 8; ++i) s += ys[i];
            const float mean = red8(s) * (1.f / 64.f);
            float s2 = 0.f;
#pragma unroll
            for (int i = 0; i < 8; ++i) { ys[i] -= mean; s2 += ys[i] * ys[i]; }
            const float rs = rsqrtf(red8(s2) * (1.f / 64.f) + 64e-5f);
            const h8 v8 = *(const h8*)(Vg + off), g8 = *(const h8*)(Gg + off);
            const f32x4 w0 = *(const f32x4*)(lnw + ch0), w1 = *(const f32x4*)(lnw + ch0 + 4), b0 = *(const f32x4*)(lnb + ch0), b1 = *(const f32x4*)(lnb + ch0 + 4);
            const float bsum = BS[(size_t)m * NH_ + head] + BS[(size_t)M_ * NH_ + (size_t)m * NH_ + head];
            float o[8];
#pragma unroll
            for (int i = 0; i < 8; ++i) {
                const float lw = i < 4 ? w0[i] : w1[i - 4], lb = i < 4 ? b0[i] : b1[i - 4];
                o[i] = (ys[i] * rs * lw + lb + bsum * (float)v8[i]) * (float)g8[i];
            }
            u32x4 w; w.x = cvt_pk_bf16(o[0], o[1]); w.y = cvt_pk_bf16(o[2], o[3]); w.z = cvt_pk_bf16(o[4], o[5]); w.w = cvt_pk_bf16(o[6], o[7]);
            *(u32x4*)(P + off) = w;
        }
    }
}

__device__ __forceinline__ void ffn_g1(unsigned char* ws, LAS unsigned char* lds, int tid, int bid, int nb, size_t o_gu) {
    SchedSimple S; S.A = (const char*)(ws + O_XN); S.Bt = (const char*)(ws + o_gu); S.nM = 64; S.nN = 44; S.G = nb; S.c = bid; S.poolmode = 0; S.wgm = 8;
    S.tstepA = (size_t)256 * D_ * 2; S.tstepB = (size_t)256 * D_ * 2;
    EpiSwiGLU E; E.U = (bf16_t*)(ws + O_U);
    gemm_phase(lds, tid, D_, D_, D_, S, E);
}
__device__ __forceinline__ void gemm_resid(unsigned char* ws, float* hout, LAS unsigned char* lds, int tid, int bid, int nb, size_t o_a, int lda, size_t o_bt, int K, int poolmode, const float* src, const float* colscale, float scale) {
    SchedSimple S; S.A = (const char*)(ws + o_a); S.Bt = (const char*)(ws + o_bt); S.nM = 64; S.nN = 8; S.G = nb; S.c = bid; S.poolmode = poolmode; S.wgm = 4;
    S.tstepA = (size_t)256 * lda * 2; S.tstepB = (size_t)256 * K * 2;
    EpiResid E; E.src = src; E.dst = hout; E.colscale = colscale; E.scale = scale;
    gemm_phase(lds, tid, K, lda, K, S, E);
}

__global__ void __launch_bounds__(512) mega(Params p) {
    extern __shared__ __attribute__((aligned(16))) unsigned char smem[];
    LAS unsigned char* lds = (LAS unsigned char*)smem;
    cg::grid_group grid = cg::this_grid();
    XcdBarrier xb;
    {
        volatile LAS unsigned* st = (volatile LAS unsigned*)(lds + 131072);
        if (threadIdx.x == 0) { st[0] = 0u; st[1] = 0u; }
        __syncthreads();
        xb.bar = (unsigned*)(p.ws + O_BAR); xb.x = xb_xcc_id(); xb.st = st;
        if (threadIdx.x == 0) (void)xb_add(&xb.bar[XB_XCNT(xb.x)], 1u);
    }
    constexpr int nb = 256;
    const int wid_s = __builtin_amdgcn_readfirstlane((int)(threadIdx.x >> 6));
#define PROLOG int m1_ = -1; asm volatile("" : "+s"(m1_)); int tid = wid_s * 64 + (int)__builtin_amdgcn_mbcnt_hi(m1_, __builtin_amdgcn_mbcnt_lo(m1_, 0)); int bid = blockIdx.x; asm volatile("" : "+s"(bid)); \
        const int lane = tid & 63, wave = tid >> 6; const int gw = bid * 8 + wave, NGW = nb * 8; LAS float* scr = (LAS float*)(lds + wave * 8704); \
        unsigned char* ws = p.ws; asm volatile("" : "+s"(ws)); float* h = p.out; asm volatile("" : "+s"(h)); (void)lane; (void)gw; (void)NGW; (void)scr; (void)h; (void)ws;
    for (int ph = p.ph_lo; ph < p.ph_hi; ++ph) {
#if REP_MASK
      const int nrep = ((REP_MASK >> ph) & 1) + 1;
      for (int rep = 0; rep < nrep; ++rep) {
        const float rsc = (rep == nrep - 1) ? 1.f : 0.f;
        if (rep) grid.sync();
#else
      { constexpr float rsc = 1.f;
#endif
        switch (ph) {
        case 0: { PROLOG
            norm_phase<false>(pin(p, 0), pin(p, 1), (bf16_t*)(ws + O_XN), nullptr, lane, gw, NGW);
            conv_ffn(pin(p, 2), pin(p, 3), pin(p, 4), (bf16_t*)(ws + O_AGU), (bf16_t*)(ws + O_AD), scr, lane, gw, NGW);
            conv_ffn(pin(p, 7), pin(p, 8), pin(p, 9), (bf16_t*)(ws + O_BGU), (bf16_t*)(ws + O_BD), scr, lane, gw, NGW);
            conv_rwkv(p, ws, scr, lane, gw, NGW);
        } break;
        case 1: { PROLOG
            ffn_g1(ws, lds, tid, bid, nb, O_AGU);
        } break;
        case 2: { PROLOG
            gemm_resid(ws, h, lds, tid, bid, nb, O_U, F_, O_AD, F_, 0, pin(p, 0), nullptr, 0.5f * rsc);
        } break;
        case 3: { PROLOG
            pool_prep_phase(h, pin(p, 5), (bf16_t*)(ws + O_XN), lds, tid, lane, wave, bid, nb);
            __syncthreads();
            conv_ffn(pin(p, 2) + (size_t)D_ * F_, pin(p, 3) + (size_t)D_ * F_, pin(p, 4) + (size_t)D_ * F_, (bf16_t*)(ws + O_AGU), (bf16_t*)(ws + O_AD), scr, lane, gw, NGW);
        } break;
        case 4: { PROLOG
            gemm_resid(ws, h, lds, tid, bid, nb, O_XN, D_, O_POOLT, 512, 1, h, pin(p, 11), 1.f * rsc);
        } break;
        case 5: { PROLOG
            norm_phase<false>(h, pin(p, 6), (bf16_t*)(ws + O_XN), nullptr, lane, gw, NGW);
        } break;
        case 6: { PROLOG
            ffn_g1(ws, lds, tid, bid, nb, O_BGU);
        } break;
        case 7: { PROLOG
            gemm_resid(ws, h, lds, tid, bid, nb, O_U, F_, O_BD, F_, 0, h, nullptr, 0.5f * rsc);
        } break;
        case 8: { PROLOG
            norm_phase<false>(h, pin(p, 1) + D_, (bf16_t*)(ws + O_XN), nullptr, lane, gw, NGW);
        } break;
        case 9: { PROLOG
            ffn_g1(ws, lds, tid, bid, nb, O_AGU);
        } break;
        case 10: { PROLOG
            gemm_resid(ws, h, lds, tid, bid, nb, O_U, F_, O_AD, F_, 0, h, nullptr, 0.5f * rsc);
        } break;
        case 11: { PROLOG
            rwkv_prep_phase(h, pin(p, 5) + D_, pin(p, 12), (bf16_t*)(ws + O_X6), lane, gw, NGW);
        } break;
        case 12: { PROLOG
            {
            SchedProj S; S.ws = (const char*)ws; S.G = nb; S.c = bid;
            EpiProj E; E.ws = ws;
            gemm_phase(lds, tid, D_, D_, D_, S, E);
        }
        } break;
        case 13: { PROLOG
            {
            SchedLora2 S; S.ws = (const char*)ws; S.G = nb; S.c = bid;
            EpiLora2 E; E.ws = ws; E.w0 = pin(p, 17); E.a0 = pin(p, 20);
            gemm_phase(lds, tid, 256, 256, 256, S, E);
        }
        } break;
        case 14: { PROLOG
            scan_phase(p, ws, lds, tid, lane, wave, bid, nb);
        } break;
        case 15: { PROLOG
            post_phase(p, ws, lane, gw, NGW);
        } break;
        case 16: { PROLOG
            gemm_resid(ws, h, lds, tid, bid, nb, O_POST, D_, O_WOT, D_, 0, h, nullptr, 1.f * rsc);
        } break;
        case 17: { PROLOG
            norm_phase<false>(h, pin(p, 6) + D_, (bf16_t*)(ws + O_XN), nullptr, lane, gw, NGW);
            conv_ffn(pin(p, 7) + (size_t)D_ * F_, pin(p, 8) + (size_t)D_ * F_, pin(p, 9) + (size_t)D_ * F_, (bf16_t*)(ws + O_BGU), (bf16_t*)(ws + O_BD), scr, lane, gw, NGW);
        } break;
        case 18: { PROLOG
            ffn_g1(ws, lds, tid, bid, nb, O_BGU);
        } break;
        case 19: { PROLOG
            gemm_resid(ws, h, lds, tid, bid, nb, O_U, F_, O_BD, F_, 0, h, nullptr, 0.5f * rsc);
        } break;
        case 20: { PROLOG
            norm_phase<true>(h, pin(p, 30), nullptr, h, lane, gw, NGW);
        } break;
        default: break;
        }
      }
        if (ph + 1 < p.ph_hi) {
            if (p.ph_lo < 0) grid.sync();
            xcd_barrier(xb, threadIdx.x == 0);
        }
    }
}

extern "C" void kernel_launch(void* const* d_in, const int* in_sizes, int n_in, void* d_out, int out_size, void* d_ws, size_t ws_size, hipStream_t stream) {
    static int grid_blocks = 0;
    if (grid_blocks == 0) {
        if (n_in != 31 || out_size != M_ * D_ || ws_size < WS_NEED) { fprintf(stderr, "kernel_launch: unexpected shapes (n_in %d out %d ws %zu)\n", n_in, out_size, ws_size); grid_blocks = -1; return; }
        int dev = 0, cus = 0, per_cu = 0;
        hipGetDevice(&dev);
        hipDeviceGetAttribute(&cus, hipDeviceAttributeMultiprocessorCount, dev);
        if (hipFuncSetAttribute((const void*)mega, hipFuncAttributeMaxDynamicSharedMemorySize, LDS_BYTES) != hipSuccess) { fprintf(stderr, "kernel_launch: hipFuncSetAttribute failed\n"); grid_blocks = -1; return; }
        hipOccupancyMaxActiveBlocksPerMultiprocessor(&per_cu, (const void*)mega, 512, LDS_BYTES);
        if (per_cu < 1) per_cu = 1;
        if (cus * per_cu < 256) { fprintf(stderr, "kernel_launch: device holds only %d co-resident workgroups, 256 needed\n", cus * per_cu); grid_blocks = -1; (void)hipGetLastError(); return; }
        grid_blocks = 256;
        (void)hipGetLastError();
    }
    if (grid_blocks < 0) return;
    Params p{};
    for (int i = 0; i < 31; ++i) p.in[i] = (const float*)d_in[i];
    p.out = (float*)d_out; p.ws = (unsigned char*)d_ws;
#if MK_SINGLE
    (void)hipMemsetAsync((unsigned char*)d_ws + O_BAR, 0, XCD_BAR_WORDS * 4, stream);
    p.ph_lo = 0; p.ph_hi = NPHASE;
    void* args[] = {&p};
    hipError_t e = hipLaunchCooperativeKernel((const void*)mega, dim3(grid_blocks), dim3(512), args, LDS_BYTES, stream);
    if (e != hipSuccess) fprintf(stderr, "cooperative launch failed: %s (grid %d)\n", hipGetErrorString(e), grid_blocks);
#else
    for (int ph = 0; ph < NPHASE; ++ph) {
        p.ph_lo = ph; p.ph_hi = ph + 1;
        hipLaunchKernelGGL(mega, dim3(grid_blocks), dim3(512), LDS_BYTES, stream, p);
    }
#endif
}
```
